# Optimizing an MI355X kernel written in HIP

```python
import jax, jax.numpy as jnp
from jax import lax
import numpy as np

D_MODEL = 1024
BATCH = 32
SEQ = 2048
DEPTH = 2
DEC_BATCH = 16
DEC_SEQ = 4096
PAST_LEN = 128

N_META = 16
N_MIXERS = 2
N_RWKV = (DEPTH + 1) // 2
N_FNET = DEPTH // 2
HEAD_SIZE = 64
N_HEADS = D_MODEL // HEAD_SIZE
DECAY_LORA = 64
AAA_LORA = 64
GATE_LORA = 160
N_MU = 6
FNET_GROUPS = 8
FNET_GROUP_DIM = D_MODEL // FNET_GROUPS
D_FF = 2816
CONV_WIDTH = 3
RMS_EPS = 1e-6
GN_EPS = 64e-5

kernel_name = 'bidir_rwkv7_fnet_convglu_trunk'


def rmsnorm(x, g):
    xf = x.astype(jnp.float32)
    y = xf * lax.rsqrt(jnp.mean(xf * xf, axis=-1, keepdims=True) + RMS_EPS)
    return (y * g.astype(jnp.float32)).astype(x.dtype)


def split_heads(z):
    return z.reshape(z.shape[:-1] + (N_HEADS, HEAD_SIZE))


def _wkv_step(S, inp):
    r, decay, k, v, avec, b = inp
    sa = jnp.einsum('bhij,bhj->bhi', S, avec)
    S = S * decay[..., None, :] + sa[..., :, None] * b[..., None, :] + v[..., :, None] * k[..., None, :]
    out = jnp.einsum('bhij,bhj->bhi', S, r)
    return S, out


def wkv_scan(r, decay, k, v, avec, b, reverse):
    B, T, H, N = r.shape
    xs = tuple(jnp.moveaxis(z, 1, 0) for z in (r, decay, k, v, avec, b))
    S0 = jnp.zeros((B, H, N, N), jnp.float32)
    _, out = lax.scan(_wkv_step, S0, xs, reverse=reverse)
    return jnp.moveaxis(out, 0, 1)


def rwkv7_time_mix(h, mu, w_rkv, w0, w1, w2, a0, a1, a2, g1, g2, k_k, k_a, r_k, gn_w, gn_b, w_o):
    B, T, D = h.shape
    f32 = jnp.float32
    hp = jnp.pad(h, ((0, 0), (1, 1), (0, 0)))
    xx = 0.5 * (hp[:, :-2] + hp[:, 2:]) - h
    xr, xw, xk, xv, xa, xg = [h + xx * mu[i] for i in range(N_MU)]
    r = xr @ w_rkv[0]
    k = xk @ w_rkv[1]
    v = xv @ w_rkv[2]
    g = jax.nn.sigmoid(xg @ g1) @ g2
    w_lin = w0[:, None, None, :] + jnp.einsum('zbtr,zrd->zbtd', jnp.tanh(jnp.einsum('btd,zdr->zbtr', xw, w1)), w2)
    w_log = -jax.nn.softplus(-w_lin.astype(f32)) - 0.5
    decay = jnp.exp(-jnp.exp(w_log))
    a = jax.nn.sigmoid((a0[:, None, None, :] + jnp.einsum('zbtr,zrd->zbtd', jnp.einsum('btd,zdr->zbtr', xa, a1), a2)).astype(f32))
    rf = split_heads(r.astype(f32))
    vf = split_heads(v.astype(f32))
    kf = k.astype(f32)
    kk = split_heads(kf * k_k.astype(f32))
    kk = kk / jnp.maximum(jnp.sqrt(jnp.sum(kk * kk, axis=-1, keepdims=True)), 1e-12)
    k_dir = split_heads(kf[None] * (1.0 + (a - 1.0) * k_a.astype(f32)))
    b_dir = kk[None] * split_heads(a)
    decay_h = split_heads(decay)
    o_fwd = wkv_scan(rf, decay_h[0], k_dir[0], vf, -kk, b_dir[0], reverse=False)
    o_bwd = wkv_scan(rf, decay_h[1], k_dir[1], vf, -kk, b_dir[1], reverse=True)
    o = o_fwd + o_bwd
    mean = jnp.mean(o, axis=-1, keepdims=True)
    var = jnp.mean(jnp.square(o - mean), axis=-1, keepdims=True)
    o = ((o - mean) * lax.rsqrt(var + GN_EPS)).reshape(B, T, D) * gn_w.astype(f32) + gn_b.astype(f32)
    bonus = jnp.sum(jnp.sum(rf[None] * k_dir * r_k.astype(f32), axis=-1, keepdims=True), axis=0)
    o = o + (bonus * vf).reshape(B, T, D)
    return (o.astype(h.dtype) * g) @ w_o


def fourier_mix(h, w_f):
    B, T, D = h.shape
    hg = h.astype(jnp.float32).reshape(B, T, FNET_GROUPS, FNET_GROUP_DIM)
    f = jnp.fft.fftn(hg, axes=(1, 3), norm='ortho').real
    return f.reshape(B, T, D).astype(h.dtype) @ w_f


def conv_glu_ffn(h, w_in, conv_w, conv_b, w_out):
    u = h @ w_in
    act_in, lin = u[..., :D_FF], u[..., D_FF:]
    p = jnp.pad(act_in, ((0, 0), (1, 1), (0, 0)))
    c = p[:, :-2] * conv_w[0] + p[:, 1:-1] * conv_w[1] + p[:, 2:] * conv_w[2] + conv_b
    return (jax.nn.silu(c) * lin) @ w_out


def trunk(x, meta_tokens, norm_mix, norm_ffn, norm_final,
          rwkv_mu, rwkv_w_rkv, rwkv_w0, rwkv_w1, rwkv_w2, rwkv_a0, rwkv_a1, rwkv_a2,
          rwkv_g1, rwkv_g2, rwkv_k_k, rwkv_k_a, rwkv_r_k, rwkv_gn_w, rwkv_gn_b, rwkv_w_o,
          fnet_w_o, ffn_w_in, ffn_conv_w, ffn_conv_b, ffn_w_out):
    B = x.shape[0]
    meta = jnp.broadcast_to(meta_tokens.astype(x.dtype)[None], (B, N_META, D_MODEL))
    h = jnp.concatenate([meta, x], axis=1)
    for i in range(DEPTH):
        hn = rmsnorm(h, norm_mix[i])
        j = i // N_MIXERS
        if i % N_MIXERS == 0:
            h = h + rwkv7_time_mix(hn, rwkv_mu[j], rwkv_w_rkv[j], rwkv_w0[j], rwkv_w1[j], rwkv_w2[j],
                                   rwkv_a0[j], rwkv_a1[j], rwkv_a2[j], rwkv_g1[j], rwkv_g2[j],
                                   rwkv_k_k[j], rwkv_k_a[j], rwkv_r_k[j], rwkv_gn_w[j], rwkv_gn_b[j], rwkv_w_o[j])
        else:
            h = h + fourier_mix(hn, fnet_w_o[j])
        h = h + conv_glu_ffn(rmsnorm(h, norm_ffn[i]), ffn_w_in[i], ffn_conv_w[i], ffn_conv_b[i], ffn_w_out[i])
    return rmsnorm(h, norm_final)[:, N_META:]


def setup_inputs(seed: int = 0) -> dict:
    key = jax.random.key(seed)
    ks = jax.random.split(key, 32)
    nrm = jax.random.normal
    D = D_MODEL
    return {
        'x_prompt': nrm(ks[0], (BATCH, SEQ, D), jnp.float32),
        'x_sample': nrm(ks[1], (DEC_BATCH, DEC_SEQ, D), jnp.float32),
        'meta_tokens': nrm(ks[2], (N_META, D), jnp.float32),
        'norm_mix': 1.0 + 0.02 * nrm(ks[3], (DEPTH, D), jnp.float32),
        'norm_ffn': 1.0 + 0.02 * nrm(ks[4], (DEPTH, D), jnp.float32),
        'norm_final': 1.0 + 0.02 * nrm(ks[5], (D,), jnp.float32),
        'rwkv_mu': jax.random.uniform(ks[6], (N_RWKV, N_MU, D), jnp.float32),
        'rwkv_w_rkv': nrm(ks[7], (N_RWKV, 3, D, D), jnp.float32) * D ** -0.5,
        'rwkv_w0': jax.random.uniform(ks[8], (N_RWKV, 2, D), jnp.float32, -5.0, 1.0),
        'rwkv_w1': nrm(ks[9], (N_RWKV, 2, D, DECAY_LORA), jnp.float32) * D ** -0.5,
        'rwkv_w2': nrm(ks[10], (N_RWKV, 2, DECAY_LORA, D), jnp.float32) * 0.1 * DECAY_LORA ** -0.5,
        'rwkv_a0': 0.5 * nrm(ks[11], (N_RWKV, 2, D), jnp.float32),
        'rwkv_a1': nrm(ks[12], (N_RWKV, 2, D, AAA_LORA), jnp.float32) * D ** -0.5,
        'rwkv_a2': nrm(ks[13], (N_RWKV, 2, AAA_LORA, D), jnp.float32) * 0.1 * AAA_LORA ** -0.5,
        'rwkv_g1': nrm(ks[14], (N_RWKV, D, GATE_LORA), jnp.float32) * D ** -0.5,
        'rwkv_g2': nrm(ks[15], (N_RWKV, GATE_LORA, D), jnp.float32) * GATE_LORA ** -0.5,
        'rwkv_k_k': 0.85 + 0.02 * nrm(ks[16], (N_RWKV, D), jnp.float32),
        'rwkv_k_a': 1.0 + 0.02 * nrm(ks[17], (N_RWKV, D), jnp.float32),
        'rwkv_r_k': 0.1 * nrm(ks[18], (N_RWKV, N_HEADS, HEAD_SIZE), jnp.float32),
        'rwkv_gn_w': 1.0 + 0.02 * nrm(ks[19], (N_RWKV, D), jnp.float32),
        'rwkv_gn_b': 0.02 * nrm(ks[20], (N_RWKV, D), jnp.float32),
        'rwkv_w_o': nrm(ks[21], (N_RWKV, D, D), jnp.float32) * D ** -0.5,
        'fnet_w_o': nrm(ks[22], (N_FNET, D, D), jnp.float32) * D ** -0.5,
        'ffn_w_in': nrm(ks[23], (DEPTH, D, 2 * D_FF), jnp.float32) * D ** -0.5,
        'ffn_conv_w': nrm(ks[24], (DEPTH, CONV_WIDTH, D_FF), jnp.float32) * CONV_WIDTH ** -0.5,
        'ffn_conv_b': 0.02 * nrm(ks[25], (DEPTH, D_FF), jnp.float32),
        'ffn_w_out': nrm(ks[26], (DEPTH, D_FF, D), jnp.float32) * D_FF ** -0.5,
    }


def reference(x_prompt, x_sample, meta_tokens, norm_mix, norm_ffn, norm_final,
              rwkv_mu, rwkv_w_rkv, rwkv_w0, rwkv_w1, rwkv_w2, rwkv_a0, rwkv_a1, rwkv_a2,
              rwkv_g1, rwkv_g2, rwkv_k_k, rwkv_k_a, rwkv_r_k, rwkv_gn_w, rwkv_gn_b, rwkv_w_o,
              fnet_w_o, ffn_w_in, ffn_conv_w, ffn_conv_b, ffn_w_out):
    y_prompt = trunk(x_prompt, meta_tokens, norm_mix, norm_ffn, norm_final,
                     rwkv_mu, rwkv_w_rkv, rwkv_w0, rwkv_w1, rwkv_w2, rwkv_a0, rwkv_a1, rwkv_a2,
                     rwkv_g1, rwkv_g2, rwkv_k_k, rwkv_k_a, rwkv_r_k, rwkv_gn_w, rwkv_gn_b, rwkv_w_o,
                     fnet_w_o, ffn_w_in, ffn_conv_w, ffn_conv_b, ffn_w_out)
    y_sample = trunk(x_sample, meta_tokens, norm_mix, norm_ffn, norm_final,
                     rwkv_mu, rwkv_w_rkv, rwkv_w0, rwkv_w1, rwkv_w2, rwkv_a0, rwkv_a1, rwkv_a2,
                     rwkv_g1, rwkv_g2, rwkv_k_k, rwkv_k_a, rwkv_r_k, rwkv_gn_w, rwkv_gn_b, rwkv_w_o,
                     fnet_w_o, ffn_w_in, ffn_conv_w, ffn_conv_b, ffn_w_out)
    return (y_prompt, y_sample)
```

```cpp
#include <hip/hip_runtime.h>
#include <hip/hip_cooperative_groups.h>
#include <cstdio>
namespace cg = cooperative_groups;

#ifndef MK_PER_PHASE
#define MK_PER_PHASE 0
#endif

#define LAS __attribute__((address_space(3)))
typedef unsigned short bf16_t;
typedef short bf16x8 __attribute__((ext_vector_type(8)));
typedef float f32x4 __attribute__((ext_vector_type(4)));
typedef unsigned u32x4 __attribute__((ext_vector_type(4)));
typedef unsigned u32x2 __attribute__((ext_vector_type(2)));
typedef const __attribute__((address_space(4))) unsigned* cptr;

constexpr int D = 1024, DFF = 2816, NMETA = 16;
constexpr int RP = 33024;
constexpr int MT = RP / 256;
constexpr size_t SLOT = (size_t)RP * D * 2;
constexpr int NSLOT = 13;
constexpr size_t O_WRKV = NSLOT * SLOT;
constexpr size_t O_G1 = O_WRKV + (size_t)3072 * 1024 * 2;
constexpr size_t O_W1 = O_G1 + (size_t)256 * 1024 * 2;
constexpr size_t O_A1 = O_W1 + (size_t)256 * 1024 * 2;
constexpr size_t O_L2 = O_A1 + (size_t)256 * 1024 * 2;
constexpr size_t O_G2 = O_L2 + (size_t)4096 * 256 * 2;
constexpr size_t O_WO = O_G2 + (size_t)1024 * 256 * 2;
constexpr size_t O_WF = O_WO + (size_t)1024 * 1024 * 2;
constexpr size_t O_WIN = O_WF + (size_t)1024 * 1024 * 2;
constexpr size_t O_WOUT = O_WIN + (size_t)2 * 5632 * 1024 * 2;
constexpr size_t O_CHD = O_WOUT + (size_t)2 * 1024 * 2816 * 2;
constexpr int TP_P = 2112, TP_S = 4160, MP_P = 2304, MP_S = 4352;
constexpr size_t O_DFTP = O_CHD + (size_t)2048 * 1024 * 2;
constexpr size_t O_DFTS = O_DFTP + (size_t)MP_P * 2 * TP_P * 2;
constexpr size_t O_SS = O_DFTS + (size_t)MP_S * 2 * TP_S * 2;
constexpr size_t O_RSTD = O_SS + (size_t)3 * 16 * RP * 4;
constexpr size_t O_BONUS = O_RSTD + (size_t)3 * RP * 4;
constexpr size_t WS_END = O_BONUS + (size_t)RP * 16 * 4;

struct Params { const float* in[27]; float* out; unsigned char* ws; };
struct Ctx { int g, T, nseq, R, Tp, tm; const float* x; float* y; };

__device__ __forceinline__ Ctx get_ctx(const Params& p, int g) {
    Ctx c; c.g = g;
    if (g < 2) { c.T = 2064; c.nseq = 16; c.Tp = TP_P; c.tm = 9; c.x = p.in[0] + (size_t)g * 16 * 2048 * 1024; c.y = p.out + (size_t)g * 16 * 2048 * 1024; }
    else { c.T = 4112; c.nseq = 8; c.Tp = TP_S; c.tm = 17; c.x = p.in[1] + (size_t)(g - 2) * 8 * 4096 * 1024; c.y = p.out + (size_t)32 * 2048 * 1024 + (size_t)(g - 2) * 8 * 4096 * 1024; }
    c.R = c.nseq * c.T; return c;
}
__device__ __forceinline__ int ltid() { int t = threadIdx.x; asm volatile("" : "+v"(t)); return t; }
__device__ __forceinline__ unsigned char* slot(const Params& p, int i) { return p.ws + (size_t)i * SLOT; }

__device__ __forceinline__ unsigned pk2(float lo, float hi) { unsigned r; asm volatile("v_cvt_pk_bf16_f32 %0, %1, %2" : "=v"(r) : "v"(lo), "v"(hi)); return r; }
__device__ __forceinline__ float bflo(unsigned u) { return __uint_as_float(u << 16); }
__device__ __forceinline__ float bfhi(unsigned u) { return __uint_as_float(u & 0xffff0000u); }
__device__ __forceinline__ float wave_sum(float v) {
#pragma unroll
    for (int o = 1; o < 64; o <<= 1) v += __shfl_xor(v, o);
    return v;
}
__device__ __forceinline__ float sigmoidf_(float x) { return 1.f / (1.f + __expf(-x)); }
__device__ __forceinline__ void unpack16(const u32x4 a, const u32x4 b, float (&v)[16]) {
#pragma unroll
    for (int i = 0; i < 4; ++i) { v[2 * i] = bflo(a[i]); v[2 * i + 1] = bfhi(a[i]); v[8 + 2 * i] = bflo(b[i]); v[8 + 2 * i + 1] = bfhi(b[i]); }
}
__device__ __forceinline__ void load16bf(const unsigned char* base, size_t elem, float (&v)[16]) {
    const u32x4* q = (const u32x4*)(base + elem * 2); unpack16(q[0], q[1], v);
}
__device__ __forceinline__ void store16bf(unsigned char* base, size_t elem, const float (&v)[16]) {
    u32x4 a, b;
#pragma unroll
    for (int i = 0; i < 4; ++i) { a[i] = pk2(v[2 * i], v[2 * i + 1]); b[i] = pk2(v[8 + 2 * i], v[8 + 2 * i + 1]); }
    u32x4* q = (u32x4*)(base + elem * 2); q[0] = a; q[1] = b;
}
__device__ __forceinline__ void load16f(const float* src, float (&v)[16]) {
#pragma unroll
    for (int j = 0; j < 4; ++j) { f32x4 t = ((const f32x4*)src)[j]; v[4 * j] = t[0]; v[4 * j + 1] = t[1]; v[4 * j + 2] = t[2]; v[4 * j + 3] = t[3]; }
}

constexpr int BM = 256, BK = 64, HALF = 128, HTB = HALF * BK * 2, STAGE_BYTES = 8 * HTB;
__device__ __forceinline__ int lds_byte(int r, int c) { const int st = (r >> 4) * 2 + (c >> 5), rr = r & 15, cc = c & 31, ob = rr * 64 + cc * 2; return st * 1024 + (ob ^ (((ob >> 9) & 1) << 5)); }
__device__ __forceinline__ void stage_rc(int b, int& R, int& C) { const int st = b / 1024, sb = b % 1024, swz = sb ^ (((sb >> 9) & 1) << 5); R = (st >> 1) * 16 + swz / 64; C = (st & 1) * 32 + (swz % 64) / 2; }
__device__ __forceinline__ int perm32(int rho) { const int n = rho >> 4, i = rho & 15; return 8 * (i >> 2) + 4 * n + (i & 3); }

enum { K_L1 = 0, K_L2, K_RES, K_U, K_CH, K_TD };
struct Unit { const char* A; const char* B; int pm, pn, job, s; };
struct GemmPh {
    int kind, nunits, lda, ldb, K, G, c;
    const char* A; const char* B;
    unsigned char* O; float* ss; const float* ssin; int ldo;
};

__device__ __forceinline__ bool next_unit(const GemmPh& P, const Params& p, const Ctx& cx, int i, Unit& u) {
    const long Lg = (long)i * P.G + P.c; if (Lg >= P.nunits) return false;
    const int L = (int)Lg; u.s = 0; u.job = 0;
    if (P.kind == K_L1) {
        const int pm = L / 15, jn = L % 15; int job, pn;
        if (jn < 12) { job = jn >> 2; pn = jn & 3; } else { job = 3 + (jn - 12); pn = 0; }
        const int aslot = job == 0 ? 1 : job == 1 ? 3 : job == 2 ? 4 : job == 3 ? 6 : job == 4 ? 2 : 5;
        u.A = (const char*)slot(p, aslot) + (size_t)pm * 256 * 2048;
        const size_t boff = job < 3 ? O_WRKV + ((size_t)job * 1024 + pn * 256) * 2048 : job == 3 ? O_G1 : job == 4 ? O_W1 : O_A1;
        u.B = (const char*)p.ws + boff; u.pm = pm; u.pn = pn; u.job = job;
    } else if (P.kind == K_L2) {
        const int pm = L / 20, jn = L % 20; const int job = jn < 16 ? 0 : 1, pn = jn < 16 ? jn : jn - 16;
        u.A = (const char*)slot(p, 10) + (job == 0 ? (size_t)RP * 512 : 0) + (size_t)pm * 256 * 512;
        u.B = (const char*)p.ws + (job == 0 ? O_L2 : O_G2) + (size_t)pn * 256 * 512; u.pm = pm; u.pn = pn; u.job = job;
    } else if (P.kind == K_RES) {
        const int pm = L >> 2, pn = L & 3;
        u.A = P.A + (size_t)pm * 256 * P.lda * 2; u.B = P.B + (size_t)pn * 256 * P.ldb * 2; u.pm = pm; u.pn = pn;
    } else if (P.kind == K_U) {
        const int pm = L / 22, pn = L % 22;
        u.A = P.A + (size_t)pm * 256 * 2048; u.B = P.B + (size_t)pn * 256 * 2048; u.pm = pm; u.pn = pn;
    } else if (P.kind == K_CH) {
        const int pn = L >> 3, pm = L & 7;
        u.A = P.A + (size_t)pm * 256 * 2048 + (pm & 3) * 512; u.B = P.B + (size_t)pn * 256 * 2048 + (pm & 3) * 512; u.pm = pm; u.pn = pn;
    } else {
        const int per = cx.tm * 4, s = L / per, rem = L % per, pm = rem >> 2, pn = rem & 3;
        u.A = P.A + (size_t)pm * 256 * P.lda * 2; u.B = P.B + ((size_t)s * 1024 + pn * 256) * P.ldb * 2; u.pm = pm; u.pn = pn; u.s = s;
    }
    return true;
}

__device__ __forceinline__ void st8(unsigned char* ptr, const f32x4 a, const f32x4 b) {
    u32x4 o; o[0] = pk2(a[0], a[1]); o[1] = pk2(a[2], a[3]); o[2] = pk2(b[0], b[1]); o[3] = pk2(b[2], b[3]); *(u32x4*)ptr = o;
}
__device__ __forceinline__ float decaymap(float w) {
    const float e = 0.6065306597f / (1.f + __expf(-w)); return __expf(-e) - 1.f;
}
__device__ __forceinline__ float act_apply(int act, float x) {
    if (act == 1) return 1.f / (1.f + __expf(-x));
    if (act == 2) return 1.f - 2.f / (__expf(2.f * x) + 1.f);
    if (act == 3) return decaymap(x);
    return x;
}

__device__ __forceinline__ float rstd16(const float* ss, int r) {
    float s = 0.f;
#pragma unroll
    for (int i = 0; i < 16; ++i) s += ss[(size_t)i * RP + r];
    return rsqrtf(s * (1.f / 1024.f) + 1e-6f);
}
__device__ __forceinline__ void epilogue(const GemmPh& P, const Params& p, const Ctx& cx, const f32x4 (&acc)[2][2][4][2], const Unit& u, int wr, int wc, int fr, int fq) {
    const int rbase = u.pm * 256 + wr * 64 + fr, cbase = u.pn * 256 + wc * 32 + 8 * fq;
    if (P.kind == K_L1 || P.kind == K_L2) {
        unsigned char* O; int ldo = 1024, coff = 0, act = 0, cvalid = 1 << 30; const float* bias = nullptr;
        if (P.kind == K_L1) {
            if (u.job < 3) { O = slot(p, 7 + u.job); }
            else if (u.job == 3) { O = slot(p, 10); ldo = 256; act = 1; }
            else if (u.job == 4) { O = slot(p, 10) + (size_t)RP * 512; ldo = 256; act = 2; cvalid = 128; }
            else { O = slot(p, 10) + (size_t)RP * 512; ldo = 256; coff = 128; cvalid = 128; }
        } else {
            if (u.job == 1) { O = slot(p, 5); }
            else { const int cb = u.pn >> 2; O = slot(p, 1 + cb); bias = (cb < 2 ? p.in[8] : p.in[11]) + (cb & 1) * 1024 - cb * 1024; coff = -cb * 1024; act = cb < 2 ? 3 : 1; }
        }
        f32x4 bv[2][2];
#pragma unroll
        for (int bj = 0; bj < 2; ++bj)
#pragma unroll
            for (int n = 0; n < 2; ++n) bv[bj][n] = bias ? *(const f32x4*)(bias + cbase + bj * 128 + 4 * n) : (f32x4){0.f, 0.f, 0.f, 0.f};
#pragma unroll
        for (int ai = 0; ai < 2; ++ai)
#pragma unroll
            for (int m = 0; m < 4; ++m) { if ((m & 1) == 0) __builtin_amdgcn_sched_barrier(0);
#pragma unroll
                for (int bj = 0; bj < 2; ++bj) { const int r = rbase + ai * 128 + m * 16; const int c0 = cbase + bj * 128;
                    f32x4 v0 = acc[ai][bj][m][0] + bv[bj][0], v1 = acc[ai][bj][m][1] + bv[bj][1];
#pragma unroll
                    for (int i = 0; i < 4; ++i) { v0[i] = act_apply(act, v0[i]); v1[i] = act_apply(act, v1[i]); }
                    if (c0 < cvalid) st8(O + ((size_t)r * ldo + coff + c0) * 2, v0, v1); } }
    } else if (P.kind == K_RES) {
        unsigned char* H = P.O;
#pragma unroll
        for (int ai = 0; ai < 2; ++ai)
#pragma unroll
            for (int m = 0; m < 4; ++m) { if ((m & 1) == 0) __builtin_amdgcn_sched_barrier(0); const int r = rbase + ai * 128 + m * 16; float sq = 0.f;
#pragma unroll
                for (int bj = 0; bj < 2; ++bj) { unsigned char* ptr = H + ((size_t)r * 1024 + cbase + bj * 128) * 2;
                    const u32x4 old = *(const u32x4*)ptr; u32x4 o; const f32x4 a0 = acc[ai][bj][m][0], a1 = acc[ai][bj][m][1];
                    o[0] = pk2(bflo(old[0]) + a0[0], bfhi(old[0]) + a0[1]); o[1] = pk2(bflo(old[1]) + a0[2], bfhi(old[1]) + a0[3]);
                    o[2] = pk2(bflo(old[2]) + a1[0], bfhi(old[2]) + a1[1]); o[3] = pk2(bflo(old[3]) + a1[2], bfhi(old[3]) + a1[3]);
#pragma unroll
                    for (int i = 0; i < 4; ++i) { const float rl = bflo(o[i]), rh = bfhi(o[i]); sq += rl * rl + rh * rh; }
                    *(u32x4*)ptr = o; }
                if (P.ss) { sq += __shfl_xor(sq, 16); sq += __shfl_xor(sq, 32); if (fq == 0) P.ss[(size_t)(u.pn * 4 + wc) * RP + r] = sq; } }
    } else if (P.kind == K_U) {
#pragma unroll
        for (int ai = 0; ai < 2; ++ai)
#pragma unroll
            for (int m = 0; m < 4; ++m) { if ((m & 1) == 0) __builtin_amdgcn_sched_barrier(0); const int r = rbase + ai * 128 + m * 16; const float rs = P.ssin[r];
#pragma unroll
                for (int bj = 0; bj < 2; ++bj) st8(P.O + ((size_t)r * 5632 + cbase + bj * 128) * 2, acc[ai][bj][m][0] * rs, acc[ai][bj][m][1] * rs); }
    } else if (P.kind == K_CH) {
#pragma unroll
        for (int bj = 0; bj < 2; ++bj) { const int n0 = cbase + bj * 128; const bool ok = n0 < cx.R; const int nn = ok ? n0 : 0;
            const int s = nn / cx.T, t = nn - s * cx.T; f32x4 r0, r1;
#pragma unroll
            for (int i = 0; i < 4; ++i) { r0[i] = P.ssin[nn + i]; r1[i] = P.ssin[nn + 4 + i]; }
#pragma unroll
            for (int ai = 0; ai < 2; ++ai)
#pragma unroll
                for (int m = 0; m < 4; ++m) { if ((m & 1) == 0) __builtin_amdgcn_sched_barrier(0); const int rr = rbase + ai * 128 + m * 16; const int cs = rr >> 10, ch = rr & 1023;
                    if (ok) st8(P.O + ((((size_t)s * 1024 + ch) * 2 + cs) * cx.Tp + t) * 2, acc[ai][bj][m][0] * r0, acc[ai][bj][m][1] * r1); } }
    } else {
#pragma unroll
        for (int ai = 0; ai < 2; ++ai)
#pragma unroll
            for (int m = 0; m < 4; ++m) { if ((m & 1) == 0) __builtin_amdgcn_sched_barrier(0); const int k = rbase + ai * 128 + m * 16; const size_t row = (size_t)u.s * cx.T + k;
#pragma unroll
                for (int bj = 0; bj < 2; ++bj) if (k < cx.T) st8(P.O + (row * 1024 + cbase + bj * 128) * 2, acc[ai][bj][m][0], acc[ai][bj][m][1]); }
    }
}

template <int KIND> __device__ __forceinline__ void gemm_phase(LAS unsigned char* lds, GemmPh P, const Params& p, const Ctx& cx) {
    P.kind = KIND;
    const int tid = ltid(), wid = __builtin_amdgcn_readfirstlane(tid >> 6), lane = tid & 63, wr = wid >> 2, wc = wid & 3, fr = lane & 15, fq = lane >> 4;
    const int nt = P.K / BK;
    unsigned voffA[2], voffB[2];
#pragma unroll
    for (int i = 0; i < 2; ++i) { int R, C; stage_rc(tid * 16 + i * 8192, R, C); const int Rb = (R & ~31) + perm32(R & 31);
        voffA[i] = (unsigned)(R * P.lda + C) * 2u; voffB[i] = (unsigned)(Rb * P.ldb + C) * 2u; }
    const size_t kstep = (size_t)(BK * 2);
    const size_t hstepA = (size_t)HALF * P.lda * 2, hstepB = (size_t)HALF * P.ldb * 2;
    const unsigned ldsw = (unsigned)wid * 1024u;
    const int aoff = lds_byte(wr * 64 + fr, fq * 8), boff = lds_byte(wc * 32 + fr, fq * 8);
#define PG8_SA(b, h) (((b) * 2 + (h)) * HTB)
#define PG8_SB(b, h) ((4 + (b) * 2 + (h)) * HTB)
#define PG8_STAGE(bufoff, gbase, voff) do { _Pragma("unroll") for (int _i = 0; _i < 2; ++_i) \
        __builtin_amdgcn_global_load_lds((const unsigned*)((const char*)(gbase) + (voff)[_i]), (LAS unsigned*)(lds + (bufoff) + ldsw + _i * 8192), 16, 0, 0); } while (0)
#define PG8_LDA(dst, b, h) do { _Pragma("unroll") for (int m = 0; m < 4; ++m) _Pragma("unroll") for (int k = 0; k < 2; ++k) dst[m][k] = *(const LAS bf16x8*)(lds + PG8_SA(b, h) + aoff + m * 2048 + k * 1024); } while (0)
#define PG8_LDB(dst, b, h) do { _Pragma("unroll") for (int n = 0; n < 2; ++n) _Pragma("unroll") for (int k = 0; k < 2; ++k) dst[n][k] = *(const LAS bf16x8*)(lds + PG8_SB(b, h) + boff + n * 2048 + k * 1024); } while (0)
#define PG8_MMA(ai, bj, At, Bt) do { __builtin_amdgcn_s_setprio(1); _Pragma("unroll") for (int m = 0; m < 4; ++m) _Pragma("unroll") for (int n = 0; n < 2; ++n) _Pragma("unroll") for (int k = 0; k < 2; ++k) \
        acc[ai][bj][m][n] = __builtin_amdgcn_mfma_f32_16x16x32_bf16(Bt[n][k], At[m][k], acc[ai][bj][m][n], 0, 0, 0); __builtin_amdgcn_s_setprio(0); } while (0)
#define PG8_WAIT_V(n) asm volatile("s_waitcnt vmcnt(" #n ")" ::: "memory")
#define PG8_WAIT_L(n) asm volatile("s_waitcnt lgkmcnt(" #n ")" ::: "memory")
#define PG8_BAR __builtin_amdgcn_s_barrier()
#define PG8_SCHED __builtin_amdgcn_sched_barrier(0)
    Unit cur, nxt; int ui = 0;
    if (!next_unit(P, p, cx, 0, cur)) return;
    f32x4 acc[2][2][4][2];
#pragma unroll
    for (int a = 0; a < 2; ++a)
#pragma unroll
        for (int b = 0; b < 2; ++b)
#pragma unroll
            for (int m = 0; m < 4; ++m)
#pragma unroll
                for (int n = 0; n < 2; ++n) acc[a][b][m][n] = (f32x4){0.f, 0.f, 0.f, 0.f};
    bf16x8 At[4][2], B0[2][2], B1[2][2];
    const char* cA = cur.A; const char* cB = cur.B;
    PG8_STAGE(PG8_SB(0, 0), cB, voffB); PG8_STAGE(PG8_SA(0, 0), cA, voffA); PG8_STAGE(PG8_SB(0, 1), cB + hstepB, voffB); PG8_STAGE(PG8_SA(0, 1), cA + hstepA, voffA);
    if (wr == 1) PG8_BAR;
    PG8_WAIT_V(4); PG8_BAR;
    PG8_STAGE(PG8_SB(1, 0), cB + kstep, voffB); PG8_STAGE(PG8_SA(1, 0), cA + kstep, voffA); PG8_STAGE(PG8_SB(1, 1), cB + hstepB + kstep, voffB);
    PG8_WAIT_V(6); PG8_BAR;
    for (;;) {
        const bool has_next = next_unit(P, p, cx, ui + 1, nxt);
        const char* nA = has_next ? nxt.A : cA; const char* nB = has_next ? nxt.B : cB;
        for (int t = 0; t < nt; t += 2) {
            const bool last = (t == nt - 2);
            const char* a1 = cA + (size_t)(t + 1) * kstep;
            const char* a2 = last ? nA : cA + (size_t)(t + 2) * kstep; const char* b2 = last ? nB : cB + (size_t)(t + 2) * kstep;
            const char* a3 = a2 + kstep; const char* b3 = b2 + kstep;
            PG8_LDB(B0, 0, 0); PG8_SCHED; PG8_LDA(At, 0, 0); PG8_STAGE(PG8_SA(1, 1), a1 + hstepA, voffA);
            PG8_WAIT_L(8); PG8_BAR; PG8_WAIT_L(0); PG8_MMA(0, 0, At, B0); PG8_BAR; PG8_SCHED;
            PG8_LDB(B1, 0, 1); PG8_STAGE(PG8_SB(0, 0), b2, voffB);
            PG8_BAR; PG8_WAIT_L(0); PG8_MMA(0, 1, At, B1); PG8_BAR;
            PG8_LDA(At, 0, 1); PG8_STAGE(PG8_SA(0, 0), a2, voffA);
            PG8_BAR; PG8_WAIT_L(0); PG8_MMA(1, 0, At, B0); PG8_BAR; PG8_SCHED;
            PG8_STAGE(PG8_SB(0, 1), b2 + hstepB, voffB);
            PG8_WAIT_V(6); PG8_BAR; PG8_MMA(1, 1, At, B1); PG8_BAR;
            PG8_LDB(B0, 1, 0); PG8_SCHED; PG8_LDA(At, 1, 0); PG8_STAGE(PG8_SA(0, 1), a2 + hstepA, voffA);
            PG8_WAIT_L(8); PG8_BAR; PG8_WAIT_L(0); PG8_MMA(0, 0, At, B0); PG8_BAR; PG8_SCHED;
            PG8_LDB(B1, 1, 1); PG8_STAGE(PG8_SB(1, 0), b3, voffB);
            PG8_BAR; PG8_WAIT_L(0); PG8_MMA(0, 1, At, B1); PG8_BAR;
            PG8_LDA(At, 1, 1); PG8_STAGE(PG8_SA(1, 0), a3, voffA);
            PG8_BAR; PG8_WAIT_L(0); PG8_MMA(1, 0, At, B0); PG8_BAR; PG8_SCHED;
            PG8_STAGE(PG8_SB(1, 1), b3 + hstepB, voffB);
            PG8_WAIT_V(6); PG8_BAR; PG8_MMA(1, 1, At, B1); PG8_BAR;
        }
        epilogue(P, p, cx, acc, cur, wr, wc, fr, fq);
        if (!has_next) break;
#pragma unroll
        for (int a = 0; a < 2; ++a)
#pragma unroll
            for (int b = 0; b < 2; ++b)
#pragma unroll
                for (int m = 0; m < 4; ++m)
#pragma unroll
                    for (int n = 0; n < 2; ++n) acc[a][b][m][n] = (f32x4){0.f, 0.f, 0.f, 0.f};
        cur = nxt; cA = nA; cB = nB; ++ui;
    }
    PG8_WAIT_V(0);
    if (wr == 0) PG8_BAR;
    PG8_BAR;
#undef PG8_SA
#undef PG8_SB
#undef PG8_STAGE
#undef PG8_LDA
#undef PG8_LDB
#undef PG8_MMA
#undef PG8_WAIT_V
#undef PG8_WAIT_L
#undef PG8_BAR
#undef PG8_SCHED
}

__device__ __forceinline__ void tr_job(LAS float* tile, const float* src, int K, int N, unsigned char* dst, int ldk, int koff, int Kpad, int Npad, const float* scale, int& cnt, int stride_start, int G) {
    const int tk = Kpad / 64, tn = Npad / 64, ntile = tk * tn; const int tid = ltid();
    for (int it = 0; it < ntile; ++it, ++cnt) {
        if ((cnt % G) != stride_start) continue;
        const int k0 = (it / tn) * 64, n0 = (it % tn) * 64;
        __syncthreads();
        { const int tx = tid & 63, ty = tid >> 6;
#pragma unroll
            for (int i = 0; i < 8; ++i) { const int kd = k0 + ty + 8 * i, ks = kd - koff, n = n0 + tx; float v = 0.f;
                if (ks >= 0 && ks < K && n < N) { v = src[(size_t)ks * N + n]; if (scale) v *= scale[ks]; }
                tile[(ty + 8 * i) * 65 + tx] = v; } }
        __syncthreads();
        { const int n = tid >> 3, kc = (tid & 7) * 8; u32x4 o;
#pragma unroll
            for (int i = 0; i < 4; ++i) o[i] = pk2(tile[(kc + 2 * i) * 65 + n], tile[(kc + 2 * i + 1) * 65 + n]);
            *(u32x4*)(dst + ((size_t)(n0 + n) * ldk + k0 + kc) * 2) = o; }
    }
}

__device__ __forceinline__ void prep_phase(LAS unsigned char* lds, const Params& p) {
    LAS float* tile = (LAS float*)lds; unsigned char* ws = p.ws; int cnt = 0; const int b = blockIdx.x, G = gridDim.x;
    for (int i = 0; i < 3; ++i) tr_job(tile, p.in[7] + (size_t)i * D * D, D, D, ws + O_WRKV + (size_t)i * D * D * 2, 1024, 0, 1024, 1024, nullptr, cnt, b, G);
    tr_job(tile, p.in[14], D, 160, ws + O_G1, 1024, 0, 1024, 256, nullptr, cnt, b, G);
    tr_job(tile, p.in[9], D, 64, ws + O_W1, 1024, 0, 1024, 64, nullptr, cnt, b, G);
    tr_job(tile, p.in[9] + D * 64, D, 64, ws + O_W1 + (size_t)64 * 1024 * 2, 1024, 0, 1024, 192, nullptr, cnt, b, G);
    tr_job(tile, p.in[12], D, 64, ws + O_A1, 1024, 0, 1024, 64, nullptr, cnt, b, G);
    tr_job(tile, p.in[12] + D * 64, D, 64, ws + O_A1 + (size_t)64 * 1024 * 2, 1024, 0, 1024, 192, nullptr, cnt, b, G);
    for (int z = 0; z < 2; ++z) {
        tr_job(tile, p.in[10] + (size_t)z * 64 * D, 64, D, ws + O_L2 + (size_t)z * 1024 * 256 * 2, 256, z * 64, 256, 1024, nullptr, cnt, b, G);
        tr_job(tile, p.in[13] + (size_t)z * 64 * D, 64, D, ws + O_L2 + (size_t)(2 + z) * 1024 * 256 * 2, 256, (2 + z) * 64, 256, 1024, nullptr, cnt, b, G);
    }
    tr_job(tile, p.in[15], 160, D, ws + O_G2, 256, 0, 256, 1024, nullptr, cnt, b, G);
    tr_job(tile, p.in[21], D, D, ws + O_WO, 1024, 0, 1024, 1024, nullptr, cnt, b, G);
    tr_job(tile, p.in[22], D, D, ws + O_WF, 1024, 0, 1024, 1024, nullptr, cnt, b, G);
    for (int l = 0; l < 2; ++l) {
        tr_job(tile, p.in[23] + (size_t)l * D * 5632, D, 5632, ws + O_WIN + (size_t)l * 5632 * 1024 * 2, 1024, 0, 1024, 5632, p.in[4] + l * D, cnt, b, G);
        tr_job(tile, p.in[26] + (size_t)l * DFF * D, DFF, D, ws + O_WOUT + (size_t)l * 1024 * DFF * 2, DFF, 0, DFF, 1024, nullptr, cnt, b, G);
    }
    const size_t gt = (size_t)blockIdx.x * 512 + ltid(), NT = (size_t)gridDim.x * 512;
    const float* nm1 = p.in[3] + D;
    for (size_t e = gt; e < (size_t)2048 * 128; e += NT) {
        const int rr = (int)(e >> 7), c0 = (int)(e & 127) * 8; const int cs = rr >> 10, ch = rr & 1023; float v[8];
#pragma unroll
        for (int i = 0; i < 8; ++i) { const int c = c0 + i; float val = 0.f;
            if ((c >> 7) == (ch >> 7)) { const int m = ((ch & 127) * (c & 127)) & 127; float sn, cn; sincospif((float)m * (1.f / 64.f), &sn, &cn); val = (cs ? sn : cn) * nm1[c] * 0.08838834764831845f; }
            v[i] = val; }
        u32x4 o; o[0] = pk2(v[0], v[1]); o[1] = pk2(v[2], v[3]); o[2] = pk2(v[4], v[5]); o[3] = pk2(v[6], v[7]);
        *(u32x4*)(ws + O_CHD + e * 16) = o;
    }
    for (int ty = 0; ty < 2; ++ty) {
        const int T = ty ? 4112 : 2064, Tp = ty ? TP_S : TP_P, Mp = ty ? MP_S : MP_P; const int rowv = 2 * Tp / 8;
        unsigned char* dst = ws + (ty ? O_DFTS : O_DFTP); const float isq = rsqrtf((float)T), invT = 2.f / (float)T;
        for (size_t e = gt; e < (size_t)Mp * rowv; e += NT) {
            const int k = (int)(e / rowv), kk0 = (int)(e % rowv) * 8; float v[8];
#pragma unroll
            for (int i = 0; i < 8; ++i) { const int kk = kk0 + i; const int issin = kk >= Tp, t = issin ? kk - Tp : kk; float val = 0.f;
                if (k < T && t < T) { const int m = (int)(((long)k * t) % T); float sn, cn; sincospif((float)m * invT, &sn, &cn); val = (issin ? -sn : cn) * isq; }
                v[i] = val; }
            u32x4 o; o[0] = pk2(v[0], v[1]); o[1] = pk2(v[2], v[3]); o[2] = pk2(v[4], v[5]); o[3] = pk2(v[6], v[7]);
            *(u32x4*)(dst + e * 16) = o;
        }
    }
}

__device__ __forceinline__ void ea_load_row(const Params& p, const Ctx& c, int s, int pos, int lane, float (&v)[16]) {
    if (pos < 0 || pos >= c.T) {
#pragma unroll
        for (int i = 0; i < 16; ++i) v[i] = 0.f;
        return; }
    const float* src = pos < NMETA ? p.in[2] + (size_t)pos * D : c.x + ((size_t)s * (c.T - NMETA) + (pos - NMETA)) * D;
#pragma unroll
    for (int j = 0; j < 4; ++j) { const f32x4 t = *(const f32x4*)(src + j * 256 + lane * 4); v[4 * j] = t[0]; v[4 * j + 1] = t[1]; v[4 * j + 2] = t[2]; v[4 * j + 3] = t[3]; }
}
__device__ __forceinline__ void ea_store_row(unsigned char* base, size_t row, int lane, const float (&v)[16]) {
#pragma unroll
    for (int j = 0; j < 4; ++j) { u32x2 o; o[0] = pk2(v[4 * j], v[4 * j + 1]); o[1] = pk2(v[4 * j + 2], v[4 * j + 3]); *(u32x2*)(base + (row * 1024 + j * 256 + lane * 4) * 2) = o; }
}
__device__ __forceinline__ void ea_norm(float (&v)[16], const float (&nw)[16]) {
    float ss = 0.f;
#pragma unroll
    for (int i = 0; i < 16; ++i) ss += v[i] * v[i];
    ss = wave_sum(ss); const float rs = rsqrtf(ss * (1.f / 1024.f) + 1e-6f);
#pragma unroll
    for (int i = 0; i < 16; ++i) v[i] = v[i] * rs * nw[i];
}
__device__ __forceinline__ void phase_mix(const Params& p, const Ctx& c) {
    const int wave = __builtin_amdgcn_readfirstlane(ltid() >> 6), lane = ltid() & 63;
    const int gw = blockIdx.x * 8 + wave, NW = gridDim.x * 8;
    float nw[16];
#pragma unroll
    for (int j = 0; j < 4; ++j) { const f32x4 t = *(const f32x4*)(p.in[3] + j * 256 + lane * 4); nw[4 * j] = t[0]; nw[4 * j + 1] = t[1]; nw[4 * j + 2] = t[2]; nw[4 * j + 3] = t[3]; }
    const int nstrips = c.R / 16, spq = c.T / 16;
    for (int st = gw; st < nstrips; st += NW) {
        const int s = st / spq, pos0 = (st - s * spq) * 16; const size_t row0 = (size_t)st * 16;
        float prev[16], cur[16], nx[16];
        ea_load_row(p, c, s, pos0 - 1, lane, prev); ea_norm(prev, nw);
        ea_load_row(p, c, s, pos0, lane, cur); ea_store_row(slot(p, 0), row0, lane, cur); ea_norm(cur, nw);
        for (int i = 0; i < 16; ++i) {
            ea_load_row(p, c, s, pos0 + i + 1, lane, nx);
            if (i < 15) ea_store_row(slot(p, 0), row0 + i + 1, lane, nx);
            ea_norm(nx, nw);
            float xx[16], o[16];
#pragma unroll
            for (int e = 0; e < 16; ++e) xx[e] = 0.5f * (prev[e] + nx[e]) - cur[e];
            for (int m = 0; m < 6; ++m) {
#pragma unroll
                for (int j = 0; j < 4; ++j) { const f32x4 t = *(const f32x4*)(p.in[6] + m * D + j * 256 + lane * 4);
#pragma unroll
                    for (int e = 0; e < 4; ++e) o[4 * j + e] = cur[4 * j + e] + xx[4 * j + e] * t[e]; }
                ea_store_row(slot(p, 1 + m), row0 + i, lane, o); }
#pragma unroll
            for (int e = 0; e < 16; ++e) { prev[e] = cur[e]; cur[e] = nx[e]; }
        }
    }
}

__device__ __forceinline__ void phase_prescan(const Params& p, const Ctx& c) {
    const int wave = __builtin_amdgcn_readfirstlane(ltid() >> 6), lane = ltid() & 63;
    const int gw = blockIdx.x * 8 + wave, NW = gridDim.x * 8; const int ch0 = lane * 16;
    float kkw[16], kaw[16], rkw[16];
    load16f(p.in[16] + ch0, kkw); load16f(p.in[17] + ch0, kaw); load16f(p.in[18] + ch0, rkw);
    float* bonus = (float*)(p.ws + O_BONUS);
    for (int row = gw; row < c.R; row += NW) {
        const size_t e = (size_t)row * 1024 + ch0;
        float k[16], a0[16], a1[16], r[16];
        load16bf(slot(p, 8), e, k); load16bf(slot(p, 3), e, a0); load16bf(slot(p, 4), e, a1); load16bf(slot(p, 7), e, r);
        float kk[16], n2 = 0.f;
#pragma unroll
        for (int i = 0; i < 16; ++i) { kk[i] = k[i] * kkw[i]; n2 += kk[i] * kk[i]; }
        n2 += __shfl_xor(n2, 1); n2 += __shfl_xor(n2, 2);
        const float inv = 1.f / fmaxf(sqrtf(n2), 1e-12f);
        float kd0[16], kd1[16], bon = 0.f;
#pragma unroll
        for (int i = 0; i < 16; ++i) { kk[i] *= inv; kd0[i] = k[i] * (1.f + (a0[i] - 1.f) * kaw[i]); kd1[i] = k[i] * (1.f + (a1[i] - 1.f) * kaw[i]);
            bon += r[i] * (kd0[i] + kd1[i]) * rkw[i]; a0[i] *= kk[i]; a1[i] *= kk[i]; }
        bon += __shfl_xor(bon, 1); bon += __shfl_xor(bon, 2);
        if ((lane & 3) == 0) bonus[(size_t)row * 16 + (lane >> 2)] = bon;
        store16bf(slot(p, 8), e, kk); store16bf(slot(p, 3), e, a0); store16bf(slot(p, 4), e, a1);
        store16bf(slot(p, 6), e, kd0); store16bf(slot(p, 10), e, kd1);
    }
}

__device__ __forceinline__ void scan_ld(const unsigned char* Kkb, const unsigned char* Ngb, const unsigned char* Bdb, const unsigned char* Kdb, const unsigned char* Rb, const unsigned char* Vb,
                                        size_t ro, int lane, float (&x)[6]) {
    const size_t o = ro + lane * 2;
    x[0] = __uint_as_float(((unsigned)*(const bf16_t*)(Kkb + o)) << 16); x[1] = __uint_as_float(((unsigned)*(const bf16_t*)(Ngb + o)) << 16);
    x[2] = __uint_as_float(((unsigned)*(const bf16_t*)(Bdb + o)) << 16); x[3] = __uint_as_float(((unsigned)*(const bf16_t*)(Kdb + o)) << 16);
    x[4] = __uint_as_float(((unsigned)*(const bf16_t*)(Rb + o)) << 16); x[5] = __uint_as_float(((unsigned)*(const bf16_t*)(Vb + o)) << 16);
}
__device__ __forceinline__ void phase_scan(LAS unsigned char* lds, const Params& p, const Ctx& c) {
    const int tid = ltid(); const int wave = __builtin_amdgcn_readfirstlane(tid >> 6), lane = tid & 63;
    const int nscan = c.nseq * 32;
    LAS float* wb = (LAS float*)(lds + wave * 4096);
    for (int q = blockIdx.x + gridDim.x * wave; q < nscan; q += gridDim.x * 8) {
        const int dir = q & 1, hh = (q >> 1) & 15, s = q >> 5;
        const size_t e0 = (size_t)s * c.T * 1024 + hh * 64;
        const unsigned char* Rb = slot(p, 7) + e0 * 2; const unsigned char* Kkb = slot(p, 8) + e0 * 2; const unsigned char* Vb = slot(p, 9) + e0 * 2;
        const unsigned char* Ngb = slot(p, 1 + dir) + e0 * 2; const unsigned char* Bdb = slot(p, 3 + dir) + e0 * 2;
        const unsigned char* Kdb = slot(p, dir ? 10 : 6) + e0 * 2; unsigned char* Ob = slot(p, 11 + dir) + e0 * 2;
        float S[64];
#pragma unroll
        for (int j = 0; j < 64; ++j) S[j] = 0.f;
        float x[6];
        scan_ld(Kkb, Ngb, Bdb, Kdb, Rb, Vb, (size_t)(dir ? c.T - 1 : 0) * 2048, lane, x);
        for (int t = 0; t < c.T; ++t) {
            const int pos = dir ? c.T - 1 - t : t; const size_t ro = (size_t)pos * 2048;
            LAS float* sb = wb + (t & 1) * 512;
            sb[lane] = x[0]; sb[64 + lane] = x[1]; sb[128 + lane] = x[2]; sb[192 + lane] = x[3]; sb[256 + lane] = x[4];
            const float vi = x[5];
            { const int tn = t + 1 < c.T ? t + 1 : t; const int posn = dir ? c.T - 1 - tn : tn; scan_ld(Kkb, Ngb, Bdb, Kdb, Rb, Vb, (size_t)posn * 2048, lane, x); }
            const LAS f32x4* qk = (const LAS f32x4*)sb; const LAS f32x4* qg = qk + 16; const LAS f32x4* qb = qk + 32; const LAS f32x4* qd = qk + 48; const LAS f32x4* qr = qk + 64;
            float s0 = 0.f, s1 = 0.f;
#pragma unroll
            for (int j = 0; j < 16; ++j) { const f32x4 k4 = qk[j]; s0 = fmaf(S[4 * j], k4[0], s0); s1 = fmaf(S[4 * j + 1], k4[1], s1); s0 = fmaf(S[4 * j + 2], k4[2], s0); s1 = fmaf(S[4 * j + 3], k4[3], s1); }
            const float sa = -(s0 + s1);
            float o0 = 0.f, o1 = 0.f;
#pragma unroll
            for (int j = 0; j < 16; ++j) { const f32x4 g4 = qg[j], b4 = qb[j], d4 = qd[j], r4 = qr[j];
#pragma unroll
                for (int e = 0; e < 4; ++e) { float xx = fmaf(S[4 * j + e], g4[e], S[4 * j + e]); xx = fmaf(sa, b4[e], xx); xx = fmaf(vi, d4[e], xx); S[4 * j + e] = xx; }
                o0 = fmaf(S[4 * j], r4[0], o0); o1 = fmaf(S[4 * j + 1], r4[1], o1); o0 = fmaf(S[4 * j + 2], r4[2], o0); o1 = fmaf(S[4 * j + 3], r4[3], o1); }
            *(bf16_t*)(Ob + ro + lane * 2) = (bf16_t)(pk2(o0 + o1, 0.f) & 0xffffu);
        }
    }
}

__device__ __forceinline__ void phase_postscan(const Params& p, const Ctx& c) {
    const int wave = __builtin_amdgcn_readfirstlane(ltid() >> 6), lane = ltid() & 63;
    const int gw = blockIdx.x * 8 + wave, NW = gridDim.x * 8; const int ch0 = lane * 16;
    float gw_[16], gb_[16]; load16f(p.in[19] + ch0, gw_); load16f(p.in[20] + ch0, gb_);
    const float* bonus = (const float*)(p.ws + O_BONUS);
    for (int row = gw; row < c.R; row += NW) {
        const size_t e = (size_t)row * 1024 + ch0;
        float of[16], ob[16], v[16], g[16];
        load16bf(slot(p, 11), e, of); load16bf(slot(p, 12), e, ob); load16bf(slot(p, 9), e, v); load16bf(slot(p, 5), e, g);
        float sum = 0.f;
#pragma unroll
        for (int i = 0; i < 16; ++i) { of[i] += ob[i]; sum += of[i]; }
        sum += __shfl_xor(sum, 1); sum += __shfl_xor(sum, 2); const float mean = sum * (1.f / 64.f);
        float var = 0.f;
#pragma unroll
        for (int i = 0; i < 16; ++i) { of[i] -= mean; var += of[i] * of[i]; }
        var += __shfl_xor(var, 1); var += __shfl_xor(var, 2); const float rs = rsqrtf(var * (1.f / 64.f) + 64e-5f);
        const float bon = bonus[(size_t)row * 16 + (lane >> 2)];
#pragma unroll
        for (int i = 0; i < 16; ++i) of[i] = (of[i] * rs * gw_[i] + gb_[i] + bon * v[i]) * g[i];
        store16bf(slot(p, 1), e, of);
    }
}

__device__ __forceinline__ void phase_glu(const Params& p, const Ctx& c, int layer) {
    const size_t gt = (size_t)blockIdx.x * 512 + ltid(), NT = (size_t)gridDim.x * 512;
    const unsigned char* U = slot(p, 1); unsigned char* Aout = slot(p, 7);
    const float* cw = p.in[24] + (size_t)layer * 3 * DFF; const float* cb = p.in[25] + (size_t)layer * DFF;
    const size_t nitem = (size_t)c.R * 352;
    for (size_t it = gt; it < nitem; it += NT) {
        const int row = (int)(it / 352), cc = (int)(it % 352) * 8; const int pos = row % c.T;
        const unsigned char* ur = U + (size_t)row * 5632 * 2 + cc * 2;
        const u32x4 z = (u32x4){0u, 0u, 0u, 0u};
        const u32x4 pm = pos > 0 ? *(const u32x4*)(ur - 5632 * 2) : z, pc = *(const u32x4*)ur, pp = pos < c.T - 1 ? *(const u32x4*)(ur + 5632 * 2) : z;
        const u32x4 ln = *(const u32x4*)(ur + DFF * 2);
        float w0[8], w1[8], w2[8], bb[8];
#pragma unroll
        for (int h = 0; h < 2; ++h) { const f32x4 a = *(const f32x4*)(cw + cc + 4 * h), b = *(const f32x4*)(cw + DFF + cc + 4 * h), d = *(const f32x4*)(cw + 2 * DFF + cc + 4 * h), e = *(const f32x4*)(cb + cc + 4 * h);
#pragma unroll
            for (int i = 0; i < 4; ++i) { w0[4 * h + i] = a[i]; w1[4 * h + i] = b[i]; w2[4 * h + i] = d[i]; bb[4 * h + i] = e[i]; } }
        u32x4 o;
#pragma unroll
        for (int i = 0; i < 4; ++i) {
            const float c0 = bflo(pm[i]) * w0[2 * i] + bflo(pc[i]) * w1[2 * i] + bflo(pp[i]) * w2[2 * i] + bb[2 * i];
            const float c1 = bfhi(pm[i]) * w0[2 * i + 1] + bfhi(pc[i]) * w1[2 * i + 1] + bfhi(pp[i]) * w2[2 * i + 1] + bb[2 * i + 1];
            o[i] = pk2(c0 * sigmoidf_(c0) * bflo(ln[i]), c1 * sigmoidf_(c1) * bfhi(ln[i])); }
        *(u32x4*)(Aout + ((size_t)row * DFF + cc) * 2) = o;
    }
}

__device__ __forceinline__ void phase_final(const Params& p, const Ctx& c) {
    const int wave = __builtin_amdgcn_readfirstlane(ltid() >> 6), lane = ltid() & 63;
    const int gw = blockIdx.x * 8 + wave, NW = gridDim.x * 8; const int ch0 = lane * 16;
    float nf[16]; load16f(p.in[5] + ch0, nf);
    const int To = c.T - NMETA, nrow = c.nseq * To;
    for (int q = gw; q < nrow; q += NW) {
        const int s = q / To, po = q - s * To; const size_t row = (size_t)s * c.T + NMETA + po;
        float h[16]; load16bf(slot(p, 0), row * 1024 + ch0, h);
        float ss = 0.f;
#pragma unroll
        for (int i = 0; i < 16; ++i) ss += h[i] * h[i];
        ss = wave_sum(ss); const float rs = rsqrtf(ss * (1.f / 1024.f) + 1e-6f);
        float* dst = c.y + (size_t)q * 1024 + ch0;
#pragma unroll
        for (int j = 0; j < 4; ++j) { f32x4 o; o[0] = h[4 * j] * rs * nf[4 * j]; o[1] = h[4 * j + 1] * rs * nf[4 * j + 1]; o[2] = h[4 * j + 2] * rs * nf[4 * j + 2]; o[3] = h[4 * j + 3] * rs * nf[4 * j + 3]; ((f32x4*)dst)[j] = o; }
    }
}

constexpr int NSUB = 20, NPHASE = 1 + 4 * NSUB;

__device__ __forceinline__ void phase_rstd(const Params& p, int which) {
    const float* part = (const float*)(p.ws + O_SS) + (size_t)which * 16 * RP; float* rs = (float*)(p.ws + O_RSTD) + (size_t)which * RP;
    for (int r = blockIdx.x * 512 + ltid(); r < RP; r += gridDim.x * 512) rs[r] = rstd16(part, r);
}

__device__ __forceinline__ void run_phase(LAS unsigned char* lds, const Params& p, int ph) {
    if (ph == 0) { prep_phase(lds, p); return; }
    const int g = (ph - 1) / NSUB, sp = (ph - 1) % NSUB; const Ctx c = get_ctx(p, g);
    GemmPh P; P.G = gridDim.x; P.c = blockIdx.x; P.A = nullptr; P.B = nullptr; P.O = nullptr; P.ss = nullptr; P.ssin = nullptr; P.ldo = 0; P.kind = -1;
    float* ssb = (float*)(p.ws + O_SS); const float* rsb = (const float*)(p.ws + O_RSTD);
    switch (sp) {
    case 1: P.kind = K_L1; P.nunits = MT * 15; P.lda = 1024; P.ldb = 1024; P.K = 1024; break;
    case 2: P.kind = K_L2; P.nunits = MT * 20; P.lda = 256; P.ldb = 256; P.K = 256; break;
    case 6: P.kind = K_RES; P.nunits = MT * 4; P.lda = 1024; P.ldb = 1024; P.K = 1024; P.A = (const char*)slot(p, 1); P.B = (const char*)p.ws + O_WO; P.O = slot(p, 0); P.ss = ssb; break;
    case 8: case 16: { const int l = sp == 8 ? 0 : 1; P.kind = K_U; P.nunits = MT * 22; P.lda = 1024; P.ldb = 1024; P.K = 1024; P.A = (const char*)slot(p, 0); P.B = (const char*)p.ws + O_WIN + (size_t)l * 5632 * 1024 * 2;
        P.O = slot(p, 1); P.ssin = rsb + (l ? 2 * RP : 0); } break;
    case 10: case 18: { const int l = sp == 10 ? 0 : 1; P.kind = K_RES; P.nunits = MT * 4; P.lda = DFF; P.ldb = DFF; P.K = DFF; P.A = (const char*)slot(p, 7); P.B = (const char*)p.ws + O_WOUT + (size_t)l * 1024 * DFF * 2;
        P.O = slot(p, 0); P.ss = l ? nullptr : ssb + 16 * RP; } break;
    case 12: P.kind = K_CH; P.nunits = MT * 8; P.lda = 1024; P.ldb = 1024; P.K = 256; P.A = (const char*)p.ws + O_CHD; P.B = (const char*)slot(p, 0); P.O = slot(p, 1); P.ssin = rsb + RP; break;
    case 13: P.kind = K_TD; P.nunits = c.nseq * c.tm * 4; P.lda = 2 * c.Tp; P.ldb = 2 * c.Tp; P.K = 2 * c.Tp; P.A = (const char*)p.ws + (g < 2 ? O_DFTP : O_DFTS); P.B = (const char*)slot(p, 1); P.O = slot(p, 4); break;
    case 14: P.kind = K_RES; P.nunits = MT * 4; P.lda = 1024; P.ldb = 1024; P.K = 1024; P.A = (const char*)slot(p, 4); P.B = (const char*)p.ws + O_WF; P.O = slot(p, 0); P.ss = ssb + 2 * 16 * RP; break;
    default: break;
    }
    if (P.kind >= 0) {
        switch (P.kind) {
        case K_L1: gemm_phase<K_L1>(lds, P, p, c); break;
        case K_L2: gemm_phase<K_L2>(lds, P, p, c); break;
        case K_RES: gemm_phase<K_RES>(lds, P, p, c); break;
        case K_U: gemm_phase<K_U>(lds, P, p, c); break;
        case K_CH: gemm_phase<K_CH>(lds, P, p, c); break;
        default: gemm_phase<K_TD>(lds, P, p, c); break;
        }
        if (sp == 12) {
            const int padw = c.Tp - c.T; const size_t nrows = (size_t)c.nseq * 2048, n = nrows * padw; bf16_t* yT = (bf16_t*)slot(p, 1);
            for (size_t i = (size_t)blockIdx.x * 512 + ltid(); i < n; i += (size_t)gridDim.x * 512) { const size_t rr = i / padw; const int cc = (int)(i - rr * padw); yT[rr * c.Tp + c.T + cc] = 0; } }
        return;
    }
    if (sp == 0) phase_mix(p, c);
    else if (sp == 3) phase_prescan(p, c);
    else if (sp == 4) phase_scan(lds, p, c);
    else if (sp == 5) phase_postscan(p, c);
    else if (sp == 7 || sp == 11 || sp == 15) phase_rstd(p, sp == 7 ? 0 : sp == 11 ? 1 : 2);
    else if (sp == 9 || sp == 17) phase_glu(p, c, sp == 9 ? 0 : 1);
    else phase_final(p, c);
}

__global__ void __launch_bounds__(512, 2) mega(Params p, int ph_lo, int ph_hi) {
    extern __shared__ __attribute__((aligned(16))) unsigned char shm[];
    LAS unsigned char* lds = (LAS unsigned char*)shm;
    cg::grid_group grid = cg::this_grid();
    for (int ph = ph_lo; ph < ph_hi; ++ph) {
        if (ph > ph_lo) grid.sync();
        run_phase(lds, p, ph);
    }
}

extern "C" void kernel_launch(void* const* d_in, const int* in_sizes, int n_in, void* d_out, int out_size, void* d_ws, size_t ws_size, hipStream_t stream) {
    static int grid = 0;
    if (grid == 0) {
        if (n_in != 27 || ws_size < WS_END) { fprintf(stderr, "kernel_launch: need 27 inputs and %zu B of workspace (got %d, %zu)\n", (size_t)WS_END, n_in, ws_size); grid = -1; return; }
        int dev = 0, cus = 0, per_cu = 0;
        hipGetDevice(&dev); hipDeviceGetAttribute(&cus, hipDeviceAttributeMultiprocessorCount, dev);
        if (hipFuncSetAttribute((const void*)mega, hipFuncAttributeMaxDynamicSharedMemorySize, STAGE_BYTES) != hipSuccess) { fprintf(stderr, "hipFuncSetAttribute failed\n"); grid = -1; return; }
        hipOccupancyMaxActiveBlocksPerMultiprocessor(&per_cu, (const void*)mega, 512, STAGE_BYTES);
        if (per_cu < 1) per_cu = 1;
        (void)hipGetLastError();
        grid = cus * 1;
    }
    if (grid < 0) return;
    Params p{};
    for (int i = 0; i < 27; ++i) p.in[i] = (const float*)d_in[i];
    p.out = (float*)d_out; p.ws = (unsigned char*)d_ws;
#if MK_PER_PHASE
    for (int ph = 0; ph < NPHASE; ++ph) hipLaunchKernelGGL(mega, dim3(grid), dim3(512), STAGE_BYTES, stream, p, ph, ph + 1);
#else
    int lo = 0, hi = NPHASE;
    void* args[] = {&p, &lo, &hi};
    hipError_t e = hipLaunchCooperativeKernel((const void*)mega, dim3(grid), dim3(512), args, STAGE_BYTES, stream);
    if (e != hipSuccess) fprintf(stderr, "cooperative launch failed: %s (grid %d)\n", hipGetErrorString(e), grid);
#endif
}
```

```cpp
#include <hip/hip_runtime.h>
#include <hip/hip_cooperative_groups.h>
#include <cstdio>
namespace cg = cooperative_groups;

#ifndef MK_PER_PHASE
#define MK_PER_PHASE 0
#endif

#define LAS __attribute__((address_space(3)))
typedef unsigned short bf16_t;
typedef short bf16x8 __attribute__((ext_vector_type(8)));
typedef float f32x4 __attribute__((ext_vector_type(4)));
typedef unsigned u32x4 __attribute__((ext_vector_type(4)));
typedef unsigned u32x2 __attribute__((ext_vector_type(2)));
typedef float f32x2 __attribute__((ext_vector_type(2)));
typedef const __attribute__((address_space(4))) unsigned* cptr;

constexpr int D = 1024, DFF = 2816, NMETA = 16;
constexpr int RP = 33024;
constexpr int MT = RP / 256;
constexpr size_t SLOT = (size_t)RP * D * 2;
constexpr int NSLOT = 13;
constexpr size_t O_WRKV = NSLOT * SLOT;
constexpr size_t O_G1 = O_WRKV + (size_t)3072 * 1024 * 2;
constexpr size_t O_W1 = O_G1 + (size_t)256 * 1024 * 2;
constexpr size_t O_A1 = O_W1 + (size_t)256 * 1024 * 2;
constexpr size_t O_L2 = O_A1 + (size_t)256 * 1024 * 2;
constexpr size_t O_G2 = O_L2 + (size_t)4096 * 256 * 2;
constexpr size_t O_WO = O_G2 + (size_t)1024 * 256 * 2;
constexpr size_t O_WF = O_WO + (size_t)1024 * 1024 * 2;
constexpr size_t O_WIN = O_WF + (size_t)1024 * 1024 * 2;
constexpr size_t O_WOUT = O_WIN + (size_t)2 * 5632 * 1024 * 2;
constexpr size_t O_CHD = O_WOUT + (size_t)2 * 1024 * 2816 * 2;
constexpr int TP_P = 2112, TP_S = 4160, MP_P = 2304, MP_S = 4352;
constexpr size_t O_DFTP = O_CHD + (size_t)2048 * 1024 * 2;
constexpr size_t O_DFTS = O_DFTP + (size_t)MP_P * 2 * TP_P * 2;
constexpr size_t O_SS = O_DFTS + (size_t)MP_S * 2 * TP_S * 2;
constexpr size_t O_RSTD = O_SS + (size_t)3 * 16 * RP * 4;
constexpr size_t O_BONUS = O_RSTD + (size_t)3 * RP * 4;
constexpr size_t O_BAR = O_BONUS + (size_t)RP * 16 * 4;
constexpr size_t WS_END = O_BAR + 16384;

struct Params { const float* in[27]; float* out; unsigned char* ws; };
struct Ctx { int g, T, nseq, R, Tp, tm; const float* x; float* y; };

__device__ __forceinline__ Ctx get_ctx(const Params& p, int g) {
    Ctx c; c.g = g;
    if (g < 2) { c.T = 2064; c.nseq = 16; c.Tp = TP_P; c.tm = 9; c.x = p.in[0] + (size_t)g * 16 * 2048 * 1024; c.y = p.out + (size_t)g * 16 * 2048 * 1024; }
    else { c.T = 4112; c.nseq = 8; c.Tp = TP_S; c.tm = 17; c.x = p.in[1] + (size_t)(g - 2) * 8 * 4096 * 1024; c.y = p.out + (size_t)32 * 2048 * 1024 + (size_t)(g - 2) * 8 * 4096 * 1024; }
    c.R = c.nseq * c.T; return c;
}
__device__ __forceinline__ int ltid() { int t = threadIdx.x; asm volatile("" : "+v"(t)); return t; }
__device__ __forceinline__ unsigned char* slot(const Params& p, int i) { return p.ws + (size_t)i * SLOT; }

__device__ __forceinline__ unsigned pk2(float lo, float hi) { unsigned r; asm volatile("v_cvt_pk_bf16_f32 %0, %1, %2" : "=v"(r) : "v"(lo), "v"(hi)); return r; }
__device__ __forceinline__ float bflo(unsigned u) { return __uint_as_float(u << 16); }
__device__ __forceinline__ float bfhi(unsigned u) { return __uint_as_float(u & 0xffff0000u); }
__device__ __forceinline__ float wave_sum(float v) {
#pragma unroll
    for (int o = 1; o < 64; o <<= 1) v += __shfl_xor(v, o);
    return v;
}
__device__ __forceinline__ float sigmoidf_(float x) { return 1.f / (1.f + __expf(-x)); }
__device__ __forceinline__ void unpack16(const u32x4 a, const u32x4 b, float (&v)[16]) {
#pragma unroll
    for (int i = 0; i < 4; ++i) { v[2 * i] = bflo(a[i]); v[2 * i + 1] = bfhi(a[i]); v[8 + 2 * i] = bflo(b[i]); v[8 + 2 * i + 1] = bfhi(b[i]); }
}
__device__ __forceinline__ void load16bf(const unsigned char* base, size_t elem, float (&v)[16]) {
    const u32x4* q = (const u32x4*)(base + elem * 2); unpack16(q[0], q[1], v);
}
__device__ __forceinline__ void store16bf(unsigned char* base, size_t elem, const float (&v)[16]) {
    u32x4 a, b;
#pragma unroll
    for (int i = 0; i < 4; ++i) { a[i] = pk2(v[2 * i], v[2 * i + 1]); b[i] = pk2(v[8 + 2 * i], v[8 + 2 * i + 1]); }
    u32x4* q = (u32x4*)(base + elem * 2); q[0] = a; q[1] = b;
}
__device__ __forceinline__ void load16f(const float* src, float (&v)[16]) {
#pragma unroll
    for (int j = 0; j < 4; ++j) { f32x4 t = ((const f32x4*)src)[j]; v[4 * j] = t[0]; v[4 * j + 1] = t[1]; v[4 * j + 2] = t[2]; v[4 * j + 3] = t[3]; }
}

constexpr int BM = 256, BK = 64, HALF = 128, HTB = HALF * BK * 2, STAGE_BYTES = 8 * HTB;
__device__ __forceinline__ int lds_byte(int r, int c) { const int st = (r >> 4) * 2 + (c >> 5), rr = r & 15, cc = c & 31, ob = rr * 64 + cc * 2; return st * 1024 + (ob ^ (((ob >> 9) & 1) << 5)); }
__device__ __forceinline__ void stage_rc(int b, int& R, int& C) { const int st = b / 1024, sb = b % 1024, swz = sb ^ (((sb >> 9) & 1) << 5); R = (st >> 1) * 16 + swz / 64; C = (st & 1) * 32 + (swz % 64) / 2; }
__device__ __forceinline__ int perm32(int rho) { const int n = rho >> 4, i = rho & 15; return 8 * (i >> 2) + 4 * n + (i & 3); }

enum { K_L1 = 0, K_L2, K_RES, K_U, K_CH, K_TD };
struct Unit { const char* A; const char* B; int pm, pn, job, s; };
struct GemmPh {
    int kind, nunits, lda, ldb, K, G, c;
    const char* A; const char* B;
    unsigned char* O; float* ss; const float* ssin; int ldo;
};

__device__ __forceinline__ bool next_unit(const GemmPh& P, const Params& p, const Ctx& cx, int i, Unit& u) {
    const long Lg = (long)i * P.G + P.c; if (Lg >= P.nunits) return false;
    const int L = (int)Lg; u.s = 0; u.job = 0;
    if (P.kind == K_L1) {
        const int pm = L / 15, jn = L % 15; int job, pn;
        if (jn < 12) { job = jn >> 2; pn = jn & 3; } else { job = 3 + (jn - 12); pn = 0; }
        const int aslot = job == 0 ? 1 : job == 1 ? 3 : job == 2 ? 4 : job == 3 ? 6 : job == 4 ? 2 : 5;
        u.A = (const char*)slot(p, aslot) + (size_t)pm * 256 * 2048;
        const size_t boff = job < 3 ? O_WRKV + ((size_t)job * 1024 + pn * 256) * 2048 : job == 3 ? O_G1 : job == 4 ? O_W1 : O_A1;
        u.B = (const char*)p.ws + boff; u.pm = pm; u.pn = pn; u.job = job;
    } else if (P.kind == K_L2) {
        const int pm = L / 20, jn = L % 20; const int job = jn < 16 ? 0 : 1, pn = jn < 16 ? jn : jn - 16;
        u.A = (const char*)slot(p, 10) + (job == 0 ? (size_t)RP * 512 : 0) + (size_t)pm * 256 * 512;
        u.B = (const char*)p.ws + (job == 0 ? O_L2 : O_G2) + (size_t)pn * 256 * 512; u.pm = pm; u.pn = pn; u.job = job;
    } else if (P.kind == K_RES) {
        const int pm = L >> 2, pn = L & 3;
        u.A = P.A + (size_t)pm * 256 * P.lda * 2; u.B = P.B + (size_t)pn * 256 * P.ldb * 2; u.pm = pm; u.pn = pn;
    } else if (P.kind == K_U) {
        const int pm = L / 22, pn = L % 22;
        u.A = P.A + (size_t)pm * 256 * 2048; u.B = P.B + (size_t)pn * 256 * 2048; u.pm = pm; u.pn = pn;
    } else if (P.kind == K_CH) {
        const int pn = L >> 3, pm = L & 7;
        u.A = P.A + (size_t)pm * 256 * 2048 + (pm & 3) * 512; u.B = P.B + (size_t)pn * 256 * 2048 + (pm & 3) * 512; u.pm = pm; u.pn = pn;
    } else {
        const int per = cx.tm * 4, s = L / per, rem = L % per, pm = rem >> 2, pn = rem & 3;
        u.A = P.A + (size_t)pm * 256 * P.lda * 2; u.B = P.B + ((size_t)s * 1024 + pn * 256) * P.ldb * 2; u.pm = pm; u.pn = pn; u.s = s;
    }
    return true;
}

__device__ __forceinline__ void st8(unsigned char* ptr, const f32x4 a, const f32x4 b) {
    u32x4 o; o[0] = pk2(a[0], a[1]); o[1] = pk2(a[2], a[3]); o[2] = pk2(b[0], b[1]); o[3] = pk2(b[2], b[3]); *(u32x4*)ptr = o;
}
__device__ __forceinline__ float decaymap(float w) {
    const float e = 0.6065306597f / (1.f + __expf(-w)); return __expf(-e) - 1.f;
}
__device__ __forceinline__ float act_apply(int act, float x) {
    if (act == 1) return 1.f / (1.f + __expf(-x));
    if (act == 2) return 1.f - 2.f / (__expf(2.f * x) + 1.f);
    if (act == 3) return decaymap(x);
    return x;
}

__device__ __forceinline__ float rstd16(const float* ss, int r) {
    float s = 0.f;
#pragma unroll
    for (int i = 0; i < 16; ++i) s += ss[(size_t)i * RP + r];
    return rsqrtf(s * (1.f / 1024.f) + 1e-6f);
}
__device__ __forceinline__ void epilogue(const GemmPh& P, const Params& p, const Ctx& cx, const f32x4 (&acc)[2][2][4][2], const Unit& u, int wr, int wc, int fr, int fq) {
    const int rbase = u.pm * 256 + wr * 64 + fr, cbase = u.pn * 256 + wc * 32 + 8 * fq;
    if (P.kind == K_L1 || P.kind == K_L2) {
        unsigned char* O; int ldo = 1024, coff = 0, act = 0, cvalid = 1 << 30; const float* bias = nullptr;
        if (P.kind == K_L1) {
            if (u.job < 3) { O = slot(p, 7 + u.job); }
            else if (u.job == 3) { O = slot(p, 10); ldo = 256; act = 1; }
            else if (u.job == 4) { O = slot(p, 10) + (size_t)RP * 512; ldo = 256; act = 2; cvalid = 128; }
            else { O = slot(p, 10) + (size_t)RP * 512; ldo = 256; coff = 128; cvalid = 128; }
        } else {
            if (u.job == 1) { O = slot(p, 5); }
            else { const int cb = u.pn >> 2; O = slot(p, 1 + cb); bias = (cb < 2 ? p.in[8] : p.in[11]) + (cb & 1) * 1024 - cb * 1024; coff = -cb * 1024; act = cb < 2 ? 3 : 1; }
        }
        f32x4 bv[2][2];
#pragma unroll
        for (int bj = 0; bj < 2; ++bj)
#pragma unroll
            for (int n = 0; n < 2; ++n) bv[bj][n] = bias ? *(const f32x4*)(bias + cbase + bj * 128 + 4 * n) : (f32x4){0.f, 0.f, 0.f, 0.f};
#pragma unroll
        for (int ai = 0; ai < 2; ++ai)
#pragma unroll
            for (int m = 0; m < 4; ++m) { if ((m & 1) == 0) __builtin_amdgcn_sched_barrier(0);
#pragma unroll
                for (int bj = 0; bj < 2; ++bj) { const int r = rbase + ai * 128 + m * 16; const int c0 = cbase + bj * 128;
                    f32x4 v0 = acc[ai][bj][m][0] + bv[bj][0], v1 = acc[ai][bj][m][1] + bv[bj][1];
#pragma unroll
                    for (int i = 0; i < 4; ++i) { v0[i] = act_apply(act, v0[i]); v1[i] = act_apply(act, v1[i]); }
                    if (c0 < cvalid) st8(O + ((size_t)r * ldo + coff + c0) * 2, v0, v1); } }
    } else if (P.kind == K_RES) {
        unsigned char* H = P.O;
#pragma unroll
        for (int ai = 0; ai < 2; ++ai)
#pragma unroll
            for (int m = 0; m < 4; ++m) { if ((m & 1) == 0) __builtin_amdgcn_sched_barrier(0); const int r = rbase + ai * 128 + m * 16; float sq = 0.f;
#pragma unroll
                for (int bj = 0; bj < 2; ++bj) { unsigned char* ptr = H + ((size_t)r * 1024 + cbase + bj * 128) * 2;
                    const u32x4 old = *(const u32x4*)ptr; u32x4 o; const f32x4 a0 = acc[ai][bj][m][0], a1 = acc[ai][bj][m][1];
                    o[0] = pk2(bflo(old[0]) + a0[0], bfhi(old[0]) + a0[1]); o[1] = pk2(bflo(old[1]) + a0[2], bfhi(old[1]) + a0[3]);
                    o[2] = pk2(bflo(old[2]) + a1[0], bfhi(old[2]) + a1[1]); o[3] = pk2(bflo(old[3]) + a1[2], bfhi(old[3]) + a1[3]);
#pragma unroll
                    for (int i = 0; i < 4; ++i) { const float rl = bflo(o[i]), rh = bfhi(o[i]); sq += rl * rl + rh * rh; }
                    *(u32x4*)ptr = o; }
                if (P.ss) { sq += __shfl_xor(sq, 16); sq += __shfl_xor(sq, 32); if (fq == 0) P.ss[(size_t)(u.pn * 4 + wc) * RP + r] = sq; } }
    } else if (P.kind == K_U) {
#pragma unroll
        for (int ai = 0; ai < 2; ++ai)
#pragma unroll
            for (int m = 0; m < 4; ++m) { if ((m & 1) == 0) __builtin_amdgcn_sched_barrier(0); const int r = rbase + ai * 128 + m * 16; const float rs = P.ssin[r];
#pragma unroll
                for (int bj = 0; bj < 2; ++bj) st8(P.O + ((size_t)r * 5632 + cbase + bj * 128) * 2, acc[ai][bj][m][0] * rs, acc[ai][bj][m][1] * rs); }
    } else if (P.kind == K_CH) {
#pragma unroll
        for (int bj = 0; bj < 2; ++bj) { const int n0 = cbase + bj * 128; const bool ok = n0 < cx.R; const int nn = ok ? n0 : 0;
            const int s = nn / cx.T, t = nn - s * cx.T; f32x4 r0, r1;
#pragma unroll
            for (int i = 0; i < 4; ++i) { r0[i] = P.ssin[nn + i]; r1[i] = P.ssin[nn + 4 + i]; }
#pragma unroll
            for (int ai = 0; ai < 2; ++ai)
#pragma unroll
                for (int m = 0; m < 4; ++m) { if ((m & 1) == 0) __builtin_amdgcn_sched_barrier(0); const int rr = rbase + ai * 128 + m * 16; const int cs = rr >> 10, ch = rr & 1023;
                    if (ok) st8(P.O + ((((size_t)s * 1024 + ch) * 2 + cs) * cx.Tp + t) * 2, acc[ai][bj][m][0] * r0, acc[ai][bj][m][1] * r1); } }
    } else {
#pragma unroll
        for (int ai = 0; ai < 2; ++ai)
#pragma unroll
            for (int m = 0; m < 4; ++m) { if ((m & 1) == 0) __builtin_amdgcn_sched_barrier(0); const int k = rbase + ai * 128 + m * 16; const size_t row = (size_t)u.s * cx.T + k;
#pragma unroll
                for (int bj = 0; bj < 2; ++bj) if (k < cx.T) st8(P.O + (row * 1024 + cbase + bj * 128) * 2, acc[ai][bj][m][0], acc[ai][bj][m][1]); }
    }
}

template <int KIND> __device__ __forceinline__ void gemm_phase(LAS unsigned char* lds, GemmPh P, const Params& p, const Ctx& cx) {
    P.kind = KIND;
    const int tid = ltid(), wid = __builtin_amdgcn_readfirstlane(tid >> 6), lane = tid & 63, wr = wid >> 2, wc = wid & 3, fr = lane & 15, fq = lane >> 4;
    const int nt = P.K / BK;
    unsigned voffA[2], voffB[2];
#pragma unroll
    for (int i = 0; i < 2; ++i) { int R, C; stage_rc(tid * 16 + i * 8192, R, C); const int Rb = (R & ~31) + perm32(R & 31);
        voffA[i] = (unsigned)(R * P.lda + C) * 2u; voffB[i] = (unsigned)(Rb * P.ldb + C) * 2u; }
    const size_t kstep = (size_t)(BK * 2);
    const size_t hstepA = (size_t)HALF * P.lda * 2, hstepB = (size_t)HALF * P.ldb * 2;
    const unsigned ldsw = (unsigned)wid * 1024u;
    const int aoff = lds_byte(wr * 64 + fr, fq * 8), boff = lds_byte(wc * 32 + fr, fq * 8);
#define PG8_SA(b, h) (((b) * 2 + (h)) * HTB)
#define PG8_SB(b, h) ((4 + (b) * 2 + (h)) * HTB)
#define PG8_STAGE(bufoff, gbase, voff) do { _Pragma("unroll") for (int _i = 0; _i < 2; ++_i) \
        __builtin_amdgcn_global_load_lds((const unsigned*)((const char*)(gbase) + (voff)[_i]), (LAS unsigned*)(lds + (bufoff) + ldsw + _i * 8192), 16, 0, 0); } while (0)
#define PG8_LDA(dst, b, h) do { _Pragma("unroll") for (int m = 0; m < 4; ++m) _Pragma("unroll") for (int k = 0; k < 2; ++k) dst[m][k] = *(const LAS bf16x8*)(lds + PG8_SA(b, h) + aoff + m * 2048 + k * 1024); } while (0)
#define PG8_LDB(dst, b, h) do { _Pragma("unroll") for (int n = 0; n < 2; ++n) _Pragma("unroll") for (int k = 0; k < 2; ++k) dst[n][k] = *(const LAS bf16x8*)(lds + PG8_SB(b, h) + boff + n * 2048 + k * 1024); } while (0)
#define PG8_MMA(ai, bj, At, Bt) do { __builtin_amdgcn_s_setprio(1); _Pragma("unroll") for (int m = 0; m < 4; ++m) _Pragma("unroll") for (int n = 0; n < 2; ++n) _Pragma("unroll") for (int k = 0; k < 2; ++k) \
        acc[ai][bj][m][n] = __builtin_amdgcn_mfma_f32_16x16x32_bf16(Bt[n][k], At[m][k], acc[ai][bj][m][n], 0, 0, 0); __builtin_amdgcn_s_setprio(0); } while (0)
#define PG8_WAIT_V(n) asm volatile("s_waitcnt vmcnt(" #n ")" ::: "memory")
#define PG8_WAIT_L(n) asm volatile("s_waitcnt lgkmcnt(" #n ")" ::: "memory")
#define PG8_BAR __builtin_amdgcn_s_barrier()
#define PG8_SCHED __builtin_amdgcn_sched_barrier(0)
    Unit cur, nxt; int ui = 0;
    if (!next_unit(P, p, cx, 0, cur)) return;
    f32x4 acc[2][2][4][2];
#pragma unroll
    for (int a = 0; a < 2; ++a)
#pragma unroll
        for (int b = 0; b < 2; ++b)
#pragma unroll
            for (int m = 0; m < 4; ++m)
#pragma unroll
                for (int n = 0; n < 2; ++n) acc[a][b][m][n] = (f32x4){0.f, 0.f, 0.f, 0.f};
    bf16x8 At[4][2], B0[2][2], B1[2][2];
    const char* cA = cur.A; const char* cB = cur.B;
    PG8_STAGE(PG8_SB(0, 0), cB, voffB); PG8_STAGE(PG8_SA(0, 0), cA, voffA); PG8_STAGE(PG8_SB(0, 1), cB + hstepB, voffB); PG8_STAGE(PG8_SA(0, 1), cA + hstepA, voffA);
    if (wr == 1) PG8_BAR;
    PG8_WAIT_V(4); PG8_BAR;
    PG8_STAGE(PG8_SB(1, 0), cB + kstep, voffB); PG8_STAGE(PG8_SA(1, 0), cA + kstep, voffA); PG8_STAGE(PG8_SB(1, 1), cB + hstepB + kstep, voffB);
    PG8_WAIT_V(6); PG8_BAR;
    for (;;) {
        const bool has_next = next_unit(P, p, cx, ui + 1, nxt);
        const char* nA = has_next ? nxt.A : cA; const char* nB = has_next ? nxt.B : cB;
        for (int t = 0; t < nt; t += 2) {
            const bool last = (t == nt - 2);
            const char* a1 = cA + (size_t)(t + 1) * kstep;
            const char* a2 = last ? nA : cA + (size_t)(t + 2) * kstep; const char* b2 = last ? nB : cB + (size_t)(t + 2) * kstep;
            const char* a3 = a2 + kstep; const char* b3 = b2 + kstep;
            PG8_LDB(B0, 0, 0); PG8_SCHED; PG8_LDA(At, 0, 0); PG8_STAGE(PG8_SA(1, 1), a1 + hstepA, voffA);
            PG8_WAIT_L(8); PG8_BAR; PG8_WAIT_L(0); PG8_MMA(0, 0, At, B0); PG8_BAR; PG8_SCHED;
            PG8_LDB(B1, 0, 1); PG8_STAGE(PG8_SB(0, 0), b2, voffB);
            PG8_BAR; PG8_WAIT_L(0); PG8_MMA(0, 1, At, B1); PG8_BAR;
            PG8_LDA(At, 0, 1); PG8_STAGE(PG8_SA(0, 0), a2, voffA);
            PG8_BAR; PG8_WAIT_L(0); PG8_MMA(1, 0, At, B0); PG8_BAR; PG8_SCHED;
            PG8_STAGE(PG8_SB(0, 1), b2 + hstepB, voffB);
            PG8_WAIT_V(6); PG8_BAR; PG8_MMA(1, 1, At, B1); PG8_BAR;
            PG8_LDB(B0, 1, 0); PG8_SCHED; PG8_LDA(At, 1, 0); PG8_STAGE(PG8_SA(0, 1), a2 + hstepA, voffA);
            PG8_WAIT_L(8); PG8_BAR; PG8_WAIT_L(0); PG8_MMA(0, 0, At, B0); PG8_BAR; PG8_SCHED;
            PG8_LDB(B1, 1, 1); PG8_STAGE(PG8_SB(1, 0), b3, voffB);
            PG8_BAR; PG8_WAIT_L(0); PG8_MMA(0, 1, At, B1); PG8_BAR;
            PG8_LDA(At, 1, 1); PG8_STAGE(PG8_SA(1, 0), a3, voffA);
            PG8_BAR; PG8_WAIT_L(0); PG8_MMA(1, 0, At, B0); PG8_BAR; PG8_SCHED;
            PG8_STAGE(PG8_SB(1, 1), b3 + hstepB, voffB);
            PG8_WAIT_V(6); PG8_BAR; PG8_MMA(1, 1, At, B1); PG8_BAR;
        }
        epilogue(P, p, cx, acc, cur, wr, wc, fr, fq);
        if (!has_next) break;
#pragma unroll
        for (int a = 0; a < 2; ++a)
#pragma unroll
            for (int b = 0; b < 2; ++b)
#pragma unroll
                for (int m = 0; m < 4; ++m)
#pragma unroll
                    for (int n = 0; n < 2; ++n) acc[a][b][m][n] = (f32x4){0.f, 0.f, 0.f, 0.f};
        cur = nxt; cA = nA; cB = nB; ++ui;
    }
    PG8_WAIT_V(0);
    if (wr == 0) PG8_BAR;
    PG8_BAR;
#undef PG8_SA
#undef PG8_SB
#undef PG8_STAGE
#undef PG8_LDA
#undef PG8_LDB
#undef PG8_MMA
#undef PG8_WAIT_V
#undef PG8_WAIT_L
#undef PG8_BAR
#undef PG8_SCHED
}

__device__ __forceinline__ void tr_job(LAS float* tile, const float* src, int K, int N, unsigned char* dst, int ldk, int koff, int Kpad, int Npad, const float* scale, int& cnt, int stride_start, int G) {
    const int tk = Kpad / 64, tn = Npad / 64, ntile = tk * tn; const int tid = ltid();
    for (int it = 0; it < ntile; ++it, ++cnt) {
        if ((cnt % G) != stride_start) continue;
        const int k0 = (it / tn) * 64, n0 = (it % tn) * 64;
        __syncthreads();
        { const int tx = tid & 63, ty = tid >> 6;
#pragma unroll
            for (int i = 0; i < 8; ++i) { const int kd = k0 + ty + 8 * i, ks = kd - koff, n = n0 + tx; float v = 0.f;
                if (ks >= 0 && ks < K && n < N) { v = src[(size_t)ks * N + n]; if (scale) v *= scale[ks]; }
                tile[(ty + 8 * i) * 65 + tx] = v; } }
        __syncthreads();
        { const int n = tid >> 3, kc = (tid & 7) * 8; u32x4 o;
#pragma unroll
            for (int i = 0; i < 4; ++i) o[i] = pk2(tile[(kc + 2 * i) * 65 + n], tile[(kc + 2 * i + 1) * 65 + n]);
            *(u32x4*)(dst + ((size_t)(n0 + n) * ldk + k0 + kc) * 2) = o; }
    }
}

__device__ __forceinline__ void prep_phase(LAS unsigned char* lds, const Params& p) {
    LAS float* tile = (LAS float*)lds; unsigned char* ws = p.ws; int cnt = 0; const int b = blockIdx.x, G = gridDim.x;
    for (int i = 0; i < 3; ++i) tr_job(tile, p.in[7] + (size_t)i * D * D, D, D, ws + O_WRKV + (size_t)i * D * D * 2, 1024, 0, 1024, 1024, nullptr, cnt, b, G);
    tr_job(tile, p.in[14], D, 160, ws + O_G1, 1024, 0, 1024, 256, nullptr, cnt, b, G);
    tr_job(tile, p.in[9], D, 64, ws + O_W1, 1024, 0, 1024, 64, nullptr, cnt, b, G);
    tr_job(tile, p.in[9] + D * 64, D, 64, ws + O_W1 + (size_t)64 * 1024 * 2, 1024, 0, 1024, 192, nullptr, cnt, b, G);
    tr_job(tile, p.in[12], D, 64, ws + O_A1, 1024, 0, 1024, 64, nullptr, cnt, b, G);
    tr_job(tile, p.in[12] + D * 64, D, 64, ws + O_A1 + (size_t)64 * 1024 * 2, 1024, 0, 1024, 192, nullptr, cnt, b, G);
    for (int z = 0; z < 2; ++z) {
        tr_job(tile, p.in[10] + (size_t)z * 64 * D, 64, D, ws + O_L2 + (size_t)z * 1024 * 256 * 2, 256, z * 64, 256, 1024, nullptr, cnt, b, G);
        tr_job(tile, p.in[13] + (size_t)z * 64 * D, 64, D, ws + O_L2 + (size_t)(2 + z) * 1024 * 256 * 2, 256, (2 + z) * 64, 256, 1024, nullptr, cnt, b, G);
    }
    tr_job(tile, p.in[15], 160, D, ws + O_G2, 256, 0, 256, 1024, nullptr, cnt, b, G);
    tr_job(tile, p.in[21], D, D, ws + O_WO, 1024, 0, 1024, 1024, nullptr, cnt, b, G);
    tr_job(tile, p.in[22], D, D, ws + O_WF, 1024, 0, 1024, 1024, nullptr, cnt, b, G);
    for (int l = 0; l < 2; ++l) {
        tr_job(tile, p.in[23] + (size_t)l * D * 5632, D, 5632, ws + O_WIN + (size_t)l * 5632 * 1024 * 2, 1024, 0, 1024, 5632, p.in[4] + l * D, cnt, b, G);
        tr_job(tile, p.in[26] + (size_t)l * DFF * D, DFF, D, ws + O_WOUT + (size_t)l * 1024 * DFF * 2, DFF, 0, DFF, 1024, nullptr, cnt, b, G);
    }
    const size_t gt = (size_t)blockIdx.x * 512 + ltid(), NT = (size_t)gridDim.x * 512;
    const float* nm1 = p.in[3] + D;
    for (size_t e = gt; e < (size_t)2048 * 128; e += NT) {
        const int rr = (int)(e >> 7), c0 = (int)(e & 127) * 8; const int cs = rr >> 10, ch = rr & 1023; float v[8];
#pragma unroll
        for (int i = 0; i < 8; ++i) { const int c = c0 + i; float val = 0.f;
            if ((c >> 7) == (ch >> 7)) { const int m = ((ch & 127) * (c & 127)) & 127; float sn, cn; sincospif((float)m * (1.f / 64.f), &sn, &cn); val = (cs ? sn : cn) * nm1[c] * 0.08838834764831845f; }
            v[i] = val; }
        u32x4 o; o[0] = pk2(v[0], v[1]); o[1] = pk2(v[2], v[3]); o[2] = pk2(v[4], v[5]); o[3] = pk2(v[6], v[7]);
        *(u32x4*)(ws + O_CHD + e * 16) = o;
    }
    for (int ty = 0; ty < 2; ++ty) {
        const int T = ty ? 4112 : 2064, Tp = ty ? TP_S : TP_P, Mp = ty ? MP_S : MP_P; const int rowv = 2 * Tp / 8;
        unsigned char* dst = ws + (ty ? O_DFTS : O_DFTP); const float isq = rsqrtf((float)T), invT = 2.f / (float)T;
        for (size_t e = gt; e < (size_t)Mp * rowv; e += NT) {
            const int k = (int)(e / rowv), kk0 = (int)(e % rowv) * 8; float v[8];
#pragma unroll
            for (int i = 0; i < 8; ++i) { const int kk = kk0 + i; const int issin = kk >= Tp, t = issin ? kk - Tp : kk; float val = 0.f;
                if (k < T && t < T) { const int m = (int)(((long)k * t) % T); float sn, cn; sincospif((float)m * invT, &sn, &cn); val = (issin ? -sn : cn) * isq; }
                v[i] = val; }
            u32x4 o; o[0] = pk2(v[0], v[1]); o[1] = pk2(v[2], v[3]); o[2] = pk2(v[4], v[5]); o[3] = pk2(v[6], v[7]);
            *(u32x4*)(dst + e * 16) = o;
        }
    }
}

__device__ __forceinline__ void ea_load_row(const Params& p, const Ctx& c, int s, int pos, int lane, float (&v)[16]) {
    if (pos < 0 || pos >= c.T) {
#pragma unroll
        for (int i = 0; i < 16; ++i) v[i] = 0.f;
        return; }
    const float* src = pos < NMETA ? p.in[2] + (size_t)pos * D : c.x + ((size_t)s * (c.T - NMETA) + (pos - NMETA)) * D;
#pragma unroll
    for (int j = 0; j < 4; ++j) { const f32x4 t = *(const f32x4*)(src + j * 256 + lane * 4); v[4 * j] = t[0]; v[4 * j + 1] = t[1]; v[4 * j + 2] = t[2]; v[4 * j + 3] = t[3]; }
}
__device__ __forceinline__ void ea_store_row(unsigned char* base, size_t row, int lane, const float (&v)[16]) {
#pragma unroll
    for (int j = 0; j < 4; ++j) { u32x2 o; o[0] = pk2(v[4 * j], v[4 * j + 1]); o[1] = pk2(v[4 * j + 2], v[4 * j + 3]); *(u32x2*)(base + (row * 1024 + j * 256 + lane * 4) * 2) = o; }
}
__device__ __forceinline__ void ea_norm(float (&v)[16], const float (&nw)[16]) {
    float ss = 0.f;
#pragma unroll
    for (int i = 0; i < 16; ++i) ss += v[i] * v[i];
    ss = wave_sum(ss); const float rs = rsqrtf(ss * (1.f / 1024.f) + 1e-6f);
#pragma unroll
    for (int i = 0; i < 16; ++i) v[i] = v[i] * rs * nw[i];
}
__device__ __forceinline__ void phase_mix(const Params& p, const Ctx& c) {
    const int wave = __builtin_amdgcn_readfirstlane(ltid() >> 6), lane = ltid() & 63;
    const int gw = blockIdx.x * 8 + wave, NW = gridDim.x * 8;
    float nw[16];
#pragma unroll
    for (int j = 0; j < 4; ++j) { const f32x4 t = *(const f32x4*)(p.in[3] + j * 256 + lane * 4); nw[4 * j] = t[0]; nw[4 * j + 1] = t[1]; nw[4 * j + 2] = t[2]; nw[4 * j + 3] = t[3]; }
    const int nstrips = c.R / 16, spq = c.T / 16;
    for (int st = gw; st < nstrips; st += NW) {
        const int s = st / spq, pos0 = (st - s * spq) * 16; const size_t row0 = (size_t)st * 16;
        float prev[16], cur[16], nx[16];
        ea_load_row(p, c, s, pos0 - 1, lane, prev); ea_norm(prev, nw);
        ea_load_row(p, c, s, pos0, lane, cur); ea_store_row(slot(p, 0), row0, lane, cur); ea_norm(cur, nw);
        for (int i = 0; i < 16; ++i) {
            ea_load_row(p, c, s, pos0 + i + 1, lane, nx);
            if (i < 15) ea_store_row(slot(p, 0), row0 + i + 1, lane, nx);
            ea_norm(nx, nw);
            float xx[16], o[16];
#pragma unroll
            for (int e = 0; e < 16; ++e) xx[e] = 0.5f * (prev[e] + nx[e]) - cur[e];
            for (int m = 0; m < 6; ++m) {
#pragma unroll
                for (int j = 0; j < 4; ++j) { const f32x4 t = *(const f32x4*)(p.in[6] + m * D + j * 256 + lane * 4);
#pragma unroll
                    for (int e = 0; e < 4; ++e) o[4 * j + e] = cur[4 * j + e] + xx[4 * j + e] * t[e]; }
                ea_store_row(slot(p, 1 + m), row0 + i, lane, o); }
#pragma unroll
            for (int e = 0; e < 16; ++e) { prev[e] = cur[e]; cur[e] = nx[e]; }
        }
    }
}

__device__ __forceinline__ void phase_prescan(const Params& p, const Ctx& c) {
    const int wave = __builtin_amdgcn_readfirstlane(ltid() >> 6), lane = ltid() & 63;
    const int gw = blockIdx.x * 8 + wave, NW = gridDim.x * 8; const int ch0 = lane * 16;
    float kkw[16], kaw[16], rkw[16];
    load16f(p.in[16] + ch0, kkw); load16f(p.in[17] + ch0, kaw); load16f(p.in[18] + ch0, rkw);
    float* bonus = (float*)(p.ws + O_BONUS);
    for (int row = gw; row < c.R; row += NW) {
        const size_t e = (size_t)row * 1024 + ch0;
        float k[16], a0[16], a1[16], r[16];
        load16bf(slot(p, 8), e, k); load16bf(slot(p, 3), e, a0); load16bf(slot(p, 4), e, a1); load16bf(slot(p, 7), e, r);
        float kk[16], n2 = 0.f;
#pragma unroll
        for (int i = 0; i < 16; ++i) { kk[i] = k[i] * kkw[i]; n2 += kk[i] * kk[i]; }
        n2 += __shfl_xor(n2, 1); n2 += __shfl_xor(n2, 2);
        const float inv = 1.f / fmaxf(sqrtf(n2), 1e-12f);
        float kd0[16], kd1[16], bon = 0.f;
#pragma unroll
        for (int i = 0; i < 16; ++i) { kk[i] *= inv; kd0[i] = k[i] * (1.f + (a0[i] - 1.f) * kaw[i]); kd1[i] = k[i] * (1.f + (a1[i] - 1.f) * kaw[i]);
            bon += r[i] * (kd0[i] + kd1[i]) * rkw[i]; a0[i] *= kk[i]; a1[i] *= kk[i]; }
        bon += __shfl_xor(bon, 1); bon += __shfl_xor(bon, 2);
        if ((lane & 3) == 0) bonus[(size_t)row * 16 + (lane >> 2)] = bon;
        store16bf(slot(p, 8), e, kk); store16bf(slot(p, 3), e, a0); store16bf(slot(p, 4), e, a1);
        store16bf(slot(p, 6), e, kd0); store16bf(slot(p, 10), e, kd1);
    }
}

__device__ __forceinline__ float half_sum(float x) {
    const unsigned a = __float_as_uint(x); auto r = __builtin_amdgcn_permlane32_swap(a, a, false, false);
    return __uint_as_float(r[0]) + __uint_as_float(r[1]);
}
__device__ __forceinline__ float ldbf(const unsigned char* base, int idx) { return __uint_as_float(((unsigned)((const bf16_t*)base)[idx]) << 16); }
__device__ __forceinline__ void phase_scan(LAS unsigned char* lds, const Params& p, const Ctx& c) {
    const int tid = ltid(); const int wave = __builtin_amdgcn_readfirstlane(tid >> 6), lane = tid & 63;
    const int nitem = c.nseq * 64; const int r32 = lane & 31, jh = lane >> 5;
    LAS float* wb = (LAS float*)(lds + wave * 16384);
    LAS float* oring = wb + 1024;
    for (int w = blockIdx.x + gridDim.x * wave; w < nitem; w += gridDim.x * 8) {
        const int q = w >> 1, rh = w & 1; const int dir = q & 1, hh = (q >> 1) & 15, s = q >> 5;
        const size_t e0 = (size_t)s * c.T * 1024 + hh * 64;
        const unsigned char* Rb = slot(p, 7) + e0 * 2; const unsigned char* Kkb = slot(p, 8) + e0 * 2; const unsigned char* Vb = slot(p, 9) + e0 * 2;
        const unsigned char* Ngb = slot(p, 1 + dir) + e0 * 2; const unsigned char* Bdb = slot(p, 3 + dir) + e0 * 2;
        const unsigned char* Kdb = slot(p, dir ? 10 : 6) + e0 * 2; unsigned char* Ob = slot(p, 11 + dir) + e0 * 2;
        const int vrow = rh * 32 + r32;
        const int step = dir ? -2048 : 2048; long ro = dir ? (long)(c.T - 1) * 2048 : 0;
        f32x2 S2[16];
#pragma unroll
        for (int j = 0; j < 16; ++j) S2[j] = (f32x2){0.f, 0.f};
        float xr[8][6];
#define SCAN_LD(dst, tt) do { const int _t = (tt) < c.T ? (tt) : c.T - 1; const long _r = ro0 + (long)_t * step; \
            dst[0] = ldbf(Kkb + _r, lane); dst[1] = ldbf(Ngb + _r, lane); dst[2] = ldbf(Bdb + _r, lane); dst[3] = ldbf(Kdb + _r, lane); dst[4] = ldbf(Rb + _r, lane); dst[5] = ldbf(Vb + _r, vrow); } while (0)
#define SCAN_RD4(dst, base, jj) do { dst[0] = ((const LAS f32x4*)((base) + 64))[jj]; dst[1] = ((const LAS f32x4*)((base) + 128))[jj]; dst[2] = ((const LAS f32x4*)((base) + 192))[jj]; dst[3] = ((const LAS f32x4*)((base) + 256))[jj]; \
            dst[4] = ((const LAS f32x4*)((base) + 64))[(jj) + 1]; dst[5] = ((const LAS f32x4*)((base) + 128))[(jj) + 1]; dst[6] = ((const LAS f32x4*)((base) + 192))[(jj) + 1]; dst[7] = ((const LAS f32x4*)((base) + 256))[(jj) + 1]; } while (0)
#define SCAN_UPD(src, jj) do { _Pragma("unroll") for (int _h = 0; _h < 2; ++_h) { const f32x4 g4 = src[4 * _h], b4 = src[4 * _h + 1], d4 = src[4 * _h + 2], r4 = src[4 * _h + 3]; const int _j = 2 * ((jj) + _h); \
            f32x2 s0 = S2[_j], s1 = S2[_j + 1]; \
            s0 = __builtin_elementwise_fma(s0, (f32x2){g4[0], g4[1]}, s0); s1 = __builtin_elementwise_fma(s1, (f32x2){g4[2], g4[3]}, s1); \
            s0 = __builtin_elementwise_fma(sa2, (f32x2){b4[0], b4[1]}, s0); s1 = __builtin_elementwise_fma(sa2, (f32x2){b4[2], b4[3]}, s1); \
            s0 = __builtin_elementwise_fma(v2, (f32x2){d4[0], d4[1]}, s0); s1 = __builtin_elementwise_fma(v2, (f32x2){d4[2], d4[3]}, s1); \
            S2[_j] = s0; S2[_j + 1] = s1; \
            oa0 = __builtin_elementwise_fma(s0, (f32x2){r4[0], r4[1]}, oa0); oa1 = __builtin_elementwise_fma(s1, (f32x2){r4[2], r4[3]}, oa1); } } while (0)
        const long ro0 = ro;
        { float x[6]; SCAN_LD(x, 0); wb[lane] = x[0]; wb[64 + lane] = x[1]; wb[128 + lane] = x[2]; wb[192 + lane] = x[3]; wb[256 + lane] = x[4]; xr[0][5] = x[5]; }
        float vi = xr[0][5];
#pragma unroll
        for (int k = 1; k < 8; ++k) SCAN_LD(xr[k], k);
        SCAN_LD(xr[0], 8);
        f32x4 kq[8];
#pragma unroll
        for (int j = 0; j < 8; ++j) kq[j] = ((const LAS f32x4*)(wb + jh * 32))[j];
        int fstart = 0;
        for (int tb = 0; tb < c.T; tb += 8) {
#pragma unroll
            for (int k = 0; k < 8; ++k) {
                const int t = tb + k;
                const LAS float* sb = wb + (k & 1) * 512 + jh * 32; LAS float* sn = wb + ((k + 1) & 1) * 512;
                f32x4 P[8], Q[8];
                SCAN_RD4(P, sb, 0);
                __builtin_amdgcn_sched_barrier(0);
                f32x2 a0 = (f32x2){0.f, 0.f}, a1 = (f32x2){0.f, 0.f};
#pragma unroll
                for (int j = 0; j < 8; ++j) { a0 = __builtin_elementwise_fma(S2[2 * j], (f32x2){kq[j][0], kq[j][1]}, a0); a1 = __builtin_elementwise_fma(S2[2 * j + 1], (f32x2){kq[j][2], kq[j][3]}, a1); }
                float (&xs)[6] = xr[(k + 1) & 7];
                sn[lane] = xs[0]; sn[64 + lane] = xs[1]; sn[128 + lane] = xs[2]; sn[192 + lane] = xs[3]; sn[256 + lane] = xs[4];
                const float vcur = vi; vi = xs[5];
                SCAN_LD(xs, t + 9);
                const float sa = -half_sum((a0[0] + a0[1]) + (a1[0] + a1[1]));
                const f32x2 sa2 = (f32x2){sa, sa}, v2 = (f32x2){vcur, vcur};
                f32x2 oa0 = (f32x2){0.f, 0.f}, oa1 = (f32x2){0.f, 0.f};
                SCAN_RD4(Q, sb, 2);
                __builtin_amdgcn_sched_barrier(0);
                SCAN_UPD(P, 0);
                __builtin_amdgcn_sched_barrier(0);
                SCAN_RD4(P, sb, 4);
                __builtin_amdgcn_sched_barrier(0);
                SCAN_UPD(Q, 2);
                __builtin_amdgcn_sched_barrier(0);
                SCAN_RD4(Q, sb, 6);
                __builtin_amdgcn_sched_barrier(0);
                SCAN_UPD(P, 4);
                __builtin_amdgcn_sched_barrier(0);
#pragma unroll
                for (int j = 0; j < 8; ++j) kq[j] = ((const LAS f32x4*)(sn + jh * 32))[j];
                __builtin_amdgcn_sched_barrier(0);
                SCAN_UPD(Q, 6);
                const float ov = half_sum((oa0[0] + oa0[1]) + (oa1[0] + oa1[1]));
                if (jh == 0) oring[(t & 63) * 32 + r32] = ov;
            }
            const int tend = tb + 8, nfl = tend - fstart;
            if (nfl == 64 || tend >= c.T) {
                for (int idx = lane; idx < nfl * 32; idx += 64) { const int st = idx >> 5, row = idx & 31;
                    ((bf16_t*)(Ob + ro0 + (long)(fstart + st) * step))[rh * 32 + row] = (bf16_t)(pk2(oring[idx], 0.f) & 0xffffu); }
                fstart = tend;
            }
        }
#undef SCAN_LD
#undef SCAN_RD4
#undef SCAN_UPD
    }
}

__device__ __forceinline__ void phase_postscan(const Params& p, const Ctx& c) {
    const int wave = __builtin_amdgcn_readfirstlane(ltid() >> 6), lane = ltid() & 63;
    const int gw = blockIdx.x * 8 + wave, NW = gridDim.x * 8; const int ch0 = lane * 16;
    float gw_[16], gb_[16]; load16f(p.in[19] + ch0, gw_); load16f(p.in[20] + ch0, gb_);
    const float* bonus = (const float*)(p.ws + O_BONUS);
    for (int row = gw; row < c.R; row += NW) {
        const size_t e = (size_t)row * 1024 + ch0;
        float of[16], ob[16], v[16], g[16];
        load16bf(slot(p, 11), e, of); load16bf(slot(p, 12), e, ob); load16bf(slot(p, 9), e, v); load16bf(slot(p, 5), e, g);
        float sum = 0.f;
#pragma unroll
        for (int i = 0; i < 16; ++i) { of[i] += ob[i]; sum += of[i]; }
        sum += __shfl_xor(sum, 1); sum += __shfl_xor(sum, 2); const float mean = sum * (1.f / 64.f);
        float var = 0.f;
#pragma unroll
        for (int i = 0; i < 16; ++i) { of[i] -= mean; var += of[i] * of[i]; }
        var += __shfl_xor(var, 1); var += __shfl_xor(var, 2); const float rs = rsqrtf(var * (1.f / 64.f) + 64e-5f);
        const float bon = bonus[(size_t)row * 16 + (lane >> 2)];
#pragma unroll
        for (int i = 0; i < 16; ++i) of[i] = (of[i] * rs * gw_[i] + gb_[i] + bon * v[i]) * g[i];
        store16bf(slot(p, 1), e, of);
    }
}

__device__ __forceinline__ void phase_glu(const Params& p, const Ctx& c, int layer) {
    const size_t gt = (size_t)blockIdx.x * 512 + ltid(), NT = (size_t)gridDim.x * 512;
    const unsigned char* U = slot(p, 1); unsigned char* Aout = slot(p, 7);
    const float* cw = p.in[24] + (size_t)layer * 3 * DFF; const float* cb = p.in[25] + (size_t)layer * DFF;
    const size_t nitem = (size_t)c.R * 352;
    for (size_t it = gt; it < nitem; it += NT) {
        const int row = (int)(it / 352), cc = (int)(it % 352) * 8; const int pos = row % c.T;
        const unsigned char* ur = U + (size_t)row * 5632 * 2 + cc * 2;
        const u32x4 z = (u32x4){0u, 0u, 0u, 0u};
        const u32x4 pm = pos > 0 ? *(const u32x4*)(ur - 5632 * 2) : z, pc = *(const u32x4*)ur, pp = pos < c.T - 1 ? *(const u32x4*)(ur + 5632 * 2) : z;
        const u32x4 ln = *(const u32x4*)(ur + DFF * 2);
        float w0[8], w1[8], w2[8], bb[8];
#pragma unroll
        for (int h = 0; h < 2; ++h) { const f32x4 a = *(const f32x4*)(cw + cc + 4 * h), b = *(const f32x4*)(cw + DFF + cc + 4 * h), d = *(const f32x4*)(cw + 2 * DFF + cc + 4 * h), e = *(const f32x4*)(cb + cc + 4 * h);
#pragma unroll
            for (int i = 0; i < 4; ++i) { w0[4 * h + i] = a[i]; w1[4 * h + i] = b[i]; w2[4 * h + i] = d[i]; bb[4 * h + i] = e[i]; } }
        u32x4 o;
#pragma unroll
        for (int i = 0; i < 4; ++i) {
            const float c0 = bflo(pm[i]) * w0[2 * i] + bflo(pc[i]) * w1[2 * i] + bflo(pp[i]) * w2[2 * i] + bb[2 * i];
            const float c1 = bfhi(pm[i]) * w0[2 * i + 1] + bfhi(pc[i]) * w1[2 * i + 1] + bfhi(pp[i]) * w2[2 * i + 1] + bb[2 * i + 1];
            o[i] = pk2(c0 * sigmoidf_(c0) * bflo(ln[i]), c1 * sigmoidf_(c1) * bfhi(ln[i])); }
        *(u32x4*)(Aout + ((size_t)row * DFF + cc) * 2) = o;
    }
}

__device__ __forceinline__ void phase_final(const Params& p, const Ctx& c) {
    const int wave = __builtin_amdgcn_readfirstlane(ltid() >> 6), lane = ltid() & 63;
    const int gw = blockIdx.x * 8 + wave, NW = gridDim.x * 8; const int ch0 = lane * 16;
    float nf[16]; load16f(p.in[5] + ch0, nf);
    const int To = c.T - NMETA, nrow = c.nseq * To;
    for (int q = gw; q < nrow; q += NW) {
        const int s = q / To, po = q - s * To; const size_t row = (size_t)s * c.T + NMETA + po;
        float h[16]; load16bf(slot(p, 0), row * 1024 + ch0, h);
        float ss = 0.f;
#pragma unroll
        for (int i = 0; i < 16; ++i) ss += h[i] * h[i];
        ss = wave_sum(ss); const float rs = rsqrtf(ss * (1.f / 1024.f) + 1e-6f);
        float* dst = c.y + (size_t)q * 1024 + ch0;
#pragma unroll
        for (int j = 0; j < 4; ++j) { f32x4 o; o[0] = h[4 * j] * rs * nf[4 * j]; o[1] = h[4 * j + 1] * rs * nf[4 * j + 1]; o[2] = h[4 * j + 2] * rs * nf[4 * j + 2]; o[3] = h[4 * j + 3] * rs * nf[4 * j + 3]; ((f32x4*)dst)[j] = o; }
    }
}


#define XB_TMO      128
#define XB_XCNT(j)  (256  + 64 * (j))
#define XB_XSUB(j)  (1280 + 64 * (j))
#define XB_XGEN(j)  (2304 + 64 * (j))
#define XB_TOP      3328
#define XB_TOPGEN   3392
#define XCD_BAR_WORDS 3456
#define XB_SPIN_CAP (1u << 18)
__device__ __forceinline__ unsigned xb_ld(unsigned* p)              { return __hip_atomic_load(p, __ATOMIC_RELAXED, __HIP_MEMORY_SCOPE_AGENT); }
__device__ __forceinline__ unsigned xb_add(unsigned* p, unsigned v) { return __hip_atomic_fetch_add(p, v, __ATOMIC_RELAXED, __HIP_MEMORY_SCOPE_AGENT); }
__device__ __forceinline__ unsigned xb_xcc_id() { return (unsigned)__builtin_amdgcn_s_getreg((3 << 11) | 20) & 0xFu; }
#define XB_SPIN(cond, bar) do { unsigned _sp = 0; while (cond) { __builtin_amdgcn_s_sleep(1); \
    if ((++_sp & 255u) == 0u) { if (xb_ld(&(bar)[XB_TMO])) break; if (_sp > XB_SPIN_CAP) { atomicAdd(&(bar)[XB_TMO], 1u); break; } } } } while (0)
struct XcdBarrier { unsigned* bar; unsigned x; volatile LAS unsigned* st; };
__device__ __forceinline__ XcdBarrier xcd_barrier_post(unsigned* bar, volatile LAS unsigned* st) {
    XcdBarrier b; b.bar = bar; b.x = xb_xcc_id(); b.st = st;
    if (threadIdx.x == 0) (void)xb_add(&bar[XB_XCNT(b.x)], 1u);
    return b;
}
__device__ __forceinline__ void xcd_barrier_complete(unsigned* bar, unsigned x, unsigned& nloc, unsigned& nx) {
    const unsigned G = gridDim.x * gridDim.y * gridDim.z;
    unsigned sum, cnt, mine, sp = 0u;
    for (;;) {
        sum = 0u; cnt = 0u; mine = 0u;
#pragma unroll
        for (unsigned j = 0; j < 16; ++j) { const unsigned c = xb_ld(&bar[XB_XCNT(j)]); sum += c; cnt += (c > 0u) ? 1u : 0u; mine = (j == x) ? c : mine; }
        if (sum == G) break;
        __builtin_amdgcn_s_sleep(1);
        if ((++sp & 255u) == 0u) { if (xb_ld(&bar[XB_TMO])) break; if (sp > XB_SPIN_CAP) { atomicAdd(&bar[XB_TMO], 1u); break; } }
    }
    nloc = mine > 0u ? mine : 1u; nx = cnt > 0u ? cnt : 1u;
}
__device__ __forceinline__ void xcd_barrier(const XcdBarrier& b) {
    asm volatile("s_waitcnt vmcnt(0)" ::: "memory");
    __syncthreads();
    if (threadIdx.x == 0) {
        unsigned* bar = b.bar;
        __builtin_amdgcn_s_waitcnt(0);
        unsigned nloc = b.st[0], nx = b.st[1];
        if (nloc == 0u) { xcd_barrier_complete(bar, b.x, nloc, nx); b.st[0] = nloc; b.st[1] = nx; }
        const unsigned old = xb_add(&bar[XB_XSUB(b.x)], 1u);
        const unsigned gen = old / nloc;
        if (old + 1u == (gen + 1u) * nloc) {
            __builtin_amdgcn_fence(__ATOMIC_RELEASE, "agent");
            asm volatile("s_waitcnt vmcnt(0)" ::: "memory");
            const unsigned og = xb_add(&bar[XB_TOP], 1u);
            const unsigned tg = og / nx;
            if (og + 1u == (tg + 1u) * nx) xb_add(&bar[XB_TOPGEN], 1u);
            else XB_SPIN(xb_ld(&bar[XB_TOPGEN]) == tg, bar);
            __builtin_amdgcn_fence(__ATOMIC_ACQUIRE, "agent");
            xb_add(&bar[XB_XGEN(b.x)], 1u);
            asm volatile("s_waitcnt vmcnt(0)" ::: "memory");
        } else {
            XB_SPIN(xb_ld(&bar[XB_XGEN(b.x)]) == gen, bar);
            __builtin_amdgcn_fence(__ATOMIC_ACQUIRE, "agent");
            asm volatile("s_waitcnt vmcnt(0)" ::: "memory");
        }
    }
    __syncthreads();
}

constexpr int NSUB = 20, NPHASE = 1 + 4 * NSUB;

__device__ __forceinline__ void phase_rstd(const Params& p, int which) {
    const float* part = (const float*)(p.ws + O_SS) + (size_t)which * 16 * RP; float* rs = (float*)(p.ws + O_RSTD) + (size_t)which * RP;
    for (int r = blockIdx.x * 512 + ltid(); r < RP; r += gridDim.x * 512) rs[r] = rstd16(part, r);
}

__device__ __forceinline__ void run_phase(LAS unsigned char* lds, const Params& p, int ph) {
    if (ph == 0) { prep_phase(lds, p); return; }
    const int g = (ph - 1) / NSUB, sp = (ph - 1) % NSUB; const Ctx c = get_ctx(p, g);
    GemmPh P; P.G = gridDim.x; P.c = blockIdx.x; P.A = nullptr; P.B = nullptr; P.O = nullptr; P.ss = nullptr; P.ssin = nullptr; P.ldo = 0; P.kind = -1;
    float* ssb = (float*)(p.ws + O_SS); const float* rsb = (const float*)(p.ws + O_RSTD);
    switch (sp) {
    case 1: P.kind = K_L1; P.nunits = MT * 15; P.lda = 1024; P.ldb = 1024; P.K = 1024; break;
    case 2: P.kind = K_L2; P.nunits = MT * 20; P.lda = 256; P.ldb = 256; P.K = 256; break;
    case 6: P.kind = K_RES; P.nunits = MT * 4; P.lda = 1024; P.ldb = 1024; P.K = 1024; P.A = (const char*)slot(p, 1); P.B = (const char*)p.ws + O_WO; P.O = slot(p, 0); P.ss = ssb; break;
    case 8: case 16: { const int l = sp == 8 ? 0 : 1; P.kind = K_U; P.nunits = MT * 22; P.lda = 1024; P.ldb = 1024; P.K = 1024; P.A = (const char*)slot(p, 0); P.B = (const char*)p.ws + O_WIN + (size_t)l * 5632 * 1024 * 2;
        P.O = slot(p, 1); P.ssin = rsb + (l ? 2 * RP : 0); } break;
    case 10: case 18: { const int l = sp == 10 ? 0 : 1; P.kind = K_RES; P.nunits = MT * 4; P.lda = DFF; P.ldb = DFF; P.K = DFF; P.A = (const char*)slot(p, 7); P.B = (const char*)p.ws + O_WOUT + (size_t)l * 1024 * DFF * 2;
        P.O = slot(p, 0); P.ss = l ? nullptr : ssb + 16 * RP; } break;
    case 12: P.kind = K_CH; P.nunits = MT * 8; P.lda = 1024; P.ldb = 1024; P.K = 256; P.A = (const char*)p.ws + O_CHD; P.B = (const char*)slot(p, 0); P.O = slot(p, 1); P.ssin = rsb + RP; break;
    case 13: P.kind = K_TD; P.nunits = c.nseq * c.tm * 4; P.lda = 2 * c.Tp; P.ldb = 2 * c.Tp; P.K = 2 * c.Tp; P.A = (const char*)p.ws + (g < 2 ? O_DFTP : O_DFTS); P.B = (const char*)slot(p, 1); P.O = slot(p, 4); break;
    case 14: P.kind = K_RES; P.nunits = MT * 4; P.lda = 1024; P.ldb = 1024; P.K = 1024; P.A = (const char*)slot(p, 4); P.B = (const char*)p.ws + O_WF; P.O = slot(p, 0); P.ss = ssb + 2 * 16 * RP; break;
    default: break;
    }
    if (P.kind >= 0) {
        switch (P.kind) {
        case K_L1: gemm_phase<K_L1>(lds, P, p, c); break;
        case K_L2: gemm_phase<K_L2>(lds, P, p, c); break;
        case K_RES: gemm_phase<K_RES>(lds, P, p, c); break;
        case K_U: gemm_phase<K_U>(lds, P, p, c); break;
        case K_CH: gemm_phase<K_CH>(lds, P, p, c); break;
        default: gemm_phase<K_TD>(lds, P, p, c); break;
        }
        if (sp == 12) {
            const int padw = c.Tp - c.T; const size_t nrows = (size_t)c.nseq * 2048, n = nrows * padw; bf16_t* yT = (bf16_t*)slot(p, 1);
            for (size_t i = (size_t)blockIdx.x * 512 + ltid(); i < n; i += (size_t)gridDim.x * 512) { const size_t rr = i / padw; const int cc = (int)(i - rr * padw); yT[rr * c.Tp + c.T + cc] = 0; } }
        return;
    }
    if (sp == 0) phase_mix(p, c);
    else if (sp == 3) phase_prescan(p, c);
    else if (sp == 4) phase_scan(lds, p, c);
    else if (sp == 5) phase_postscan(p, c);
    else if (sp == 7 || sp == 11 || sp == 15) phase_rstd(p, sp == 7 ? 0 : sp == 11 ? 1 : 2);
    else if (sp == 9 || sp == 17) phase_glu(p, c, sp == 9 ? 0 : 1);
    else phase_final(p, c);
}

__global__ void __launch_bounds__(512, 2) mega(Params p, int ph_lo, int ph_hi) {
    extern __shared__ __attribute__((aligned(16))) unsigned char shm[];
    LAS unsigned char* lds = (LAS unsigned char*)shm;
    cg::grid_group grid = cg::this_grid();
    volatile LAS unsigned* st = (volatile LAS unsigned*)(lds + STAGE_BYTES);
    if (threadIdx.x == 0) { st[0] = 0u; st[1] = 0u; }
    __syncthreads();
    const XcdBarrier xb = xcd_barrier_post((unsigned*)(p.ws + O_BAR), st);
    for (int ph = ph_lo; ph < ph_hi; ++ph) {
        if (ph == ph_lo + 1) grid.sync();
        else if (ph > ph_lo) xcd_barrier(xb);
        run_phase(lds, p, ph);
    }
}

extern "C" void kernel_launch(void* const* d_in, const int* in_sizes, int n_in, void* d_out, int out_size, void* d_ws, size_t ws_size, hipStream_t stream) {
    static int grid = 0;
    if (grid == 0) {
        if (n_in != 27 || ws_size < WS_END) { fprintf(stderr, "kernel_launch: need 27 inputs and %zu B of workspace (got %d, %zu)\n", (size_t)WS_END, n_in, ws_size); grid = -1; return; }
        int dev = 0, cus = 0, per_cu = 0;
        hipGetDevice(&dev); hipDeviceGetAttribute(&cus, hipDeviceAttributeMultiprocessorCount, dev);
        if (hipFuncSetAttribute((const void*)mega, hipFuncAttributeMaxDynamicSharedMemorySize, STAGE_BYTES + 16) != hipSuccess) { fprintf(stderr, "hipFuncSetAttribute failed\n"); grid = -1; return; }
        hipOccupancyMaxActiveBlocksPerMultiprocessor(&per_cu, (const void*)mega, 512, STAGE_BYTES + 16);
        if (per_cu < 1) per_cu = 1;
        (void)hipGetLastError();
        grid = cus * 1;
    }
    if (grid < 0) return;
    Params p{};
    for (int i = 0; i < 27; ++i) p.in[i] = (const float*)d_in[i];
    p.out = (float*)d_out; p.ws = (unsigned char*)d_ws;
#if MK_PER_PHASE
    for (int ph = 0; ph < NPHASE; ++ph) hipLaunchKernelGGL(mega, dim3(grid), dim3(512), STAGE_BYTES + 16, stream, p, ph, ph + 1);
#else
    (void)hipMemsetAsync((unsigned char*)d_ws + O_BAR, 0, 16384, stream);
    int lo = 0, hi = NPHASE;
    void* args[] = {&p, &lo, &hi};
    hipError_t e = hipLaunchCooperativeKernel((const void*)mega, dim3(grid), dim3(512), args, STAGE_BYTES + 16, stream);
    if (e != hipSuccess) fprintf(stderr, "cooperative launch failed: %s (grid %d)\n", hipGetErrorString(e), grid);
#endif
}
```

```cpp
#include <hip/hip_runtime.h>
#include <hip/hip_cooperative_groups.h>
#include <cstdio>
namespace cg = cooperative_groups;

#ifndef MK_PER_PHASE
#define MK_PER_PHASE 0
#endif

#define LAS __attribute__((address_space(3)))
typedef unsigned short bf16_t;
typedef short bf16x8 __attribute__((ext_vector_type(8)));
typedef float f32x4 __attribute__((ext_vector_type(4)));
typedef unsigned u32x4 __attribute__((ext_vector_type(4)));
typedef unsigned u32x2 __attribute__((ext_vector_type(2)));
typedef float f32x2 __attribute__((ext_vector_type(2)));
typedef const __attribute__((address_space(4))) unsigned* cptr;

constexpr int D = 1024, DFF = 2816, NMETA = 16;
constexpr int RP = 33024;
constexpr int MT = RP / 256;
constexpr size_t SLOT = (size_t)RP * D * 2;
constexpr int NSLOT = 13;
constexpr size_t O_WRKV = NSLOT * SLOT;
constexpr size_t O_G1 = O_WRKV + (size_t)3072 * 1024 * 2;
constexpr size_t O_W1 = O_G1 + (size_t)256 * 1024 * 2;
constexpr size_t O_A1 = O_W1 + (size_t)256 * 1024 * 2;
constexpr size_t O_L2 = O_A1 + (size_t)256 * 1024 * 2;
constexpr size_t O_G2 = O_L2 + (size_t)4096 * 256 * 2;
constexpr size_t O_WO = O_G2 + (size_t)1024 * 256 * 2;
constexpr size_t O_WF = O_WO + (size_t)1024 * 1024 * 2;
constexpr size_t O_WIN = O_WF + (size_t)1024 * 1024 * 2;
constexpr size_t O_WOUT = O_WIN + (size_t)2 * 5632 * 1024 * 2;
constexpr size_t O_CHD = O_WOUT + (size_t)2 * 1024 * 2816 * 2;
constexpr int TP_P = 1088, TP_S = 2112, MP_P = 2304, MP_S = 4352;
constexpr size_t O_DFTP = O_CHD + (size_t)2048 * 1024 * 2;
constexpr size_t O_DFTS = O_DFTP + (size_t)MP_P * 2 * TP_P * 2;
constexpr size_t O_SS = O_DFTS + (size_t)MP_S * 2 * TP_S * 2;
constexpr size_t O_RSTD = O_SS + (size_t)3 * 16 * RP * 4;
constexpr size_t O_BONUS = O_RSTD + (size_t)3 * RP * 4;
constexpr size_t O_BAR = O_BONUS + (size_t)RP * 16 * 4;
constexpr size_t WS_END = O_BAR + 16384;

struct Params { const float* in[27]; float* out; unsigned char* ws; };
struct Ctx { int g, T, nseq, R, Tp, tm; const float* x; float* y; };

__device__ __forceinline__ Ctx get_ctx(const Params& p, int g) {
    Ctx c; c.g = g;
    if (g < 2) { c.T = 2064; c.nseq = 16; c.Tp = TP_P; c.tm = 9; c.x = p.in[0] + (size_t)g * 16 * 2048 * 1024; c.y = p.out + (size_t)g * 16 * 2048 * 1024; }
    else { c.T = 4112; c.nseq = 8; c.Tp = TP_S; c.tm = 17; c.x = p.in[1] + (size_t)(g - 2) * 8 * 4096 * 1024; c.y = p.out + (size_t)32 * 2048 * 1024 + (size_t)(g - 2) * 8 * 4096 * 1024; }
    c.R = c.nseq * c.T; return c;
}
__device__ __forceinline__ int ltid() { int t = threadIdx.x; asm volatile("" : "+v"(t)); return t; }
__device__ __forceinline__ unsigned char* slot(const Params& p, int i) { return p.ws + (size_t)i * SLOT; }

__device__ __forceinline__ unsigned pk2(float lo, float hi) { unsigned r; asm volatile("v_cvt_pk_bf16_f32 %0, %1, %2" : "=v"(r) : "v"(lo), "v"(hi)); return r; }
__device__ __forceinline__ float bflo(unsigned u) { return __uint_as_float(u << 16); }
__device__ __forceinline__ float bfhi(unsigned u) { return __uint_as_float(u & 0xffff0000u); }
__device__ __forceinline__ float wave_sum(float v) {
#pragma unroll
    for (int o = 1; o < 64; o <<= 1) v += __shfl_xor(v, o);
    return v;
}
__device__ __forceinline__ float sigmoidf_(float x) { return 1.f / (1.f + __expf(-x)); }
__device__ __forceinline__ void unpack16(const u32x4 a, const u32x4 b, float (&v)[16]) {
#pragma unroll
    for (int i = 0; i < 4; ++i) { v[2 * i] = bflo(a[i]); v[2 * i + 1] = bfhi(a[i]); v[8 + 2 * i] = bflo(b[i]); v[8 + 2 * i + 1] = bfhi(b[i]); }
}
__device__ __forceinline__ void load16bf(const unsigned char* base, size_t elem, float (&v)[16]) {
    const u32x4* q = (const u32x4*)(base + elem * 2); unpack16(q[0], q[1], v);
}
__device__ __forceinline__ void store16bf(unsigned char* base, size_t elem, const float (&v)[16]) {
    u32x4 a, b;
#pragma unroll
    for (int i = 0; i < 4; ++i) { a[i] = pk2(v[2 * i], v[2 * i + 1]); b[i] = pk2(v[8 + 2 * i], v[8 + 2 * i + 1]); }
    u32x4* q = (u32x4*)(base + elem * 2); q[0] = a; q[1] = b;
}
__device__ __forceinline__ void load16f(const float* src, float (&v)[16]) {
#pragma unroll
    for (int j = 0; j < 4; ++j) { f32x4 t = ((const f32x4*)src)[j]; v[4 * j] = t[0]; v[4 * j + 1] = t[1]; v[4 * j + 2] = t[2]; v[4 * j + 3] = t[3]; }
}

constexpr int BM = 256, BK = 64, HALF = 128, HTB = HALF * BK * 2, STAGE_BYTES = 8 * HTB;
__device__ __forceinline__ int lds_byte(int r, int c) { const int st = (r >> 4) * 2 + (c >> 5), rr = r & 15, cc = c & 31, ob = rr * 64 + cc * 2; return st * 1024 + (ob ^ (((ob >> 9) & 1) << 5)); }
__device__ __forceinline__ void stage_rc(int b, int& R, int& C) { const int st = b / 1024, sb = b % 1024, swz = sb ^ (((sb >> 9) & 1) << 5); R = (st >> 1) * 16 + swz / 64; C = (st & 1) * 32 + (swz % 64) / 2; }
__device__ __forceinline__ int perm32(int rho) { const int n = rho >> 4, i = rho & 15; return 8 * (i >> 2) + 4 * n + (i & 3); }

enum { K_L1 = 0, K_L2, K_RES, K_U, K_CH, K_TD };
struct Unit { const char* A; const char* B; int pm, pn, job, s; };
struct GemmPh {
    int kind, nunits, lda, ldb, K, G, c;
    const char* A; const char* B;
    unsigned char* O; float* ss; const float* ssin; int ldo;
};

__device__ __forceinline__ bool next_unit(const GemmPh& P, const Params& p, const Ctx& cx, int i, Unit& u) {
    const long Lg = (long)i * P.G + P.c; if (Lg >= P.nunits) return false;
    const int L = (int)Lg; u.s = 0; u.job = 0;
    if (P.kind == K_L1) {
        const int pm = L / 15, jn = L % 15; int job, pn;
        if (jn < 12) { job = jn >> 2; pn = jn & 3; } else { job = 3 + (jn - 12); pn = 0; }
        const int aslot = job == 0 ? 1 : job == 1 ? 3 : job == 2 ? 4 : job == 3 ? 6 : job == 4 ? 2 : 5;
        u.A = (const char*)slot(p, aslot) + (size_t)pm * 256 * 2048;
        const size_t boff = job < 3 ? O_WRKV + ((size_t)job * 1024 + pn * 256) * 2048 : job == 3 ? O_G1 : job == 4 ? O_W1 : O_A1;
        u.B = (const char*)p.ws + boff; u.pm = pm; u.pn = pn; u.job = job;
    } else if (P.kind == K_L2) {
        const int pm = L / 20, jn = L % 20; const int job = jn < 16 ? 0 : 1, pn = jn < 16 ? jn : jn - 16;
        u.A = (const char*)slot(p, 10) + (job == 0 ? (size_t)RP * 512 : 0) + (size_t)pm * 256 * 512;
        u.B = (const char*)p.ws + (job == 0 ? O_L2 : O_G2) + (size_t)pn * 256 * 512; u.pm = pm; u.pn = pn; u.job = job;
    } else if (P.kind == K_RES) {
        const int pm = L >> 2, pn = L & 3;
        u.A = P.A + (size_t)pm * 256 * P.lda * 2; u.B = P.B + (size_t)pn * 256 * P.ldb * 2; u.pm = pm; u.pn = pn;
    } else if (P.kind == K_U) {
        const int pm = L / 22, pn = L % 22;
        u.A = P.A + (size_t)pm * 256 * 2048; u.B = P.B + (size_t)pn * 256 * 2048; u.pm = pm; u.pn = pn;
    } else if (P.kind == K_CH) {
        const int pn = L >> 3, pm = L & 7;
        u.A = P.A + (size_t)pm * 256 * 2048 + (pm & 3) * 512; u.B = (const char*)slot(p, pm < 4 ? 5 : 6) + (size_t)pn * 256 * 2048 + (pm & 3) * 512; u.pm = pm; u.pn = pn;
    } else {
        const int per = cx.tm * 4, s = L / per, rem = L % per, pm = rem >> 2, pn = rem & 3;
        u.A = P.A + (size_t)pm * 256 * P.lda * 2; u.B = P.B + ((size_t)s * 1024 + pn * 256) * P.ldb * 2; u.pm = pm; u.pn = pn; u.s = s;
    }
    return true;
}

__device__ __forceinline__ void st8(unsigned char* ptr, const f32x4 a, const f32x4 b) {
    u32x4 o; o[0] = pk2(a[0], a[1]); o[1] = pk2(a[2], a[3]); o[2] = pk2(b[0], b[1]); o[3] = pk2(b[2], b[3]); *(u32x4*)ptr = o;
}
__device__ __forceinline__ float decaymap(float w) {
    const float e = 0.6065306597f / (1.f + __expf(-w)); return __expf(-e) - 1.f;
}
__device__ __forceinline__ float act_apply(int act, float x) {
    if (act == 1) return 1.f / (1.f + __expf(-x));
    if (act == 2) return 1.f - 2.f / (__expf(2.f * x) + 1.f);
    if (act == 3) return decaymap(x);
    return x;
}

__device__ __forceinline__ float rstd16(const float* ss, int r) {
    float s = 0.f;
#pragma unroll
    for (int i = 0; i < 16; ++i) s += ss[(size_t)i * RP + r];
    return rsqrtf(s * (1.f / 1024.f) + 1e-6f);
}
__device__ __forceinline__ void epilogue(const GemmPh& P, const Params& p, const Ctx& cx, const f32x4 (&acc)[2][2][4][2], const Unit& u, int wr, int wc, int fr, int fq) {
    const int rbase = u.pm * 256 + wr * 64 + fr, cbase = u.pn * 256 + wc * 32 + 8 * fq;
    if (P.kind == K_L1 || P.kind == K_L2) {
        unsigned char* O; int ldo = 1024, coff = 0, act = 0, cvalid = 1 << 30; const float* bias = nullptr;
        if (P.kind == K_L1) {
            if (u.job < 3) { O = slot(p, 7 + u.job); }
            else if (u.job == 3) { O = slot(p, 10); ldo = 256; act = 1; }
            else if (u.job == 4) { O = slot(p, 10) + (size_t)RP * 512; ldo = 256; act = 2; cvalid = 128; }
            else { O = slot(p, 10) + (size_t)RP * 512; ldo = 256; coff = 128; cvalid = 128; }
        } else {
            if (u.job == 1) { O = slot(p, 5); }
            else { const int cb = u.pn >> 2; O = slot(p, 1 + cb); bias = (cb < 2 ? p.in[8] : p.in[11]) + (cb & 1) * 1024 - cb * 1024; coff = -cb * 1024; act = cb < 2 ? 3 : 1; }
        }
        f32x4 bv[2][2];
#pragma unroll
        for (int bj = 0; bj < 2; ++bj)
#pragma unroll
            for (int n = 0; n < 2; ++n) bv[bj][n] = bias ? *(const f32x4*)(bias + cbase + bj * 128 + 4 * n) : (f32x4){0.f, 0.f, 0.f, 0.f};
#pragma unroll
        for (int ai = 0; ai < 2; ++ai)
#pragma unroll
            for (int m = 0; m < 4; ++m) { if ((m & 1) == 0) __builtin_amdgcn_sched_barrier(0);
#pragma unroll
                for (int bj = 0; bj < 2; ++bj) { const int r = rbase + ai * 128 + m * 16; const int c0 = cbase + bj * 128;
                    f32x4 v0 = acc[ai][bj][m][0] + bv[bj][0], v1 = acc[ai][bj][m][1] + bv[bj][1];
#pragma unroll
                    for (int i = 0; i < 4; ++i) { v0[i] = act_apply(act, v0[i]); v1[i] = act_apply(act, v1[i]); }
                    if (c0 < cvalid) st8(O + ((size_t)r * ldo + coff + c0) * 2, v0, v1); } }
    } else if (P.kind == K_RES) {
        unsigned char* H = P.O;
#pragma unroll
        for (int ai = 0; ai < 2; ++ai)
#pragma unroll
            for (int m = 0; m < 4; ++m) { if ((m & 1) == 0) __builtin_amdgcn_sched_barrier(0); const int r = rbase + ai * 128 + m * 16; float sq = 0.f;
#pragma unroll
                for (int bj = 0; bj < 2; ++bj) { unsigned char* ptr = H + ((size_t)r * 1024 + cbase + bj * 128) * 2;
                    const u32x4 old = *(const u32x4*)ptr; u32x4 o; const f32x4 a0 = acc[ai][bj][m][0], a1 = acc[ai][bj][m][1];
                    o[0] = pk2(bflo(old[0]) + a0[0], bfhi(old[0]) + a0[1]); o[1] = pk2(bflo(old[1]) + a0[2], bfhi(old[1]) + a0[3]);
                    o[2] = pk2(bflo(old[2]) + a1[0], bfhi(old[2]) + a1[1]); o[3] = pk2(bflo(old[3]) + a1[2], bfhi(old[3]) + a1[3]);
#pragma unroll
                    for (int i = 0; i < 4; ++i) { const float rl = bflo(o[i]), rh = bfhi(o[i]); sq += rl * rl + rh * rh; }
                    *(u32x4*)ptr = o; }
                if (P.ss) { sq += __shfl_xor(sq, 16); sq += __shfl_xor(sq, 32); if (fq == 0) P.ss[(size_t)(u.pn * 4 + wc) * RP + r] = sq; } }
    } else if (P.kind == K_U) {
#pragma unroll
        for (int ai = 0; ai < 2; ++ai)
#pragma unroll
            for (int m = 0; m < 4; ++m) { if ((m & 1) == 0) __builtin_amdgcn_sched_barrier(0); const int r = rbase + ai * 128 + m * 16; const float rs = P.ssin[r];
#pragma unroll
                for (int bj = 0; bj < 2; ++bj) st8(P.O + ((size_t)r * 5632 + cbase + bj * 128) * 2, acc[ai][bj][m][0] * rs, acc[ai][bj][m][1] * rs); }
    } else if (P.kind == K_CH) {
#pragma unroll
        for (int bj = 0; bj < 2; ++bj) { const int n0 = cbase + bj * 128; const int s = n0 / cx.Tp, t = n0 - s * cx.Tp;
#pragma unroll
            for (int ai = 0; ai < 2; ++ai)
#pragma unroll
                for (int m = 0; m < 4; ++m) { if ((m & 1) == 0) __builtin_amdgcn_sched_barrier(0); const int rr = rbase + ai * 128 + m * 16; const int cs = rr >> 10, ch = rr & 1023;
                    st8(P.O + ((((size_t)s * 1024 + ch) * 2 + cs) * cx.Tp + t) * 2, acc[ai][bj][m][0], acc[ai][bj][m][1]); } }
    } else {
#pragma unroll
        for (int ai = 0; ai < 2; ++ai)
#pragma unroll
            for (int m = 0; m < 4; ++m) { if ((m & 1) == 0) __builtin_amdgcn_sched_barrier(0); const int k = rbase + ai * 128 + m * 16; const size_t row = (size_t)u.s * cx.T + k;
#pragma unroll
                for (int bj = 0; bj < 2; ++bj) if (k < cx.T) st8(P.O + (row * 1024 + cbase + bj * 128) * 2, acc[ai][bj][m][0], acc[ai][bj][m][1]); }
    }
}

template <int KIND> __device__ __forceinline__ void gemm_phase(LAS unsigned char* lds, GemmPh P, const Params& p, const Ctx& cx) {
    P.kind = KIND;
    const int tid = ltid(), wid = __builtin_amdgcn_readfirstlane(tid >> 6), lane = tid & 63, wr = wid >> 2, wc = wid & 3, fr = lane & 15, fq = lane >> 4;
    const int nt = P.K / BK;
    unsigned voffA[2], voffB[2];
#pragma unroll
    for (int i = 0; i < 2; ++i) { int R, C; stage_rc(tid * 16 + i * 8192, R, C); const int Rb = (R & ~31) + perm32(R & 31);
        voffA[i] = (unsigned)(R * P.lda + C) * 2u; voffB[i] = (unsigned)(Rb * P.ldb + C) * 2u; }
    const size_t kstep = (size_t)(BK * 2);
    const size_t hstepA = (size_t)HALF * P.lda * 2, hstepB = (size_t)HALF * P.ldb * 2;
    const unsigned ldsw = (unsigned)wid * 1024u;
    const int aoff = lds_byte(wr * 64 + fr, fq * 8), boff = lds_byte(wc * 32 + fr, fq * 8);
#define PG8_SA(b, h) (((b) * 2 + (h)) * HTB)
#define PG8_SB(b, h) ((4 + (b) * 2 + (h)) * HTB)
#define PG8_STAGE(bufoff, gbase, voff) do { _Pragma("unroll") for (int _i = 0; _i < 2; ++_i) \
        __builtin_amdgcn_global_load_lds((const unsigned*)((const char*)(gbase) + (voff)[_i]), (LAS unsigned*)(lds + (bufoff) + ldsw + _i * 8192), 16, 0, 0); } while (0)
#define PG8_LDA(dst, b, h) do { _Pragma("unroll") for (int m = 0; m < 4; ++m) _Pragma("unroll") for (int k = 0; k < 2; ++k) dst[m][k] = *(const LAS bf16x8*)(lds + PG8_SA(b, h) + aoff + m * 2048 + k * 1024); } while (0)
#define PG8_LDB(dst, b, h) do { _Pragma("unroll") for (int n = 0; n < 2; ++n) _Pragma("unroll") for (int k = 0; k < 2; ++k) dst[n][k] = *(const LAS bf16x8*)(lds + PG8_SB(b, h) + boff + n * 2048 + k * 1024); } while (0)
#define PG8_MMA(ai, bj, At, Bt) do { __builtin_amdgcn_s_setprio(1); _Pragma("unroll") for (int m = 0; m < 4; ++m) _Pragma("unroll") for (int n = 0; n < 2; ++n) _Pragma("unroll") for (int k = 0; k < 2; ++k) \
        acc[ai][bj][m][n] = __builtin_amdgcn_mfma_f32_16x16x32_bf16(Bt[n][k], At[m][k], acc[ai][bj][m][n], 0, 0, 0); __builtin_amdgcn_s_setprio(0); } while (0)
#define PG8_WAIT_V(n) asm volatile("s_waitcnt vmcnt(" #n ")" ::: "memory")
#define PG8_WAIT_L(n) asm volatile("s_waitcnt lgkmcnt(" #n ")" ::: "memory")
#define PG8_BAR __builtin_amdgcn_s_barrier()
#define PG8_SCHED __builtin_amdgcn_sched_barrier(0)
    Unit cur, nxt; int ui = 0;
    if (!next_unit(P, p, cx, 0, cur)) return;
    f32x4 acc[2][2][4][2];
#pragma unroll
    for (int a = 0; a < 2; ++a)
#pragma unroll
        for (int b = 0; b < 2; ++b)
#pragma unroll
            for (int m = 0; m < 4; ++m)
#pragma unroll
                for (int n = 0; n < 2; ++n) acc[a][b][m][n] = (f32x4){0.f, 0.f, 0.f, 0.f};
    bf16x8 At[4][2], B0[2][2], B1[2][2];
    const char* cA = cur.A; const char* cB = cur.B;
    PG8_STAGE(PG8_SB(0, 0), cB, voffB); PG8_STAGE(PG8_SA(0, 0), cA, voffA); PG8_STAGE(PG8_SB(0, 1), cB + hstepB, voffB); PG8_STAGE(PG8_SA(0, 1), cA + hstepA, voffA);
    if (wr == 1) PG8_BAR;
    PG8_WAIT_V(4); PG8_BAR;
    PG8_STAGE(PG8_SB(1, 0), cB + kstep, voffB); PG8_STAGE(PG8_SA(1, 0), cA + kstep, voffA); PG8_STAGE(PG8_SB(1, 1), cB + hstepB + kstep, voffB);
    PG8_WAIT_V(6); PG8_BAR;
    for (;;) {
        const bool has_next = next_unit(P, p, cx, ui + 1, nxt);
        const char* nA = has_next ? nxt.A : cA; const char* nB = has_next ? nxt.B : cB;
        for (int t = 0; t < nt; t += 2) {
            const bool last = (t == nt - 2);
            const char* a1 = cA + (size_t)(t + 1) * kstep;
            const char* a2 = last ? nA : cA + (size_t)(t + 2) * kstep; const char* b2 = last ? nB : cB + (size_t)(t + 2) * kstep;
            const char* a3 = a2 + kstep; const char* b3 = b2 + kstep;
            PG8_LDB(B0, 0, 0); PG8_SCHED; PG8_LDA(At, 0, 0); PG8_STAGE(PG8_SA(1, 1), a1 + hstepA, voffA);
            PG8_WAIT_L(8); PG8_BAR; PG8_WAIT_L(0); PG8_MMA(0, 0, At, B0); PG8_BAR; PG8_SCHED;
            PG8_LDB(B1, 0, 1); PG8_STAGE(PG8_SB(0, 0), b2, voffB);
            PG8_BAR; PG8_WAIT_L(0); PG8_MMA(0, 1, At, B1); PG8_BAR;
            PG8_LDA(At, 0, 1); PG8_STAGE(PG8_SA(0, 0), a2, voffA);
            PG8_BAR; PG8_WAIT_L(0); PG8_MMA(1, 0, At, B0); PG8_BAR; PG8_SCHED;
            PG8_STAGE(PG8_SB(0, 1), b2 + hstepB, voffB);
            PG8_WAIT_V(6); PG8_BAR; PG8_MMA(1, 1, At, B1); PG8_BAR;
            PG8_LDB(B0, 1, 0); PG8_SCHED; PG8_LDA(At, 1, 0); PG8_STAGE(PG8_SA(0, 1), a2 + hstepA, voffA);
            PG8_WAIT_L(8); PG8_BAR; PG8_WAIT_L(0); PG8_MMA(0, 0, At, B0); PG8_BAR; PG8_SCHED;
            PG8_LDB(B1, 1, 1); PG8_STAGE(PG8_SB(1, 0), b3, voffB);
            PG8_BAR; PG8_WAIT_L(0); PG8_MMA(0, 1, At, B1); PG8_BAR;
            PG8_LDA(At, 1, 1); PG8_STAGE(PG8_SA(1, 0), a3, voffA);
            PG8_BAR; PG8_WAIT_L(0); PG8_MMA(1, 0, At, B0); PG8_BAR; PG8_SCHED;
            PG8_STAGE(PG8_SB(1, 1), b3 + hstepB, voffB);
            PG8_WAIT_V(6); PG8_BAR; PG8_MMA(1, 1, At, B1); PG8_BAR;
        }
        epilogue(P, p, cx, acc, cur, wr, wc, fr, fq);
        if (!has_next) break;
#pragma unroll
        for (int a = 0; a < 2; ++a)
#pragma unroll
            for (int b = 0; b < 2; ++b)
#pragma unroll
                for (int m = 0; m < 4; ++m)
#pragma unroll
                    for (int n = 0; n < 2; ++n) acc[a][b][m][n] = (f32x4){0.f, 0.f, 0.f, 0.f};
        cur = nxt; cA = nA; cB = nB; ++ui;
    }
    PG8_WAIT_V(0);
    if (wr == 0) PG8_BAR;
    PG8_BAR;
#undef PG8_SA
#undef PG8_SB
#undef PG8_STAGE
#undef PG8_LDA
#undef PG8_LDB
#undef PG8_MMA
#undef PG8_WAIT_V
#undef PG8_WAIT_L
#undef PG8_BAR
#undef PG8_SCHED
}

__device__ __forceinline__ void tr_job(LAS float* tile, const float* src, int K, int N, unsigned char* dst, int ldk, int koff, int Kpad, int Npad, const float* scale, int& cnt, int stride_start, int G) {
    const int tk = Kpad / 64, tn = Npad / 64, ntile = tk * tn; const int tid = ltid();
    for (int it = 0; it < ntile; ++it, ++cnt) {
        if ((cnt % G) != stride_start) continue;
        const int k0 = (it / tn) * 64, n0 = (it % tn) * 64;
        __syncthreads();
        { const int tx = tid & 63, ty = tid >> 6;
#pragma unroll
            for (int i = 0; i < 8; ++i) { const int kd = k0 + ty + 8 * i, ks = kd - koff, n = n0 + tx; float v = 0.f;
                if (ks >= 0 && ks < K && n < N) { v = src[(size_t)ks * N + n]; if (scale) v *= scale[ks]; }
                tile[(ty + 8 * i) * 65 + tx] = v; } }
        __syncthreads();
        { const int n = tid >> 3, kc = (tid & 7) * 8; u32x4 o;
#pragma unroll
            for (int i = 0; i < 4; ++i) o[i] = pk2(tile[(kc + 2 * i) * 65 + n], tile[(kc + 2 * i + 1) * 65 + n]);
            *(u32x4*)(dst + ((size_t)(n0 + n) * ldk + k0 + kc) * 2) = o; }
    }
}

__device__ __forceinline__ void prep_phase(LAS unsigned char* lds, const Params& p) {
    LAS float* tile = (LAS float*)lds; unsigned char* ws = p.ws; int cnt = 0; const int b = blockIdx.x, G = gridDim.x;
    for (int i = 0; i < 3; ++i) tr_job(tile, p.in[7] + (size_t)i * D * D, D, D, ws + O_WRKV + (size_t)i * D * D * 2, 1024, 0, 1024, 1024, nullptr, cnt, b, G);
    tr_job(tile, p.in[14], D, 160, ws + O_G1, 1024, 0, 1024, 256, nullptr, cnt, b, G);
    tr_job(tile, p.in[9], D, 64, ws + O_W1, 1024, 0, 1024, 64, nullptr, cnt, b, G);
    tr_job(tile, p.in[9] + D * 64, D, 64, ws + O_W1 + (size_t)64 * 1024 * 2, 1024, 0, 1024, 192, nullptr, cnt, b, G);
    tr_job(tile, p.in[12], D, 64, ws + O_A1, 1024, 0, 1024, 64, nullptr, cnt, b, G);
    tr_job(tile, p.in[12] + D * 64, D, 64, ws + O_A1 + (size_t)64 * 1024 * 2, 1024, 0, 1024, 192, nullptr, cnt, b, G);
    for (int z = 0; z < 2; ++z) {
        tr_job(tile, p.in[10] + (size_t)z * 64 * D, 64, D, ws + O_L2 + (size_t)z * 1024 * 256 * 2, 256, z * 64, 256, 1024, nullptr, cnt, b, G);
        tr_job(tile, p.in[13] + (size_t)z * 64 * D, 64, D, ws + O_L2 + (size_t)(2 + z) * 1024 * 256 * 2, 256, (2 + z) * 64, 256, 1024, nullptr, cnt, b, G);
    }
    tr_job(tile, p.in[15], 160, D, ws + O_G2, 256, 0, 256, 1024, nullptr, cnt, b, G);
    tr_job(tile, p.in[21], D, D, ws + O_WO, 1024, 0, 1024, 1024, nullptr, cnt, b, G);
    tr_job(tile, p.in[22], D, D, ws + O_WF, 1024, 0, 1024, 1024, nullptr, cnt, b, G);
    for (int l = 0; l < 2; ++l) {
        tr_job(tile, p.in[23] + (size_t)l * D * 5632, D, 5632, ws + O_WIN + (size_t)l * 5632 * 1024 * 2, 1024, 0, 1024, 5632, p.in[4] + l * D, cnt, b, G);
        tr_job(tile, p.in[26] + (size_t)l * DFF * D, DFF, D, ws + O_WOUT + (size_t)l * 1024 * DFF * 2, DFF, 0, DFF, 1024, nullptr, cnt, b, G);
    }
    const size_t gt = (size_t)blockIdx.x * 512 + ltid(), NT = (size_t)gridDim.x * 512;
    const float* nm1 = p.in[3] + D;
    for (size_t e = gt; e < (size_t)2048 * 128; e += NT) {
        const int rr = (int)(e >> 7), c0 = (int)(e & 127) * 8; const int cs = rr >> 10, ch = rr & 1023; float v[8];
#pragma unroll
        for (int i = 0; i < 8; ++i) { const int c = c0 + i; float val = 0.f;
            if ((c >> 7) == (ch >> 7)) { const int m = ((ch & 127) * (c & 127)) & 127; float sn, cn; sincospif((float)m * (1.f / 64.f), &sn, &cn); val = (cs ? sn : cn) * nm1[c] * 0.08838834764831845f; }
            v[i] = val; }
        u32x4 o; o[0] = pk2(v[0], v[1]); o[1] = pk2(v[2], v[3]); o[2] = pk2(v[4], v[5]); o[3] = pk2(v[6], v[7]);
        *(u32x4*)(ws + O_CHD + e * 16) = o;
    }
    for (int ty = 0; ty < 2; ++ty) {
        const int T = ty ? 4112 : 2064, Tp = ty ? TP_S : TP_P, Mp = ty ? MP_S : MP_P; const int rowv = 2 * Tp / 8;
        unsigned char* dst = ws + (ty ? O_DFTS : O_DFTP); const float isq = rsqrtf((float)T), invT = 2.f / (float)T;
        for (size_t e = gt; e < (size_t)Mp * rowv; e += NT) {
            const int k = (int)(e / rowv), kk0 = (int)(e % rowv) * 8; float v[8];
#pragma unroll
            for (int i = 0; i < 8; ++i) { const int kk = kk0 + i; const int issin = kk >= Tp, t = issin ? kk - Tp : kk; float val = 0.f;
                if (k < T && (issin ? (t >= 1 && t <= T / 2 - 1) : (t <= T / 2))) { const int m = (int)(((long)k * t) % T); float sn, cn; sincospif((float)m * invT, &sn, &cn); val = (issin ? -sn : cn) * isq; }
                v[i] = val; }
            u32x4 o; o[0] = pk2(v[0], v[1]); o[1] = pk2(v[2], v[3]); o[2] = pk2(v[4], v[5]); o[3] = pk2(v[6], v[7]);
            *(u32x4*)(dst + e * 16) = o;
        }
    }
}

__device__ __forceinline__ void ea_load_row(const Params& p, const Ctx& c, int s, int pos, int lane, float (&v)[16]) {
    if (pos < 0 || pos >= c.T) {
#pragma unroll
        for (int i = 0; i < 16; ++i) v[i] = 0.f;
        return; }
    const float* src = pos < NMETA ? p.in[2] + (size_t)pos * D : c.x + ((size_t)s * (c.T - NMETA) + (pos - NMETA)) * D;
#pragma unroll
    for (int j = 0; j < 4; ++j) { const f32x4 t = *(const f32x4*)(src + j * 256 + lane * 4); v[4 * j] = t[0]; v[4 * j + 1] = t[1]; v[4 * j + 2] = t[2]; v[4 * j + 3] = t[3]; }
}
__device__ __forceinline__ void ea_store_row(unsigned char* base, size_t row, int lane, const float (&v)[16]) {
#pragma unroll
    for (int j = 0; j < 4; ++j) { u32x2 o; o[0] = pk2(v[4 * j], v[4 * j + 1]); o[1] = pk2(v[4 * j + 2], v[4 * j + 3]); *(u32x2*)(base + (row * 1024 + j * 256 + lane * 4) * 2) = o; }
}
__device__ __forceinline__ void ea_norm(float (&v)[16], const float (&nw)[16]) {
    float ss = 0.f;
#pragma unroll
    for (int i = 0; i < 16; ++i) ss += v[i] * v[i];
    ss = wave_sum(ss); const float rs = rsqrtf(ss * (1.f / 1024.f) + 1e-6f);
#pragma unroll
    for (int i = 0; i < 16; ++i) v[i] = v[i] * rs * nw[i];
}
__device__ __forceinline__ void phase_mix(const Params& p, const Ctx& c) {
    const int wave = __builtin_amdgcn_readfirstlane(ltid() >> 6), lane = ltid() & 63;
    const int gw = blockIdx.x * 8 + wave, NW = gridDim.x * 8;
    float nw[16];
#pragma unroll
    for (int j = 0; j < 4; ++j) { const f32x4 t = *(const f32x4*)(p.in[3] + j * 256 + lane * 4); nw[4 * j] = t[0]; nw[4 * j + 1] = t[1]; nw[4 * j + 2] = t[2]; nw[4 * j + 3] = t[3]; }
    const int nstrips = c.R / 16, spq = c.T / 16;
    for (int st = gw; st < nstrips; st += NW) {
        const int s = st / spq, pos0 = (st - s * spq) * 16; const size_t row0 = (size_t)st * 16;
        float prev[16], cur[16], nx[16];
        ea_load_row(p, c, s, pos0 - 1, lane, prev); ea_norm(prev, nw);
        ea_load_row(p, c, s, pos0, lane, cur); ea_store_row(slot(p, 0), row0, lane, cur); ea_norm(cur, nw);
        for (int i = 0; i < 16; ++i) {
            ea_load_row(p, c, s, pos0 + i + 1, lane, nx);
            if (i < 15) ea_store_row(slot(p, 0), row0 + i + 1, lane, nx);
            ea_norm(nx, nw);
            float xx[16], o[16];
#pragma unroll
            for (int e = 0; e < 16; ++e) xx[e] = 0.5f * (prev[e] + nx[e]) - cur[e];
            for (int m = 0; m < 6; ++m) {
#pragma unroll
                for (int j = 0; j < 4; ++j) { const f32x4 t = *(const f32x4*)(p.in[6] + m * D + j * 256 + lane * 4);
#pragma unroll
                    for (int e = 0; e < 4; ++e) o[4 * j + e] = cur[4 * j + e] + xx[4 * j + e] * t[e]; }
                ea_store_row(slot(p, 1 + m), row0 + i, lane, o); }
#pragma unroll
            for (int e = 0; e < 16; ++e) { prev[e] = cur[e]; cur[e] = nx[e]; }
        }
    }
}

__device__ __forceinline__ void phase_prescan(const Params& p, const Ctx& c) {
    const int wave = __builtin_amdgcn_readfirstlane(ltid() >> 6), lane = ltid() & 63;
    const int gw = blockIdx.x * 8 + wave, NW = gridDim.x * 8; const int ch0 = lane * 16;
    float kkw[16], kaw[16], rkw[16];
    load16f(p.in[16] + ch0, kkw); load16f(p.in[17] + ch0, kaw); load16f(p.in[18] + ch0, rkw);
    float* bonus = (float*)(p.ws + O_BONUS);
    for (int row = gw; row < c.R; row += NW) {
        const size_t e = (size_t)row * 1024 + ch0;
        float k[16], a0[16], a1[16], r[16];
        load16bf(slot(p, 8), e, k); load16bf(slot(p, 3), e, a0); load16bf(slot(p, 4), e, a1); load16bf(slot(p, 7), e, r);
        float kk[16], n2 = 0.f;
#pragma unroll
        for (int i = 0; i < 16; ++i) { kk[i] = k[i] * kkw[i]; n2 += kk[i] * kk[i]; }
        n2 += __shfl_xor(n2, 1); n2 += __shfl_xor(n2, 2);
        const float inv = 1.f / fmaxf(sqrtf(n2), 1e-12f);
        float kd0[16], kd1[16], bon = 0.f;
#pragma unroll
        for (int i = 0; i < 16; ++i) { kk[i] *= inv; kd0[i] = k[i] * (1.f + (a0[i] - 1.f) * kaw[i]); kd1[i] = k[i] * (1.f + (a1[i] - 1.f) * kaw[i]);
            bon += r[i] * (kd0[i] + kd1[i]) * rkw[i]; a0[i] *= kk[i]; a1[i] *= kk[i]; }
        bon += __shfl_xor(bon, 1); bon += __shfl_xor(bon, 2);
        if ((lane & 3) == 0) bonus[(size_t)row * 16 + (lane >> 2)] = bon;
        store16bf(slot(p, 8), e, kk); store16bf(slot(p, 3), e, a0); store16bf(slot(p, 4), e, a1);
        store16bf(slot(p, 6), e, kd0); store16bf(slot(p, 10), e, kd1);
    }
}

__device__ __forceinline__ float half_sum(float x) {
    const unsigned a = __float_as_uint(x); auto r = __builtin_amdgcn_permlane32_swap(a, a, false, false);
    return __uint_as_float(r[0]) + __uint_as_float(r[1]);
}
__device__ __forceinline__ float ldbf(const unsigned char* base, int idx) { return __uint_as_float(((unsigned)((const bf16_t*)base)[idx]) << 16); }
__device__ __forceinline__ float quarter_sum(float x) {
    const unsigned a = __float_as_uint(x); auto r = __builtin_amdgcn_permlane16_swap(a, a, false, false);
    return half_sum(__uint_as_float(r[0]) + __uint_as_float(r[1]));
}
template <int RPL, int JP, int RING>
__device__ __forceinline__ void scan_items(LAS unsigned char* lds, const Params& p, const Ctx& c) {
    constexpr int LR = 64 / JP, NJ = 64 / JP, ROWS = LR * RPL, WPS = 64 / ROWS, NQ = NJ / 4, BQ = RPL == 2 ? 1 : 2, NB = NQ / BQ;
    const int tid = ltid(); const int wave = __builtin_amdgcn_readfirstlane(tid >> 6), lane = tid & 63;
    const int nitem = c.nseq * 32 * WPS; const int lr = lane % LR, jp = lane / LR;
    LAS float* wb = (LAS float*)(lds + wave * 16384);
    LAS float* oring = wb + 1024;
    for (int w = blockIdx.x + gridDim.x * wave; w < nitem; w += gridDim.x * 8) {
        const int q = w / WPS, rq = w % WPS; const int dir = q & 1, hh = (q >> 1) & 15, s = q >> 5;
        const size_t e0 = (size_t)s * c.T * 1024 + hh * 64;
        const unsigned char* Rb = slot(p, 7) + e0 * 2; const unsigned char* Kkb = slot(p, 8) + e0 * 2; const unsigned char* Vb = slot(p, 9) + e0 * 2;
        const unsigned char* Ngb = slot(p, 1 + dir) + e0 * 2; const unsigned char* Bdb = slot(p, 3 + dir) + e0 * 2;
        const unsigned char* Kdb = slot(p, dir ? 10 : 6) + e0 * 2; unsigned char* Ob = slot(p, 11 + dir) + e0 * 2;
        const int vrow0 = rq * ROWS + lr;
        const int step = dir ? -2048 : 2048; const long ro0 = dir ? (long)(c.T - 1) * 2048 : 0;
        f32x2 S2[RPL][NJ / 2];
#pragma unroll
        for (int a_ = 0; a_ < RPL; ++a_)
#pragma unroll
            for (int j = 0; j < NJ / 2; ++j) S2[a_][j] = (f32x2){0.f, 0.f};
        float xr[RING][5 + RPL];
#define SCAN_LD(dst, tt) do { const int _t = (tt) < c.T ? (tt) : c.T - 1; const long _r = ro0 + (long)_t * step; \
            dst[0] = ldbf(Kkb + _r, lane); dst[1] = ldbf(Ngb + _r, lane); dst[2] = ldbf(Bdb + _r, lane); dst[3] = ldbf(Kdb + _r, lane); dst[4] = ldbf(Rb + _r, lane); \
            _Pragma("unroll") for (int _a = 0; _a < RPL; ++_a) dst[5 + _a] = ldbf(Vb + _r, vrow0 + _a * LR); } while (0)
#define SCAN_RD4(dst, base, jj) do { _Pragma("unroll") for (int _h = 0; _h < BQ; ++_h) { dst[4 * _h] = ((const LAS f32x4*)((base) + 64))[(jj) + _h]; dst[4 * _h + 1] = ((const LAS f32x4*)((base) + 128))[(jj) + _h]; \
            dst[4 * _h + 2] = ((const LAS f32x4*)((base) + 192))[(jj) + _h]; dst[4 * _h + 3] = ((const LAS f32x4*)((base) + 256))[(jj) + _h]; } } while (0)
        float vi[RPL];
        { float x[5 + RPL]; SCAN_LD(x, 0); wb[lane] = x[0]; wb[64 + lane] = x[1]; wb[128 + lane] = x[2]; wb[192 + lane] = x[3]; wb[256 + lane] = x[4];
#pragma unroll
          for (int a_ = 0; a_ < RPL; ++a_) vi[a_] = x[5 + a_]; }
#pragma unroll
        for (int k = 1; k < RING; ++k) SCAN_LD(xr[k], k);
        SCAN_LD(xr[0], RING);
        f32x4 kq[NQ];
#pragma unroll
        for (int j = 0; j < NQ; ++j) kq[j] = ((const LAS f32x4*)(wb + jp * NJ))[j];
        int fstart = 0;
        for (int tb = 0; tb < c.T; tb += RING) {
#pragma unroll
            for (int k = 0; k < RING; ++k) {
                const int t = tb + k;
                const LAS float* sb = wb + (k & 1) * 512 + jp * NJ; LAS float* sn = wb + ((k + 1) & 1) * 512;
                f32x4 PQ[2][4 * BQ];
                SCAN_RD4(PQ[0], sb, 0);
                __builtin_amdgcn_sched_barrier(0);
                float sa[RPL];
#pragma unroll
                for (int a_ = 0; a_ < RPL; ++a_) { f32x2 a0 = (f32x2){0.f, 0.f}, a1 = (f32x2){0.f, 0.f};
#pragma unroll
                    for (int j = 0; j < NQ; ++j) { a0 = __builtin_elementwise_fma(S2[a_][2 * j], (f32x2){kq[j][0], kq[j][1]}, a0); a1 = __builtin_elementwise_fma(S2[a_][2 * j + 1], (f32x2){kq[j][2], kq[j][3]}, a1); }
                    sa[a_] = (a0[0] + a0[1]) + (a1[0] + a1[1]); }
                float (&xs)[5 + RPL] = xr[(k + 1) % RING];
                sn[lane] = xs[0]; sn[64 + lane] = xs[1]; sn[128 + lane] = xs[2]; sn[192 + lane] = xs[3]; sn[256 + lane] = xs[4];
                float vcur[RPL];
#pragma unroll
                for (int a_ = 0; a_ < RPL; ++a_) { vcur[a_] = vi[a_]; vi[a_] = xs[5 + a_]; }
                SCAN_LD(xs, t + 1 + RING);
                f32x2 sa2[RPL], v2[RPL], oa0[RPL], oa1[RPL];
#pragma unroll
                for (int a_ = 0; a_ < RPL; ++a_) { const float sr = -(JP == 2 ? half_sum(sa[a_]) : quarter_sum(sa[a_])); sa2[a_] = (f32x2){sr, sr}; v2[a_] = (f32x2){vcur[a_], vcur[a_]};
                    oa0[a_] = (f32x2){0.f, 0.f}; oa1[a_] = (f32x2){0.f, 0.f}; }
#pragma unroll
                for (int b_ = 0; b_ < NB; ++b_) {
                    if (b_ + 1 < NB) { SCAN_RD4(PQ[(b_ + 1) & 1], sb, BQ * (b_ + 1)); }
                    else {
#pragma unroll
                        for (int j = 0; j < NQ; ++j) kq[j] = ((const LAS f32x4*)(sn + jp * NJ))[j];
                    }
                    __builtin_amdgcn_sched_barrier(0);
#pragma unroll
                    for (int h_ = 0; h_ < BQ; ++h_) { const f32x4 g4 = PQ[b_ & 1][4 * h_], b4 = PQ[b_ & 1][4 * h_ + 1], d4 = PQ[b_ & 1][4 * h_ + 2], r4 = PQ[b_ & 1][4 * h_ + 3]; const int j_ = 2 * (BQ * b_ + h_);
#pragma unroll
                        for (int a_ = 0; a_ < RPL; ++a_) { f32x2 s0 = S2[a_][j_], s1 = S2[a_][j_ + 1];
                            s0 = __builtin_elementwise_fma(s0, (f32x2){g4[0], g4[1]}, s0); s1 = __builtin_elementwise_fma(s1, (f32x2){g4[2], g4[3]}, s1);
                            s0 = __builtin_elementwise_fma(sa2[a_], (f32x2){b4[0], b4[1]}, s0); s1 = __builtin_elementwise_fma(sa2[a_], (f32x2){b4[2], b4[3]}, s1);
                            s0 = __builtin_elementwise_fma(v2[a_], (f32x2){d4[0], d4[1]}, s0); s1 = __builtin_elementwise_fma(v2[a_], (f32x2){d4[2], d4[3]}, s1);
                            S2[a_][j_] = s0; S2[a_][j_ + 1] = s1;
                            oa0[a_] = __builtin_elementwise_fma(s0, (f32x2){r4[0], r4[1]}, oa0[a_]); oa1[a_] = __builtin_elementwise_fma(s1, (f32x2){r4[2], r4[3]}, oa1[a_]); } }
                    __builtin_amdgcn_sched_barrier(0);
                }
#pragma unroll
                for (int a_ = 0; a_ < RPL; ++a_) { const float os_ = (oa0[a_][0] + oa0[a_][1]) + (oa1[a_][0] + oa1[a_][1]); const float ov = JP == 2 ? half_sum(os_) : quarter_sum(os_);
                    if (jp == 0) oring[(t & 63) * ROWS + a_ * LR + lr] = ov; }
            }
            const int tend = tb + RING, nfl = tend - fstart;
            if (nfl == 64 || tend >= c.T) {
                for (int idx = lane; idx < nfl * ROWS; idx += 64) { const int st = idx / ROWS, row = idx % ROWS;
                    ((bf16_t*)(Ob + ro0 + (long)(fstart + st) * step))[rq * ROWS + row] = (bf16_t)(pk2(oring[idx], 0.f) & 0xffffu); }
                fstart = tend;
            }
        }
#undef SCAN_LD
#undef SCAN_RD4
    }
}
__device__ __forceinline__ void phase_scan(LAS unsigned char* lds, const Params& p, const Ctx& c) {
    if (c.g < 2) scan_items<1, 2, 8>(lds, p, c); else scan_items<1, 4, 8>(lds, p, c);
}

__device__ __forceinline__ void phase_postscan(const Params& p, const Ctx& c) {
    const int wave = __builtin_amdgcn_readfirstlane(ltid() >> 6), lane = ltid() & 63;
    const int gw = blockIdx.x * 8 + wave, NW = gridDim.x * 8; const int ch0 = lane * 16;
    float gw_[16], gb_[16]; load16f(p.in[19] + ch0, gw_); load16f(p.in[20] + ch0, gb_);
    const float* bonus = (const float*)(p.ws + O_BONUS);
    for (int row = gw; row < c.R; row += NW) {
        const size_t e = (size_t)row * 1024 + ch0;
        float of[16], ob[16], v[16], g[16];
        load16bf(slot(p, 11), e, of); load16bf(slot(p, 12), e, ob); load16bf(slot(p, 9), e, v); load16bf(slot(p, 5), e, g);
        float sum = 0.f;
#pragma unroll
        for (int i = 0; i < 16; ++i) { of[i] += ob[i]; sum += of[i]; }
        sum += __shfl_xor(sum, 1); sum += __shfl_xor(sum, 2); const float mean = sum * (1.f / 64.f);
        float var = 0.f;
#pragma unroll
        for (int i = 0; i < 16; ++i) { of[i] -= mean; var += of[i] * of[i]; }
        var += __shfl_xor(var, 1); var += __shfl_xor(var, 2); const float rs = rsqrtf(var * (1.f / 64.f) + 64e-5f);
        const float bon = bonus[(size_t)row * 16 + (lane >> 2)];
#pragma unroll
        for (int i = 0; i < 16; ++i) of[i] = (of[i] * rs * gw_[i] + gb_[i] + bon * v[i]) * g[i];
        store16bf(slot(p, 1), e, of);
    }
}

__device__ __forceinline__ void phase_glu(const Params& p, const Ctx& c, int layer) {
    const size_t gt = (size_t)blockIdx.x * 512 + ltid(), NT = (size_t)gridDim.x * 512;
    const unsigned char* U = slot(p, 1); unsigned char* Aout = slot(p, 7);
    const float* cw = p.in[24] + (size_t)layer * 3 * DFF; const float* cb = p.in[25] + (size_t)layer * DFF;
    const size_t nitem = (size_t)c.R * 352;
    for (size_t it = gt; it < nitem; it += NT) {
        const int row = (int)(it / 352), cc = (int)(it % 352) * 8; const int pos = row % c.T;
        const unsigned char* ur = U + (size_t)row * 5632 * 2 + cc * 2;
        const u32x4 z = (u32x4){0u, 0u, 0u, 0u};
        const u32x4 pm = pos > 0 ? *(const u32x4*)(ur - 5632 * 2) : z, pc = *(const u32x4*)ur, pp = pos < c.T - 1 ? *(const u32x4*)(ur + 5632 * 2) : z;
        const u32x4 ln = *(const u32x4*)(ur + DFF * 2);
        float w0[8], w1[8], w2[8], bb[8];
#pragma unroll
        for (int h = 0; h < 2; ++h) { const f32x4 a = *(const f32x4*)(cw + cc + 4 * h), b = *(const f32x4*)(cw + DFF + cc + 4 * h), d = *(const f32x4*)(cw + 2 * DFF + cc + 4 * h), e = *(const f32x4*)(cb + cc + 4 * h);
#pragma unroll
            for (int i = 0; i < 4; ++i) { w0[4 * h + i] = a[i]; w1[4 * h + i] = b[i]; w2[4 * h + i] = d[i]; bb[4 * h + i] = e[i]; } }
        u32x4 o;
#pragma unroll
        for (int i = 0; i < 4; ++i) {
            const float c0 = bflo(pm[i]) * w0[2 * i] + bflo(pc[i]) * w1[2 * i] + bflo(pp[i]) * w2[2 * i] + bb[2 * i];
            const float c1 = bfhi(pm[i]) * w0[2 * i + 1] + bfhi(pc[i]) * w1[2 * i + 1] + bfhi(pp[i]) * w2[2 * i + 1] + bb[2 * i + 1];
            o[i] = pk2(c0 * sigmoidf_(c0) * bflo(ln[i]), c1 * sigmoidf_(c1) * bfhi(ln[i])); }
        *(u32x4*)(Aout + ((size_t)row * DFF + cc) * 2) = o;
    }
}

__device__ __forceinline__ void phase_final(const Params& p, const Ctx& c) {
    const int wave = __builtin_amdgcn_readfirstlane(ltid() >> 6), lane = ltid() & 63;
    const int gw = blockIdx.x * 8 + wave, NW = gridDim.x * 8; const int ch0 = lane * 16;
    float nf[16]; load16f(p.in[5] + ch0, nf);
    const int To = c.T - NMETA, nrow = c.nseq * To;
    for (int q = gw; q < nrow; q += NW) {
        const int s = q / To, po = q - s * To; const size_t row = (size_t)s * c.T + NMETA + po;
        float h[16]; load16bf(slot(p, 0), row * 1024 + ch0, h);
        float ss = 0.f;
#pragma unroll
        for (int i = 0; i < 16; ++i) ss += h[i] * h[i];
        ss = wave_sum(ss); const float rs = rsqrtf(ss * (1.f / 1024.f) + 1e-6f);
        float* dst = c.y + (size_t)q * 1024 + ch0;
#pragma unroll
        for (int j = 0; j < 4; ++j) { f32x4 o; o[0] = h[4 * j] * rs * nf[4 * j]; o[1] = h[4 * j + 1] * rs * nf[4 * j + 1]; o[2] = h[4 * j + 2] * rs * nf[4 * j + 2]; o[3] = h[4 * j + 3] * rs * nf[4 * j + 3]; ((f32x4*)dst)[j] = o; }
    }
}


#define XB_TMO      128
#define XB_XCNT(j)  (256  + 64 * (j))
#define XB_XSUB(j)  (1280 + 64 * (j))
#define XB_XGEN(j)  (2304 + 64 * (j))
#define XB_TOP      3328
#define XB_TOPGEN   3392
#define XCD_BAR_WORDS 3456
#define XB_SPIN_CAP (1u << 18)
__device__ __forceinline__ unsigned xb_ld(unsigned* p)              { return __hip_atomic_load(p, __ATOMIC_RELAXED, __HIP_MEMORY_SCOPE_AGENT); }
__device__ __forceinline__ unsigned xb_add(unsigned* p, unsigned v) { return __hip_atomic_fetch_add(p, v, __ATOMIC_RELAXED, __HIP_MEMORY_SCOPE_AGENT); }
__device__ __forceinline__ unsigned xb_xcc_id() { return (unsigned)__builtin_amdgcn_s_getreg((3 << 11) | 20) & 0xFu; }
#define XB_SPIN(cond, bar) do { unsigned _sp = 0; while (cond) { __builtin_amdgcn_s_sleep(1); \
    if ((++_sp & 255u) == 0u) { if (xb_ld(&(bar)[XB_TMO])) break; if (_sp > XB_SPIN_CAP) { atomicAdd(&(bar)[XB_TMO], 1u); break; } } } } while (0)
struct XcdBarrier { unsigned* bar; unsigned x; volatile LAS unsigned* st; };
__device__ __forceinline__ XcdBarrier xcd_barrier_post(unsigned* bar, volatile LAS unsigned* st) {
    XcdBarrier b; b.bar = bar; b.x = xb_xcc_id(); b.st = st;
    if (threadIdx.x == 0) (void)xb_add(&bar[XB_XCNT(b.x)], 1u);
    return b;
}
__device__ __forceinline__ void xcd_barrier_complete(unsigned* bar, unsigned x, unsigned& nloc, unsigned& nx) {
    const unsigned G = gridDim.x * gridDim.y * gridDim.z;
    unsigned sum, cnt, mine, sp = 0u;
    for (;;) {
        sum = 0u; cnt = 0u; mine = 0u;
#pragma unroll
        for (unsigned j = 0; j < 16; ++j) { const unsigned c = xb_ld(&bar[XB_XCNT(j)]); sum += c; cnt += (c > 0u) ? 1u : 0u; mine = (j == x) ? c : mine; }
        if (sum == G) break;
        __builtin_amdgcn_s_sleep(1);
        if ((++sp & 255u) == 0u) { if (xb_ld(&bar[XB_TMO])) break; if (sp > XB_SPIN_CAP) { atomicAdd(&bar[XB_TMO], 1u); break; } }
    }
    nloc = mine > 0u ? mine : 1u; nx = cnt > 0u ? cnt : 1u;
}
__device__ __forceinline__ void xcd_barrier(const XcdBarrier& b) {
    asm volatile("s_waitcnt vmcnt(0)" ::: "memory");
    __syncthreads();
    if (threadIdx.x == 0) {
        unsigned* bar = b.bar;
        __builtin_amdgcn_s_waitcnt(0);
        unsigned nloc = b.st[0], nx = b.st[1];
        if (nloc == 0u) { xcd_barrier_complete(bar, b.x, nloc, nx); b.st[0] = nloc; b.st[1] = nx; }
        const unsigned old = xb_add(&bar[XB_XSUB(b.x)], 1u);
        const unsigned gen = old / nloc;
        if (old + 1u == (gen + 1u) * nloc) {
            __builtin_amdgcn_fence(__ATOMIC_RELEASE, "agent");
            asm volatile("s_waitcnt vmcnt(0)" ::: "memory");
            const unsigned og = xb_add(&bar[XB_TOP], 1u);
            const unsigned tg = og / nx;
            if (og + 1u == (tg + 1u) * nx) xb_add(&bar[XB_TOPGEN], 1u);
            else XB_SPIN(xb_ld(&bar[XB_TOPGEN]) == tg, bar);
            __builtin_amdgcn_fence(__ATOMIC_ACQUIRE, "agent");
            xb_add(&bar[XB_XGEN(b.x)], 1u);
            asm volatile("s_waitcnt vmcnt(0)" ::: "memory");
        } else {
            XB_SPIN(xb_ld(&bar[XB_XGEN(b.x)]) == gen, bar);
            __builtin_amdgcn_fence(__ATOMIC_ACQUIRE, "agent");
            asm volatile("s_waitcnt vmcnt(0)" ::: "memory");
        }
    }
    __syncthreads();
}

constexpr int NSUB = 20, NPHASE = 1 + 4 * NSUB;

__device__ __forceinline__ void phase_rstd(const Params& p, int which) {
    const float* part = (const float*)(p.ws + O_SS) + (size_t)which * 16 * RP; float* rs = (float*)(p.ws + O_RSTD) + (size_t)which * RP;
    for (int r = blockIdx.x * 512 + ltid(); r < RP; r += gridDim.x * 512) rs[r] = rstd16(part, r);
}

__device__ __forceinline__ void phase_fold(const Params& p, const Ctx& c) {
    const int tid = ltid(); const int wave = __builtin_amdgcn_readfirstlane(tid >> 6), lane = tid & 63;
    const int gw = blockIdx.x * 8 + wave, NW = gridDim.x * 8; const int ch0 = lane * 16;
    const float* part = (const float*)(p.ws + O_SS) + (size_t)16 * RP;
    const int nrow = c.nseq * c.Tp, Th = c.T / 2;
    for (int q = gw; q < nrow; q += NW) {
        const int s = q / c.Tp, tf = q - s * c.Tp; float oc[16], os[16];
        if (tf > Th) {
#pragma unroll
            for (int i = 0; i < 16; ++i) { oc[i] = 0.f; os[i] = 0.f; }
        } else {
            const int r1 = s * c.T + tf; float a[16]; load16bf(slot(p, 0), (size_t)r1 * 1024 + ch0, a); const float rs1 = rsqrtf(wave_sum(lane < 16 ? part[(size_t)lane * RP + r1] : 0.f) * (1.f / 1024.f) + 1e-6f);
            if (tf == 0 || tf == Th) {
#pragma unroll
                for (int i = 0; i < 16; ++i) { oc[i] = a[i] * rs1; os[i] = 0.f; }
            } else {
                const int r2 = s * c.T + (c.T - tf); float b[16]; load16bf(slot(p, 0), (size_t)r2 * 1024 + ch0, b); const float rs2 = rsqrtf(wave_sum(lane < 16 ? part[(size_t)lane * RP + r2] : 0.f) * (1.f / 1024.f) + 1e-6f);
#pragma unroll
                for (int i = 0; i < 16; ++i) { const float x = a[i] * rs1, y = b[i] * rs2; oc[i] = x + y; os[i] = x - y; }
            }
        }
        store16bf(slot(p, 5), (size_t)q * 1024 + ch0, oc); store16bf(slot(p, 6), (size_t)q * 1024 + ch0, os);
    }
}

__device__ __forceinline__ void run_phase(LAS unsigned char* lds, const Params& p, int ph) {
    if (ph == 0) { prep_phase(lds, p); return; }
    const int g = (ph - 1) / NSUB, sp = (ph - 1) % NSUB; const Ctx c = get_ctx(p, g);
    GemmPh P; P.G = gridDim.x; P.c = blockIdx.x; P.A = nullptr; P.B = nullptr; P.O = nullptr; P.ss = nullptr; P.ssin = nullptr; P.ldo = 0; P.kind = -1;
    float* ssb = (float*)(p.ws + O_SS); const float* rsb = (const float*)(p.ws + O_RSTD);
    switch (sp) {
    case 1: P.kind = K_L1; P.nunits = MT * 15; P.lda = 1024; P.ldb = 1024; P.K = 1024; break;
    case 2: P.kind = K_L2; P.nunits = MT * 20; P.lda = 256; P.ldb = 256; P.K = 256; break;
    case 6: P.kind = K_RES; P.nunits = MT * 4; P.lda = 1024; P.ldb = 1024; P.K = 1024; P.A = (const char*)slot(p, 1); P.B = (const char*)p.ws + O_WO; P.O = slot(p, 0); P.ss = ssb; break;
    case 8: case 16: { const int l = sp == 8 ? 0 : 1; P.kind = K_U; P.nunits = MT * 22; P.lda = 1024; P.ldb = 1024; P.K = 1024; P.A = (const char*)slot(p, 0); P.B = (const char*)p.ws + O_WIN + (size_t)l * 5632 * 1024 * 2;
        P.O = slot(p, 1); P.ssin = rsb + (l ? 2 * RP : 0); } break;
    case 10: case 18: { const int l = sp == 10 ? 0 : 1; P.kind = K_RES; P.nunits = MT * 4; P.lda = DFF; P.ldb = DFF; P.K = DFF; P.A = (const char*)slot(p, 7); P.B = (const char*)p.ws + O_WOUT + (size_t)l * 1024 * DFF * 2;
        P.O = slot(p, 0); P.ss = l ? nullptr : ssb + 16 * RP; } break;
    case 12: P.kind = K_CH; P.nunits = (c.nseq * c.Tp / 256) * 8; P.lda = 1024; P.ldb = 1024; P.K = 256; P.A = (const char*)p.ws + O_CHD; P.B = (const char*)slot(p, 5); P.O = slot(p, 1); break;
    case 13: P.kind = K_TD; P.nunits = c.nseq * c.tm * 4; P.lda = 2 * c.Tp; P.ldb = 2 * c.Tp; P.K = 2 * c.Tp; P.A = (const char*)p.ws + (g < 2 ? O_DFTP : O_DFTS); P.B = (const char*)slot(p, 1); P.O = slot(p, 4); break;
    case 14: P.kind = K_RES; P.nunits = MT * 4; P.lda = 1024; P.ldb = 1024; P.K = 1024; P.A = (const char*)slot(p, 4); P.B = (const char*)p.ws + O_WF; P.O = slot(p, 0); P.ss = ssb + 2 * 16 * RP; break;
    default: break;
    }
    if (P.kind >= 0) {
        switch (P.kind) {
        case K_L1: gemm_phase<K_L1>(lds, P, p, c); break;
        case K_L2: gemm_phase<K_L2>(lds, P, p, c); break;
        case K_RES: gemm_phase<K_RES>(lds, P, p, c); break;
        case K_U: gemm_phase<K_U>(lds, P, p, c); break;
        case K_CH: gemm_phase<K_CH>(lds, P, p, c); break;
        default: gemm_phase<K_TD>(lds, P, p, c); break;
        }
        return;
    }
    if (sp == 0) phase_mix(p, c);
    else if (sp == 3) phase_prescan(p, c);
    else if (sp == 4) phase_scan(lds, p, c);
    else if (sp == 5) phase_postscan(p, c);
    else if (sp == 11) phase_fold(p, c);
    else if (sp == 7 || sp == 15) phase_rstd(p, sp == 7 ? 0 : 2);
    else if (sp == 9 || sp == 17) phase_glu(p, c, sp == 9 ? 0 : 1);
    else phase_final(p, c);
}

__global__ void __launch_bounds__(512, 2) mega(Params p, int ph_lo, int ph_hi) {
    extern __shared__ __attribute__((aligned(16))) unsigned char shm[];
    LAS unsigned char* lds = (LAS unsigned char*)shm;
    cg::grid_group grid = cg::this_grid();
    volatile LAS unsigned* st = (volatile LAS unsigned*)(lds + STAGE_BYTES);
    if (threadIdx.x == 0) { st[0] = 0u; st[1] = 0u; }
    __syncthreads();
    const XcdBarrier xb = xcd_barrier_post((unsigned*)(p.ws + O_BAR), st);
    for (int ph = ph_lo; ph < ph_hi; ++ph) {
        if (ph == ph_lo + 1) grid.sync();
        else if (ph > ph_lo) xcd_barrier(xb);
        run_phase(lds, p, ph);
    }
}

extern "C" void kernel_launch(void* const* d_in, const int* in_sizes, int n_in, void* d_out, int out_size, void* d_ws, size_t ws_size, hipStream_t stream) {
    static int grid = 0;
    if (grid == 0) {
        if (n_in != 27 || ws_size < WS_END) { fprintf(stderr, "kernel_launch: need 27 inputs and %zu B of workspace (got %d, %zu)\n", (size_t)WS_END, n_in, ws_size); grid = -1; return; }
        int dev = 0, cus = 0, per_cu = 0;
        hipGetDevice(&dev); hipDeviceGetAttribute(&cus, hipDeviceAttributeMultiprocessorCount, dev);
        if (hipFuncSetAttribute((const void*)mega, hipFuncAttributeMaxDynamicSharedMemorySize, STAGE_BYTES + 16) != hipSuccess) { fprintf(stderr, "hipFuncSetAttribute failed\n"); grid = -1; return; }
        hipOccupancyMaxActiveBlocksPerMultiprocessor(&per_cu, (const void*)mega, 512, STAGE_BYTES + 16);
        if (per_cu < 1) per_cu = 1;
        (void)hipGetLastError();
        grid = cus * 1;
    }
    if (grid < 0) return;
    Params p{};
    for (int i = 0; i < 27; ++i) p.in[i] = (const float*)d_in[i];
    p.out = (float*)d_out; p.ws = (unsigned char*)d_ws;
#if MK_PER_PHASE
    for (int ph = 0; ph < NPHASE; ++ph) hipLaunchKernelGGL(mega, dim3(grid), dim3(512), STAGE_BYTES + 16, stream, p, ph, ph + 1);
#else
    (void)hipMemsetAsync((unsigned char*)d_ws + O_BAR, 0, 16384, stream);
    int lo = 0, hi = NPHASE;
    void* args[] = {&p, &lo, &hi};
    hipError_t e = hipLaunchCooperativeKernel((const void*)mega, dim3(grid), dim3(512), args, STAGE_BYTES + 16, stream);
    if (e != hipSuccess) fprintf(stderr, "cooperative launch failed: %s (grid %d)\n", hipGetErrorString(e), grid);
#endif
}
```

```cpp
#include <hip/hip_runtime.h>
#include <hip/hip_cooperative_groups.h>
#include <cstdio>
namespace cg = cooperative_groups;

#ifndef MK_PER_PHASE
#define MK_PER_PHASE 0
#endif

#define LAS __attribute__((address_space(3)))
typedef unsigned short bf16_t;
typedef short bf16x8 __attribute__((ext_vector_type(8)));
typedef float f32x4 __attribute__((ext_vector_type(4)));
typedef unsigned u32x4 __attribute__((ext_vector_type(4)));
typedef unsigned u32x2 __attribute__((ext_vector_type(2)));
typedef float f32x2 __attribute__((ext_vector_type(2)));
typedef const __attribute__((address_space(4))) unsigned* cptr;

constexpr int D = 1024, DFF = 2816, NMETA = 16;
constexpr int RP = 33024;
constexpr int MT = RP / 256;
constexpr size_t SLOT = (size_t)RP * D * 2;
constexpr int NSLOT = 13;
constexpr size_t O_WRKV = NSLOT * SLOT;
constexpr size_t O_G1 = O_WRKV + (size_t)3072 * 1024 * 2;
constexpr size_t O_W1 = O_G1 + (size_t)256 * 1024 * 2;
constexpr size_t O_A1 = O_W1 + (size_t)256 * 1024 * 2;
constexpr size_t O_L2 = O_A1 + (size_t)256 * 1024 * 2;
constexpr size_t O_G2 = O_L2 + (size_t)4096 * 256 * 2;
constexpr size_t O_WO = O_G2 + (size_t)1024 * 256 * 2;
constexpr size_t O_WF = O_WO + (size_t)1024 * 1024 * 2;
constexpr size_t O_WIN = O_WF + (size_t)1024 * 1024 * 2;
constexpr size_t O_WOUT = O_WIN + (size_t)2 * 5632 * 1024 * 2;
constexpr size_t O_CHD = O_WOUT + (size_t)2 * 1024 * 2816 * 2;
constexpr int TP_P = 1088, TP_S = 2112, MP_P = 2304, MP_S = 4352;
constexpr size_t O_DFTP = O_CHD + (size_t)2048 * 1024 * 2;
constexpr size_t O_DFTS = O_DFTP + (size_t)MP_P * 2 * TP_P * 2;
constexpr size_t O_SS = O_DFTS + (size_t)MP_S * 2 * TP_S * 2;
constexpr size_t O_RSTD = O_SS + (size_t)3 * 16 * RP * 4;
constexpr size_t O_BONUS = O_RSTD + (size_t)3 * RP * 4;
constexpr size_t O_BAR = O_BONUS + (size_t)RP * 16 * 4;
constexpr size_t WS_END = O_BAR + 16384;

struct Params { const float* in[27]; float* out; unsigned char* ws; };
struct Ctx { int g, T, nseq, R, Tp, tm; const float* x; float* y; };

__device__ __forceinline__ Ctx get_ctx(const Params& p, int g) {
    Ctx c; c.g = g;
    if (g < 2) { c.T = 2064; c.nseq = 16; c.Tp = TP_P; c.tm = 8; c.x = p.in[0] + (size_t)g * 16 * 2048 * 1024; c.y = p.out + (size_t)g * 16 * 2048 * 1024; }
    else { c.T = 4112; c.nseq = 8; c.Tp = TP_S; c.tm = 16; c.x = p.in[1] + (size_t)(g - 2) * 8 * 4096 * 1024; c.y = p.out + (size_t)32 * 2048 * 1024 + (size_t)(g - 2) * 8 * 4096 * 1024; }
    c.R = c.nseq * c.T; return c;
}
__device__ __forceinline__ int ltid() { int t = threadIdx.x; asm volatile("" : "+v"(t)); return t; }
__device__ __forceinline__ unsigned char* slot(const Params& p, int i) { return p.ws + (size_t)i * SLOT; }

__device__ __forceinline__ unsigned pk2(float lo, float hi) { unsigned r; asm volatile("v_cvt_pk_bf16_f32 %0, %1, %2" : "=v"(r) : "v"(lo), "v"(hi)); return r; }
__device__ __forceinline__ float bflo(unsigned u) { return __uint_as_float(u << 16); }
__device__ __forceinline__ float bfhi(unsigned u) { return __uint_as_float(u & 0xffff0000u); }
__device__ __forceinline__ float wave_sum(float v) {
#pragma unroll
    for (int o = 1; o < 64; o <<= 1) v += __shfl_xor(v, o);
    return v;
}
__device__ __forceinline__ float sigmoidf_(float x) { return 1.f / (1.f + __expf(-x)); }
__device__ __forceinline__ void unpack16(const u32x4 a, const u32x4 b, float (&v)[16]) {
#pragma unroll
    for (int i = 0; i < 4; ++i) { v[2 * i] = bflo(a[i]); v[2 * i + 1] = bfhi(a[i]); v[8 + 2 * i] = bflo(b[i]); v[8 + 2 * i + 1] = bfhi(b[i]); }
}
__device__ __forceinline__ void load16bf(const unsigned char* base, size_t elem, float (&v)[16]) {
    const u32x4* q = (const u32x4*)(base + elem * 2); unpack16(q[0], q[1], v);
}
__device__ __forceinline__ void store16bf(unsigned char* base, size_t elem, const float (&v)[16]) {
    u32x4 a, b;
#pragma unroll
    for (int i = 0; i < 4; ++i) { a[i] = pk2(v[2 * i], v[2 * i + 1]); b[i] = pk2(v[8 + 2 * i], v[8 + 2 * i + 1]); }
    u32x4* q = (u32x4*)(base + elem * 2); q[0] = a; q[1] = b;
}
__device__ __forceinline__ void load16f(const float* src, float (&v)[16]) {
#pragma unroll
    for (int j = 0; j < 4; ++j) { f32x4 t = ((const f32x4*)src)[j]; v[4 * j] = t[0]; v[4 * j + 1] = t[1]; v[4 * j + 2] = t[2]; v[4 * j + 3] = t[3]; }
}

constexpr int BM = 256, BK = 64, HALF = 128, HTB = HALF * BK * 2, STAGE_BYTES = 8 * HTB;
__device__ __forceinline__ int lds_byte(int r, int c) { const int st = (r >> 4) * 2 + (c >> 5), rr = r & 15, cc = c & 31, ob = rr * 64 + cc * 2; return st * 1024 + (ob ^ (((ob >> 9) & 1) << 5)); }
__device__ __forceinline__ void stage_rc(int b, int& R, int& C) { const int st = b / 1024, sb = b % 1024, swz = sb ^ (((sb >> 9) & 1) << 5); R = (st >> 1) * 16 + swz / 64; C = (st & 1) * 32 + (swz % 64) / 2; }
__device__ __forceinline__ int perm32(int rho) { const int n = rho >> 4, i = rho & 15; return 8 * (i >> 2) + 4 * n + (i & 3); }

enum { K_L1 = 0, K_L2, K_RES, K_U, K_CH, K_TD };
struct Unit { const char* A; const char* B; int pm, pn, job, s; };
struct GemmPh {
    int kind, nunits, lda, ldb, K, G, c;
    const char* A; const char* B;
    unsigned char* O; float* ss; const float* ssin; int ldo;
};

__device__ __forceinline__ bool next_unit(const GemmPh& P, const Params& p, const Ctx& cx, int i, Unit& u) {
    const long Lg = (long)i * P.G + P.c; if (Lg >= P.nunits) return false;
    const int L = (int)Lg; u.s = 0; u.job = 0;
    if (P.kind == K_L1) {
        const int pm = L / 15, jn = L % 15; int job, pn;
        if (jn < 12) { job = jn >> 2; pn = jn & 3; } else { job = 3 + (jn - 12); pn = 0; }
        const int aslot = job == 0 ? 1 : job == 1 ? 3 : job == 2 ? 4 : job == 3 ? 6 : job == 4 ? 2 : 5;
        u.A = (const char*)slot(p, aslot) + (size_t)pm * 256 * 2048;
        const size_t boff = job < 3 ? O_WRKV + ((size_t)job * 1024 + pn * 256) * 2048 : job == 3 ? O_G1 : job == 4 ? O_W1 : O_A1;
        u.B = (const char*)p.ws + boff; u.pm = pm; u.pn = pn; u.job = job;
    } else if (P.kind == K_L2) {
        const int pm = L / 20, jn = L % 20; const int job = jn < 16 ? 0 : 1, pn = jn < 16 ? jn : jn - 16;
        u.A = (const char*)slot(p, 10) + (job == 0 ? (size_t)RP * 512 : 0) + (size_t)pm * 256 * 512;
        u.B = (const char*)p.ws + (job == 0 ? O_L2 : O_G2) + (size_t)pn * 256 * 512; u.pm = pm; u.pn = pn; u.job = job;
    } else if (P.kind == K_RES) {
        const int pm = L >> 2, pn = L & 3;
        u.A = P.A + (size_t)pm * 256 * P.lda * 2; u.B = P.B + (size_t)pn * 256 * P.ldb * 2; u.pm = pm; u.pn = pn;
    } else if (P.kind == K_U) {
        const int pm = L / 22, pn = L % 22;
        u.A = P.A + (size_t)pm * 256 * 2048; u.B = P.B + (size_t)pn * 256 * 2048; u.pm = pm; u.pn = pn;
    } else if (P.kind == K_CH) {
        const int pn = L >> 3, pm = L & 7;
        u.A = P.A + (size_t)pm * 256 * 2048 + (pm & 3) * 512; u.B = (const char*)slot(p, pm < 4 ? 5 : 6) + (size_t)pn * 256 * 2048 + (pm & 3) * 512; u.pm = pm; u.pn = pn;
    } else {
        const int per = cx.tm * 4, s = L / per, rem = L % per, pm = rem >> 2, pn = rem & 3;
        u.A = P.A + (size_t)(NMETA + pm * 256) * P.lda * 2; u.B = P.B + ((size_t)s * 1024 + pn * 256) * P.ldb * 2; u.pm = pm; u.pn = pn; u.s = s;
    }
    return true;
}

__device__ __forceinline__ void st8(unsigned char* ptr, const f32x4 a, const f32x4 b) {
    u32x4 o; o[0] = pk2(a[0], a[1]); o[1] = pk2(a[2], a[3]); o[2] = pk2(b[0], b[1]); o[3] = pk2(b[2], b[3]); *(u32x4*)ptr = o;
}
__device__ __forceinline__ float decaymap(float w) {
    const float e = 0.6065306597f / (1.f + __expf(-w)); return __expf(-e) - 1.f;
}
__device__ __forceinline__ float act_apply(int act, float x) {
    if (act == 1) return 1.f / (1.f + __expf(-x));
    if (act == 2) return 1.f - 2.f / (__expf(2.f * x) + 1.f);
    if (act == 3) return decaymap(x);
    return x;
}

__device__ __forceinline__ float rstd16(const float* ss, int r) {
    float s = 0.f;
#pragma unroll
    for (int i = 0; i < 16; ++i) s += ss[(size_t)i * RP + r];
    return rsqrtf(s * (1.f / 1024.f) + 1e-6f);
}
__device__ __forceinline__ void epilogue(const GemmPh& P, const Params& p, const Ctx& cx, const f32x4 (&acc)[2][2][4][2], const Unit& u, int wr, int wc, int fr, int fq) {
    const int rbase = u.pm * 256 + wr * 64 + fr, cbase = u.pn * 256 + wc * 32 + 8 * fq;
    if (P.kind == K_L1 || P.kind == K_L2) {
        unsigned char* O; int ldo = 1024, coff = 0, act = 0, cvalid = 1 << 30; const float* bias = nullptr;
        if (P.kind == K_L1) {
            if (u.job < 3) { O = slot(p, 7 + u.job); }
            else if (u.job == 3) { O = slot(p, 10); ldo = 256; act = 1; }
            else if (u.job == 4) { O = slot(p, 10) + (size_t)RP * 512; ldo = 256; act = 2; cvalid = 128; }
            else { O = slot(p, 10) + (size_t)RP * 512; ldo = 256; coff = 128; cvalid = 128; }
        } else {
            if (u.job == 1) { O = slot(p, 5); }
            else { const int cb = u.pn >> 2; O = slot(p, 1 + cb); bias = (cb < 2 ? p.in[8] : p.in[11]) + (cb & 1) * 1024 - cb * 1024; coff = -cb * 1024; act = cb < 2 ? 3 : 1; }
        }
        f32x4 bv[2][2];
#pragma unroll
        for (int bj = 0; bj < 2; ++bj)
#pragma unroll
            for (int n = 0; n < 2; ++n) bv[bj][n] = bias ? *(const f32x4*)(bias + cbase + bj * 128 + 4 * n) : (f32x4){0.f, 0.f, 0.f, 0.f};
#pragma unroll
        for (int ai = 0; ai < 2; ++ai)
#pragma unroll
            for (int m = 0; m < 4; ++m) { if ((m & 1) == 0) __builtin_amdgcn_sched_barrier(0);
#pragma unroll
                for (int bj = 0; bj < 2; ++bj) { const int r = rbase + ai * 128 + m * 16; const int c0 = cbase + bj * 128;
                    f32x4 v0 = acc[ai][bj][m][0] + bv[bj][0], v1 = acc[ai][bj][m][1] + bv[bj][1];
#pragma unroll
                    for (int i = 0; i < 4; ++i) { v0[i] = act_apply(act, v0[i]); v1[i] = act_apply(act, v1[i]); }
                    if (c0 < cvalid) st8(O + ((size_t)r * ldo + coff + c0) * 2, v0, v1); } }
    } else if (P.kind == K_RES) {
        unsigned char* H = P.O;
#pragma unroll
        for (int ai = 0; ai < 2; ++ai)
#pragma unroll
            for (int m = 0; m < 4; ++m) { if ((m & 1) == 0) __builtin_amdgcn_sched_barrier(0); const int r = rbase + ai * 128 + m * 16; float sq = 0.f;
#pragma unroll
                for (int bj = 0; bj < 2; ++bj) { unsigned char* ptr = H + ((size_t)r * 1024 + cbase + bj * 128) * 2;
                    const u32x4 old = *(const u32x4*)ptr; u32x4 o; const f32x4 a0 = acc[ai][bj][m][0], a1 = acc[ai][bj][m][1];
                    o[0] = pk2(bflo(old[0]) + a0[0], bfhi(old[0]) + a0[1]); o[1] = pk2(bflo(old[1]) + a0[2], bfhi(old[1]) + a0[3]);
                    o[2] = pk2(bflo(old[2]) + a1[0], bfhi(old[2]) + a1[1]); o[3] = pk2(bflo(old[3]) + a1[2], bfhi(old[3]) + a1[3]);
#pragma unroll
                    for (int i = 0; i < 4; ++i) { const float rl = bflo(o[i]), rh = bfhi(o[i]); sq += rl * rl + rh * rh; }
                    *(u32x4*)ptr = o; }
                if (P.ss) { sq += __shfl_xor(sq, 16); sq += __shfl_xor(sq, 32); if (fq == 0) P.ss[(size_t)(u.pn * 4 + wc) * RP + r] = sq; } }
    } else if (P.kind == K_U) {
#pragma unroll
        for (int ai = 0; ai < 2; ++ai)
#pragma unroll
            for (int m = 0; m < 4; ++m) { if ((m & 1) == 0) __builtin_amdgcn_sched_barrier(0); const int r = rbase + ai * 128 + m * 16; const float rs = P.ssin[r];
#pragma unroll
                for (int bj = 0; bj < 2; ++bj) st8(P.O + ((size_t)r * 5632 + cbase + bj * 128) * 2, acc[ai][bj][m][0] * rs, acc[ai][bj][m][1] * rs); }
    } else if (P.kind == K_CH) {
#pragma unroll
        for (int bj = 0; bj < 2; ++bj) { const int n0 = cbase + bj * 128; const int s = n0 / cx.Tp, t = n0 - s * cx.Tp;
#pragma unroll
            for (int ai = 0; ai < 2; ++ai)
#pragma unroll
                for (int m = 0; m < 4; ++m) { if ((m & 1) == 0) __builtin_amdgcn_sched_barrier(0); const int rr = rbase + ai * 128 + m * 16; const int cs = rr >> 10, ch = rr & 1023;
                    st8(P.O + ((((size_t)s * 1024 + ch) * 2 + cs) * cx.Tp + t) * 2, acc[ai][bj][m][0], acc[ai][bj][m][1]); } }
    } else {
#pragma unroll
        for (int ai = 0; ai < 2; ++ai)
#pragma unroll
            for (int m = 0; m < 4; ++m) { if ((m & 1) == 0) __builtin_amdgcn_sched_barrier(0); const int k = NMETA + rbase + ai * 128 + m * 16; const size_t row = (size_t)u.s * cx.T + k;
#pragma unroll
                for (int bj = 0; bj < 2; ++bj) if (k < cx.T) st8(P.O + (row * 1024 + cbase + bj * 128) * 2, acc[ai][bj][m][0], acc[ai][bj][m][1]); }
    }
}

template <int KIND> __device__ __forceinline__ void gemm_phase(LAS unsigned char* lds, GemmPh P, const Params& p, const Ctx& cx) {
    P.kind = KIND;
    const int tid = ltid(), wid = __builtin_amdgcn_readfirstlane(tid >> 6), lane = tid & 63, wr = wid >> 2, wc = wid & 3, fr = lane & 15, fq = lane >> 4;
    const int nt = P.K / BK;
    unsigned voffA[2], voffB[2];
#pragma unroll
    for (int i = 0; i < 2; ++i) { int R, C; stage_rc(tid * 16 + i * 8192, R, C); const int Rb = (R & ~31) + perm32(R & 31);
        voffA[i] = (unsigned)(R * P.lda + C) * 2u; voffB[i] = (unsigned)(Rb * P.ldb + C) * 2u; }
    const size_t kstep = (size_t)(BK * 2);
    const size_t hstepA = (size_t)HALF * P.lda * 2, hstepB = (size_t)HALF * P.ldb * 2;
    const unsigned ldsw = (unsigned)wid * 1024u;
    const int aoff = lds_byte(wr * 64 + fr, fq * 8), boff = lds_byte(wc * 32 + fr, fq * 8);
#define PG8_SA(b, h) (((b) * 2 + (h)) * HTB)
#define PG8_SB(b, h) ((4 + (b) * 2 + (h)) * HTB)
#define PG8_STAGE(bufoff, gbase, voff) do { _Pragma("unroll") for (int _i = 0; _i < 2; ++_i) \
        __builtin_amdgcn_global_load_lds((const unsigned*)((const char*)(gbase) + (voff)[_i]), (LAS unsigned*)(lds + (bufoff) + ldsw + _i * 8192), 16, 0, 0); } while (0)
#define PG8_LDA(dst, b, h) do { _Pragma("unroll") for (int m = 0; m < 4; ++m) _Pragma("unroll") for (int k = 0; k < 2; ++k) dst[m][k] = *(const LAS bf16x8*)(lds + PG8_SA(b, h) + aoff + m * 2048 + k * 1024); } while (0)
#define PG8_LDB(dst, b, h) do { _Pragma("unroll") for (int n = 0; n < 2; ++n) _Pragma("unroll") for (int k = 0; k < 2; ++k) dst[n][k] = *(const LAS bf16x8*)(lds + PG8_SB(b, h) + boff + n * 2048 + k * 1024); } while (0)
#define PG8_MMA(ai, bj, At, Bt) do { __builtin_amdgcn_s_setprio(1); _Pragma("unroll") for (int m = 0; m < 4; ++m) _Pragma("unroll") for (int n = 0; n < 2; ++n) _Pragma("unroll") for (int k = 0; k < 2; ++k) \
        acc[ai][bj][m][n] = __builtin_amdgcn_mfma_f32_16x16x32_bf16(Bt[n][k], At[m][k], acc[ai][bj][m][n], 0, 0, 0); __builtin_amdgcn_s_setprio(0); } while (0)
#define PG8_WAIT_V(n) asm volatile("s_waitcnt vmcnt(" #n ")" ::: "memory")
#define PG8_WAIT_L(n) asm volatile("s_waitcnt lgkmcnt(" #n ")" ::: "memory")
#define PG8_BAR __builtin_amdgcn_s_barrier()
#define PG8_SCHED __builtin_amdgcn_sched_barrier(0)
    Unit cur, nxt; int ui = 0;
    if (!next_unit(P, p, cx, 0, cur)) return;
    f32x4 acc[2][2][4][2];
#pragma unroll
    for (int a = 0; a < 2; ++a)
#pragma unroll
        for (int b = 0; b < 2; ++b)
#pragma unroll
            for (int m = 0; m < 4; ++m)
#pragma unroll
                for (int n = 0; n < 2; ++n) acc[a][b][m][n] = (f32x4){0.f, 0.f, 0.f, 0.f};
    bf16x8 At[4][2], B0[2][2], B1[2][2];
    const char* cA = cur.A; const char* cB = cur.B;
    PG8_STAGE(PG8_SB(0, 0), cB, voffB); PG8_STAGE(PG8_SA(0, 0), cA, voffA); PG8_STAGE(PG8_SB(0, 1), cB + hstepB, voffB); PG8_STAGE(PG8_SA(0, 1), cA + hstepA, voffA);
    if (wr == 1) PG8_BAR;
    PG8_WAIT_V(4); PG8_BAR;
    PG8_STAGE(PG8_SB(1, 0), cB + kstep, voffB); PG8_STAGE(PG8_SA(1, 0), cA + kstep, voffA); PG8_STAGE(PG8_SB(1, 1), cB + hstepB + kstep, voffB);
    PG8_WAIT_V(6); PG8_BAR;
    for (;;) {
        const bool has_next = next_unit(P, p, cx, ui + 1, nxt);
        const char* nA = has_next ? nxt.A : cA; const char* nB = has_next ? nxt.B : cB;
        for (int t = 0; t < nt; t += 2) {
            const bool last = (t == nt - 2);
            const char* a1 = cA + (size_t)(t + 1) * kstep;
            const char* a2 = last ? nA : cA + (size_t)(t + 2) * kstep; const char* b2 = last ? nB : cB + (size_t)(t + 2) * kstep;
            const char* a3 = a2 + kstep; const char* b3 = b2 + kstep;
            PG8_LDB(B0, 0, 0); PG8_SCHED; PG8_LDA(At, 0, 0); PG8_STAGE(PG8_SA(1, 1), a1 + hstepA, voffA);
            PG8_WAIT_L(8); PG8_BAR; PG8_WAIT_L(0); PG8_MMA(0, 0, At, B0); PG8_BAR; PG8_SCHED;
            PG8_LDB(B1, 0, 1); PG8_STAGE(PG8_SB(0, 0), b2, voffB);
            PG8_BAR; PG8_WAIT_L(0); PG8_MMA(0, 1, At, B1); PG8_BAR;
            PG8_LDA(At, 0, 1); PG8_STAGE(PG8_SA(0, 0), a2, voffA);
            PG8_BAR; PG8_WAIT_L(0); PG8_MMA(1, 0, At, B0); PG8_BAR; PG8_SCHED;
            PG8_STAGE(PG8_SB(0, 1), b2 + hstepB, voffB);
            PG8_WAIT_V(6); PG8_BAR; PG8_MMA(1, 1, At, B1); PG8_BAR;
            PG8_LDB(B0, 1, 0); PG8_SCHED; PG8_LDA(At, 1, 0); PG8_STAGE(PG8_SA(0, 1), a2 + hstepA, voffA);
            PG8_WAIT_L(8); PG8_BAR; PG8_WAIT_L(0); PG8_MMA(0, 0, At, B0); PG8_BAR; PG8_SCHED;
            PG8_LDB(B1, 1, 1); PG8_STAGE(PG8_SB(1, 0), b3, voffB);
            PG8_BAR; PG8_WAIT_L(0); PG8_MMA(0, 1, At, B1); PG8_BAR;
            PG8_LDA(At, 1, 1); PG8_STAGE(PG8_SA(1, 0), a3, voffA);
            PG8_BAR; PG8_WAIT_L(0); PG8_MMA(1, 0, At, B0); PG8_BAR; PG8_SCHED;
            PG8_STAGE(PG8_SB(1, 1), b3 + hstepB, voffB);
            PG8_WAIT_V(6); PG8_BAR; PG8_MMA(1, 1, At, B1); PG8_BAR;
        }
        epilogue(P, p, cx, acc, cur, wr, wc, fr, fq);
        if (!has_next) break;
#pragma unroll
        for (int a = 0; a < 2; ++a)
#pragma unroll
            for (int b = 0; b < 2; ++b)
#pragma unroll
                for (int m = 0; m < 4; ++m)
#pragma unroll
                    for (int n = 0; n < 2; ++n) acc[a][b][m][n] = (f32x4){0.f, 0.f, 0.f, 0.f};
        cur = nxt; cA = nA; cB = nB; ++ui;
    }
    PG8_WAIT_V(0);
    if (wr == 0) PG8_BAR;
    PG8_BAR;
#undef PG8_SA
#undef PG8_SB
#undef PG8_STAGE
#undef PG8_LDA
#undef PG8_LDB
#undef PG8_MMA
#undef PG8_WAIT_V
#undef PG8_WAIT_L
#undef PG8_BAR
#undef PG8_SCHED
}

__device__ __forceinline__ void tr_job(LAS float* tile, const float* src, int K, int N, unsigned char* dst, int ldk, int koff, int Kpad, int Npad, const float* scale, int& cnt, int stride_start, int G) {
    const int tk = Kpad / 64, tn = Npad / 64, ntile = tk * tn; const int tid = ltid();
    for (int it = 0; it < ntile; ++it, ++cnt) {
        if ((cnt % G) != stride_start) continue;
        const int k0 = (it / tn) * 64, n0 = (it % tn) * 64;
        __syncthreads();
        { const int tx = tid & 63, ty = tid >> 6;
#pragma unroll
            for (int i = 0; i < 8; ++i) { const int kd = k0 + ty + 8 * i, ks = kd - koff, n = n0 + tx; float v = 0.f;
                if (ks >= 0 && ks < K && n < N) { v = src[(size_t)ks * N + n]; if (scale) v *= scale[ks]; }
                tile[(ty + 8 * i) * 65 + tx] = v; } }
        __syncthreads();
        { const int n = tid >> 3, kc = (tid & 7) * 8; u32x4 o;
#pragma unroll
            for (int i = 0; i < 4; ++i) o[i] = pk2(tile[(kc + 2 * i) * 65 + n], tile[(kc + 2 * i + 1) * 65 + n]);
            *(u32x4*)(dst + ((size_t)(n0 + n) * ldk + k0 + kc) * 2) = o; }
    }
}

__device__ __forceinline__ void prep_phase(LAS unsigned char* lds, const Params& p) {
    LAS float* tile = (LAS float*)lds; unsigned char* ws = p.ws; int cnt = 0; const int b = blockIdx.x, G = gridDim.x;
    for (int i = 0; i < 3; ++i) tr_job(tile, p.in[7] + (size_t)i * D * D, D, D, ws + O_WRKV + (size_t)i * D * D * 2, 1024, 0, 1024, 1024, nullptr, cnt, b, G);
    tr_job(tile, p.in[14], D, 160, ws + O_G1, 1024, 0, 1024, 256, nullptr, cnt, b, G);
    tr_job(tile, p.in[9], D, 64, ws + O_W1, 1024, 0, 1024, 64, nullptr, cnt, b, G);
    tr_job(tile, p.in[9] + D * 64, D, 64, ws + O_W1 + (size_t)64 * 1024 * 2, 1024, 0, 1024, 192, nullptr, cnt, b, G);
    tr_job(tile, p.in[12], D, 64, ws + O_A1, 1024, 0, 1024, 64, nullptr, cnt, b, G);
    tr_job(tile, p.in[12] + D * 64, D, 64, ws + O_A1 + (size_t)64 * 1024 * 2, 1024, 0, 1024, 192, nullptr, cnt, b, G);
    for (int z = 0; z < 2; ++z) {
        tr_job(tile, p.in[10] + (size_t)z * 64 * D, 64, D, ws + O_L2 + (size_t)z * 1024 * 256 * 2, 256, z * 64, 256, 1024, nullptr, cnt, b, G);
        tr_job(tile, p.in[13] + (size_t)z * 64 * D, 64, D, ws + O_L2 + (size_t)(2 + z) * 1024 * 256 * 2, 256, (2 + z) * 64, 256, 1024, nullptr, cnt, b, G);
    }
    tr_job(tile, p.in[15], 160, D, ws + O_G2, 256, 0, 256, 1024, nullptr, cnt, b, G);
    tr_job(tile, p.in[21], D, D, ws + O_WO, 1024, 0, 1024, 1024, nullptr, cnt, b, G);
    tr_job(tile, p.in[22], D, D, ws + O_WF, 1024, 0, 1024, 1024, nullptr, cnt, b, G);
    for (int l = 0; l < 2; ++l) {
        tr_job(tile, p.in[23] + (size_t)l * D * 5632, D, 5632, ws + O_WIN + (size_t)l * 5632 * 1024 * 2, 1024, 0, 1024, 5632, p.in[4] + l * D, cnt, b, G);
        tr_job(tile, p.in[26] + (size_t)l * DFF * D, DFF, D, ws + O_WOUT + (size_t)l * 1024 * DFF * 2, DFF, 0, DFF, 1024, nullptr, cnt, b, G);
    }
    const size_t gt = (size_t)blockIdx.x * 512 + ltid(), NT = (size_t)gridDim.x * 512;
    const float* nm1 = p.in[3] + D;
    for (size_t e = gt; e < (size_t)2048 * 128; e += NT) {
        const int rr = (int)(e >> 7), c0 = (int)(e & 127) * 8; const int cs = rr >> 10, ch = rr & 1023; float v[8];
#pragma unroll
        for (int i = 0; i < 8; ++i) { const int c = c0 + i; float val = 0.f;
            if ((c >> 7) == (ch >> 7)) { const int m = ((ch & 127) * (c & 127)) & 127; float sn, cn; sincospif((float)m * (1.f / 64.f), &sn, &cn); val = (cs ? sn : cn) * nm1[c] * 0.08838834764831845f; }
            v[i] = val; }
        u32x4 o; o[0] = pk2(v[0], v[1]); o[1] = pk2(v[2], v[3]); o[2] = pk2(v[4], v[5]); o[3] = pk2(v[6], v[7]);
        *(u32x4*)(ws + O_CHD + e * 16) = o;
    }
    for (int ty = 0; ty < 2; ++ty) {
        const int T = ty ? 4112 : 2064, Tp = ty ? TP_S : TP_P, Mp = ty ? MP_S : MP_P; const int rowv = 2 * Tp / 8;
        unsigned char* dst = ws + (ty ? O_DFTS : O_DFTP); const float isq = rsqrtf((float)T), invT = 2.f / (float)T;
        for (size_t e = gt; e < (size_t)Mp * rowv; e += NT) {
            const int k = (int)(e / rowv), kk0 = (int)(e % rowv) * 8; float v[8];
#pragma unroll
            for (int i = 0; i < 8; ++i) { const int kk = kk0 + i; const int issin = kk >= Tp, t = issin ? kk - Tp : kk; float val = 0.f;
                if (k < T && (issin ? (t >= 1 && t <= T / 2 - 1) : (t <= T / 2))) { const int m = (int)(((long)k * t) % T); float sn, cn; sincospif((float)m * invT, &sn, &cn); val = (issin ? -sn : cn) * isq; }
                v[i] = val; }
            u32x4 o; o[0] = pk2(v[0], v[1]); o[1] = pk2(v[2], v[3]); o[2] = pk2(v[4], v[5]); o[3] = pk2(v[6], v[7]);
            *(u32x4*)(dst + e * 16) = o;
        }
    }
}

__device__ __forceinline__ void ea_load_row(const Params& p, const Ctx& c, int s, int pos, int lane, float (&v)[16]) {
    if (pos < 0 || pos >= c.T) {
#pragma unroll
        for (int i = 0; i < 16; ++i) v[i] = 0.f;
        return; }
    const float* src = pos < NMETA ? p.in[2] + (size_t)pos * D : c.x + ((size_t)s * (c.T - NMETA) + (pos - NMETA)) * D;
#pragma unroll
    for (int j = 0; j < 4; ++j) { const f32x4 t = *(const f32x4*)(src + j * 256 + lane * 4); v[4 * j] = t[0]; v[4 * j + 1] = t[1]; v[4 * j + 2] = t[2]; v[4 * j + 3] = t[3]; }
}
__device__ __forceinline__ void ea_store_row(unsigned char* base, size_t row, int lane, const float (&v)[16]) {
#pragma unroll
    for (int j = 0; j < 4; ++j) { u32x2 o; o[0] = pk2(v[4 * j], v[4 * j + 1]); o[1] = pk2(v[4 * j + 2], v[4 * j + 3]); *(u32x2*)(base + (row * 1024 + j * 256 + lane * 4) * 2) = o; }
}
__device__ __forceinline__ void ea_norm(float (&v)[16], const float (&nw)[16]) {
    float ss = 0.f;
#pragma unroll
    for (int i = 0; i < 16; ++i) ss += v[i] * v[i];
    ss = wave_sum(ss); const float rs = rsqrtf(ss * (1.f / 1024.f) + 1e-6f);
#pragma unroll
    for (int i = 0; i < 16; ++i) v[i] = v[i] * rs * nw[i];
}
__device__ __forceinline__ void phase_mix(const Params& p, const Ctx& c) {
    const int wave = __builtin_amdgcn_readfirstlane(ltid() >> 6), lane = ltid() & 63;
    const int gw = blockIdx.x * 8 + wave, NW = gridDim.x * 8;
    float nw[16];
#pragma unroll
    for (int j = 0; j < 4; ++j) { const f32x4 t = *(const f32x4*)(p.in[3] + j * 256 + lane * 4); nw[4 * j] = t[0]; nw[4 * j + 1] = t[1]; nw[4 * j + 2] = t[2]; nw[4 * j + 3] = t[3]; }
    const int nstrips = c.R / 16, spq = c.T / 16;
    for (int st = gw; st < nstrips; st += NW) {
        const int s = st / spq, pos0 = (st - s * spq) * 16; const size_t row0 = (size_t)st * 16;
        float prev[16], cur[16], nx[16];
        ea_load_row(p, c, s, pos0 - 1, lane, prev); ea_norm(prev, nw);
        ea_load_row(p, c, s, pos0, lane, cur); ea_store_row(slot(p, 0), row0, lane, cur); ea_norm(cur, nw);
        for (int i = 0; i < 16; ++i) {
            ea_load_row(p, c, s, pos0 + i + 1, lane, nx);
            if (i < 15) ea_store_row(slot(p, 0), row0 + i + 1, lane, nx);
            ea_norm(nx, nw);
            float xx[16], o[16];
#pragma unroll
            for (int e = 0; e < 16; ++e) xx[e] = 0.5f * (prev[e] + nx[e]) - cur[e];
            for (int m = 0; m < 6; ++m) {
#pragma unroll
                for (int j = 0; j < 4; ++j) { const f32x4 t = *(const f32x4*)(p.in[6] + m * D + j * 256 + lane * 4);
#pragma unroll
                    for (int e = 0; e < 4; ++e) o[4 * j + e] = cur[4 * j + e] + xx[4 * j + e] * t[e]; }
                ea_store_row(slot(p, 1 + m), row0 + i, lane, o); }
#pragma unroll
            for (int e = 0; e < 16; ++e) { prev[e] = cur[e]; cur[e] = nx[e]; }
        }
    }
}

__device__ __forceinline__ void phase_prescan(const Params& p, const Ctx& c) {
    const int wave = __builtin_amdgcn_readfirstlane(ltid() >> 6), lane = ltid() & 63;
    const int gw = blockIdx.x * 8 + wave, NW = gridDim.x * 8; const int ch0 = lane * 16;
    float kkw[16], kaw[16], rkw[16];
    load16f(p.in[16] + ch0, kkw); load16f(p.in[17] + ch0, kaw); load16f(p.in[18] + ch0, rkw);
    float* bonus = (float*)(p.ws + O_BONUS);
    for (int row = gw; row < c.R; row += NW) {
        const size_t e = (size_t)row * 1024 + ch0;
        float k[16], a0[16], a1[16], r[16];
        load16bf(slot(p, 8), e, k); load16bf(slot(p, 3), e, a0); load16bf(slot(p, 4), e, a1); load16bf(slot(p, 7), e, r);
        float kk[16], n2 = 0.f;
#pragma unroll
        for (int i = 0; i < 16; ++i) { kk[i] = k[i] * kkw[i]; n2 += kk[i] * kk[i]; }
        n2 += __shfl_xor(n2, 1); n2 += __shfl_xor(n2, 2);
        const float inv = 1.f / fmaxf(sqrtf(n2), 1e-12f);
        float bon = 0.f;
#pragma unroll
        for (int i = 0; i < 16; ++i) { kk[i] *= inv; const float kd0 = k[i] * (1.f + (a0[i] - 1.f) * kaw[i]), kd1 = k[i] * (1.f + (a1[i] - 1.f) * kaw[i]);
            bon += r[i] * (kd0 + kd1) * rkw[i]; }
        bon += __shfl_xor(bon, 1); bon += __shfl_xor(bon, 2);
        if ((lane & 3) == 0) bonus[(size_t)row * 16 + (lane >> 2)] = bon;
        store16bf(slot(p, 6), e, kk);
    }
}

__device__ __forceinline__ float half_sum(float x) {
    const unsigned a = __float_as_uint(x); auto r = __builtin_amdgcn_permlane32_swap(a, a, false, false);
    return __uint_as_float(r[0]) + __uint_as_float(r[1]);
}
__device__ __forceinline__ float ldbf(const unsigned char* base, int idx) { return __uint_as_float(((unsigned)((const bf16_t*)base)[idx]) << 16); }
__device__ __forceinline__ float quarter_sum(float x) {
    const unsigned a = __float_as_uint(x); auto r = __builtin_amdgcn_permlane16_swap(a, a, false, false);
    return half_sum(__uint_as_float(r[0]) + __uint_as_float(r[1]));
}
template <int RPL, int JP, int RING>
__device__ __forceinline__ void scan_items(LAS unsigned char* lds, const Params& p, const Ctx& c) {
    constexpr int LR = 64 / JP, NJ = 64 / JP, ROWS = LR * RPL, WPS = 64 / ROWS, NQ = NJ / 4, BQ = RPL == 2 ? 1 : 2, NB = NQ / BQ;
    const int tid = ltid(); const int wave = __builtin_amdgcn_readfirstlane(tid >> 6), lane = tid & 63;
    const int nitem = c.nseq * 32 * WPS; const int lr = lane % LR, jp = lane / LR;
    LAS float* wb = (LAS float*)(lds + wave * 16384);
    LAS float* oring = wb + 1024;
    for (int w = blockIdx.x + gridDim.x * wave; w < nitem; w += gridDim.x * 8) {
        const int q = w / WPS, rq = w % WPS; const int dir = q & 1, hh = (q >> 1) & 15, s = q >> 5;
        const size_t e0 = (size_t)s * c.T * 1024 + hh * 64;
        const unsigned char* Rb = slot(p, 7) + e0 * 2; const unsigned char* Kkb = slot(p, 6) + e0 * 2; const unsigned char* Vb = slot(p, 9) + e0 * 2;
        const unsigned char* Ngb = slot(p, 1 + dir) + e0 * 2; const unsigned char* Bdb = slot(p, 3 + dir) + e0 * 2;
        const unsigned char* Kdb = slot(p, 8) + e0 * 2; unsigned char* Ob = slot(p, 11 + dir) + e0 * 2;
        const float kaj = p.in[17][hh * 64 + lane];
        const int vrow0 = rq * ROWS + lr;
        const int step = dir ? -2048 : 2048; const long ro0 = dir ? (long)(c.T - 1) * 2048 : 0;
        f32x2 S2[RPL][NJ / 2];
#pragma unroll
        for (int a_ = 0; a_ < RPL; ++a_)
#pragma unroll
            for (int j = 0; j < NJ / 2; ++j) S2[a_][j] = (f32x2){0.f, 0.f};
        float xr[RING][5 + RPL];
#define SCAN_LD(dst, tt) do { const int _t = (tt) < c.T ? (tt) : c.T - 1; const long _r = ro0 + (long)_t * step; \
            dst[0] = ldbf(Kkb + _r, lane); dst[1] = ldbf(Ngb + _r, lane); dst[2] = ldbf(Bdb + _r, lane); dst[3] = ldbf(Kdb + _r, lane); dst[4] = ldbf(Rb + _r, lane); \
            _Pragma("unroll") for (int _a = 0; _a < RPL; ++_a) dst[5 + _a] = ldbf(Vb + _r, vrow0 + _a * LR); } while (0)
#define SCAN_RD4(dst, base, jj) do { _Pragma("unroll") for (int _h = 0; _h < BQ; ++_h) { dst[4 * _h] = ((const LAS f32x4*)((base) + 64))[(jj) + _h]; dst[4 * _h + 1] = ((const LAS f32x4*)((base) + 128))[(jj) + _h]; \
            dst[4 * _h + 2] = ((const LAS f32x4*)((base) + 192))[(jj) + _h]; dst[4 * _h + 3] = ((const LAS f32x4*)((base) + 256))[(jj) + _h]; } } while (0)
        float vi[RPL];
        { float x[5 + RPL]; SCAN_LD(x, 0); wb[lane] = x[0]; wb[64 + lane] = x[1]; wb[128 + lane] = x[0] * x[2]; wb[192 + lane] = x[3] * (1.f + (x[2] - 1.f) * kaj); wb[256 + lane] = x[4];
#pragma unroll
          for (int a_ = 0; a_ < RPL; ++a_) vi[a_] = x[5 + a_]; }
#pragma unroll
        for (int k = 1; k < RING; ++k) SCAN_LD(xr[k], k);
        SCAN_LD(xr[0], RING);
        f32x4 kq[NQ];
#pragma unroll
        for (int j = 0; j < NQ; ++j) kq[j] = ((const LAS f32x4*)(wb + jp * NJ))[j];
        int fstart = 0;
        for (int tb = 0; tb < c.T; tb += RING) {
#pragma unroll
            for (int k = 0; k < RING; ++k) {
                const int t = tb + k;
                const LAS float* sb = wb + (k & 1) * 512 + jp * NJ; LAS float* sn = wb + ((k + 1) & 1) * 512;
                f32x4 PQ[2][4 * BQ];
                SCAN_RD4(PQ[0], sb, 0);
                __builtin_amdgcn_sched_barrier(0);
                float sa[RPL];
#pragma unroll
                for (int a_ = 0; a_ < RPL; ++a_) { f32x2 a0 = (f32x2){0.f, 0.f}, a1 = (f32x2){0.f, 0.f};
#pragma unroll
                    for (int j = 0; j < NQ; ++j) { a0 = __builtin_elementwise_fma(S2[a_][2 * j], (f32x2){kq[j][0], kq[j][1]}, a0); a1 = __builtin_elementwise_fma(S2[a_][2 * j + 1], (f32x2){kq[j][2], kq[j][3]}, a1); }
                    sa[a_] = (a0[0] + a0[1]) + (a1[0] + a1[1]); }
                float (&xs)[5 + RPL] = xr[(k + 1) % RING];
                sn[lane] = xs[0]; sn[64 + lane] = xs[1]; sn[128 + lane] = xs[0] * xs[2]; sn[192 + lane] = xs[3] * (1.f + (xs[2] - 1.f) * kaj); sn[256 + lane] = xs[4];
                float vcur[RPL];
#pragma unroll
                for (int a_ = 0; a_ < RPL; ++a_) { vcur[a_] = vi[a_]; vi[a_] = xs[5 + a_]; }
                SCAN_LD(xs, t + 1 + RING);
                f32x2 sa2[RPL], v2[RPL], oa0[RPL], oa1[RPL];
#pragma unroll
                for (int a_ = 0; a_ < RPL; ++a_) { const float sr = -(JP == 2 ? half_sum(sa[a_]) : quarter_sum(sa[a_])); sa2[a_] = (f32x2){sr, sr}; v2[a_] = (f32x2){vcur[a_], vcur[a_]};
                    oa0[a_] = (f32x2){0.f, 0.f}; oa1[a_] = (f32x2){0.f, 0.f}; }
#pragma unroll
                for (int b_ = 0; b_ < NB; ++b_) {
                    if (b_ + 1 < NB) { SCAN_RD4(PQ[(b_ + 1) & 1], sb, BQ * (b_ + 1)); }
                    else {
#pragma unroll
                        for (int j = 0; j < NQ; ++j) kq[j] = ((const LAS f32x4*)(sn + jp * NJ))[j];
                    }
                    __builtin_amdgcn_sched_barrier(0);
#pragma unroll
                    for (int h_ = 0; h_ < BQ; ++h_) { const f32x4 g4 = PQ[b_ & 1][4 * h_], b4 = PQ[b_ & 1][4 * h_ + 1], d4 = PQ[b_ & 1][4 * h_ + 2], r4 = PQ[b_ & 1][4 * h_ + 3]; const int j_ = 2 * (BQ * b_ + h_);
#pragma unroll
                        for (int a_ = 0; a_ < RPL; ++a_) { f32x2 s0 = S2[a_][j_], s1 = S2[a_][j_ + 1];
                            s0 = __builtin_elementwise_fma(s0, (f32x2){g4[0], g4[1]}, s0); s1 = __builtin_elementwise_fma(s1, (f32x2){g4[2], g4[3]}, s1);
                            s0 = __builtin_elementwise_fma(sa2[a_], (f32x2){b4[0], b4[1]}, s0); s1 = __builtin_elementwise_fma(sa2[a_], (f32x2){b4[2], b4[3]}, s1);
                            s0 = __builtin_elementwise_fma(v2[a_], (f32x2){d4[0], d4[1]}, s0); s1 = __builtin_elementwise_fma(v2[a_], (f32x2){d4[2], d4[3]}, s1);
                            S2[a_][j_] = s0; S2[a_][j_ + 1] = s1;
                            oa0[a_] = __builtin_elementwise_fma(s0, (f32x2){r4[0], r4[1]}, oa0[a_]); oa1[a_] = __builtin_elementwise_fma(s1, (f32x2){r4[2], r4[3]}, oa1[a_]); } }
                    __builtin_amdgcn_sched_barrier(0);
                }
#pragma unroll
                for (int a_ = 0; a_ < RPL; ++a_) { const float os_ = (oa0[a_][0] + oa0[a_][1]) + (oa1[a_][0] + oa1[a_][1]); const float ov = JP == 2 ? half_sum(os_) : quarter_sum(os_);
                    if (jp == 0) oring[(t & 63) * ROWS + a_ * LR + lr] = ov; }
            }
            const int tend = tb + RING, nfl = tend - fstart;
            if (nfl == 64 || tend >= c.T) {
                for (int idx = lane; idx < nfl * ROWS; idx += 64) { const int st = idx / ROWS, row = idx % ROWS;
                    ((bf16_t*)(Ob + ro0 + (long)(fstart + st) * step))[rq * ROWS + row] = (bf16_t)(pk2(oring[idx], 0.f) & 0xffffu); }
                fstart = tend;
            }
        }
#undef SCAN_LD
#undef SCAN_RD4
    }
}
__device__ __forceinline__ void phase_scan(LAS unsigned char* lds, const Params& p, const Ctx& c) {
    if (c.g < 2) scan_items<1, 2, 8>(lds, p, c); else scan_items<1, 4, 8>(lds, p, c);
}

__device__ __forceinline__ void phase_postscan(const Params& p, const Ctx& c) {
    const int wave = __builtin_amdgcn_readfirstlane(ltid() >> 6), lane = ltid() & 63;
    const int gw = blockIdx.x * 8 + wave, NW = gridDim.x * 8; const int ch0 = lane * 16;
    float gw_[16], gb_[16]; load16f(p.in[19] + ch0, gw_); load16f(p.in[20] + ch0, gb_);
    const float* bonus = (const float*)(p.ws + O_BONUS);
    for (int row = gw; row < c.R; row += NW) {
        const size_t e = (size_t)row * 1024 + ch0;
        float of[16], ob[16], v[16], g[16];
        load16bf(slot(p, 11), e, of); load16bf(slot(p, 12), e, ob); load16bf(slot(p, 9), e, v); load16bf(slot(p, 5), e, g);
        float sum = 0.f;
#pragma unroll
        for (int i = 0; i < 16; ++i) { of[i] += ob[i]; sum += of[i]; }
        sum += __shfl_xor(sum, 1); sum += __shfl_xor(sum, 2); const float mean = sum * (1.f / 64.f);
        float var = 0.f;
#pragma unroll
        for (int i = 0; i < 16; ++i) { of[i] -= mean; var += of[i] * of[i]; }
        var += __shfl_xor(var, 1); var += __shfl_xor(var, 2); const float rs = rsqrtf(var * (1.f / 64.f) + 64e-5f);
        const float bon = bonus[(size_t)row * 16 + (lane >> 2)];
#pragma unroll
        for (int i = 0; i < 16; ++i) of[i] = (of[i] * rs * gw_[i] + gb_[i] + bon * v[i]) * g[i];
        store16bf(slot(p, 1), e, of);
    }
}

__device__ __forceinline__ void phase_glu(const Params& p, const Ctx& c, int layer) {
    const size_t gt = (size_t)blockIdx.x * 512 + ltid(), NT = (size_t)gridDim.x * 512;
    const unsigned char* U = slot(p, 1); unsigned char* Aout = slot(p, 7);
    const float* cw = p.in[24] + (size_t)layer * 3 * DFF; const float* cb = p.in[25] + (size_t)layer * DFF;
    const size_t nitem = (size_t)(c.R / 16) * 352;
    for (size_t it = gt; it < nitem; it += NT) {
        const int strip = (int)(it / 352), cc = (int)(it % 352) * 8; const int row0 = strip * 16, pos0 = row0 % c.T;
        float w0[8], w1[8], w2[8], bb[8];
#pragma unroll
        for (int h = 0; h < 2; ++h) { const f32x4 a = *(const f32x4*)(cw + cc + 4 * h), b = *(const f32x4*)(cw + DFF + cc + 4 * h), d = *(const f32x4*)(cw + 2 * DFF + cc + 4 * h), e = *(const f32x4*)(cb + cc + 4 * h);
#pragma unroll
            for (int i = 0; i < 4; ++i) { w0[4 * h + i] = a[i]; w1[4 * h + i] = b[i]; w2[4 * h + i] = d[i]; bb[4 * h + i] = e[i]; } }
        const unsigned char* ur = U + (size_t)row0 * 5632 * 2 + cc * 2;
        const u32x4 z = (u32x4){0u, 0u, 0u, 0u};
        u32x4 pm = pos0 > 0 ? *(const u32x4*)(ur - 5632 * 2) : z, pc = *(const u32x4*)ur;
#pragma unroll 4
        for (int i = 0; i < 16; ++i) {
            const u32x4 pp = (pos0 + i < c.T - 1) ? *(const u32x4*)(ur + 5632 * 2) : z;
            const u32x4 ln = *(const u32x4*)(ur + DFF * 2);
            u32x4 o;
#pragma unroll
            for (int e = 0; e < 4; ++e) {
                const float c0 = bflo(pm[e]) * w0[2 * e] + bflo(pc[e]) * w1[2 * e] + bflo(pp[e]) * w2[2 * e] + bb[2 * e];
                const float c1 = bfhi(pm[e]) * w0[2 * e + 1] + bfhi(pc[e]) * w1[2 * e + 1] + bfhi(pp[e]) * w2[2 * e + 1] + bb[2 * e + 1];
                o[e] = pk2(c0 * sigmoidf_(c0) * bflo(ln[e]), c1 * sigmoidf_(c1) * bfhi(ln[e])); }
            *(u32x4*)(Aout + ((size_t)(row0 + i) * DFF + cc) * 2) = o;
            pm = pc; pc = pp; ur += 5632 * 2;
        }
    }
}

__device__ __forceinline__ void phase_final(const Params& p, const Ctx& c) {
    const int wave = __builtin_amdgcn_readfirstlane(ltid() >> 6), lane = ltid() & 63;
    const int gw = blockIdx.x * 8 + wave, NW = gridDim.x * 8; const int ch0 = lane * 16;
    float nf[16]; load16f(p.in[5] + ch0, nf);
    const int To = c.T - NMETA, nrow = c.nseq * To;
    for (int q = gw; q < nrow; q += NW) {
        const int s = q / To, po = q - s * To; const size_t row = (size_t)s * c.T + NMETA + po;
        float h[16]; load16bf(slot(p, 0), row * 1024 + ch0, h);
        float ss = 0.f;
#pragma unroll
        for (int i = 0; i < 16; ++i) ss += h[i] * h[i];
        ss = wave_sum(ss); const float rs = rsqrtf(ss * (1.f / 1024.f) + 1e-6f);
        float* dst = c.y + (size_t)q * 1024 + ch0;
#pragma unroll
        for (int j = 0; j < 4; ++j) { f32x4 o; o[0] = h[4 * j] * rs * nf[4 * j]; o[1] = h[4 * j + 1] * rs * nf[4 * j + 1]; o[2] = h[4 * j + 2] * rs * nf[4 * j + 2]; o[3] = h[4 * j + 3] * rs * nf[4 * j + 3]; ((f32x4*)dst)[j] = o; }
    }
}


#define XB_TMO      128
#define XB_XCNT(j)  (256  + 64 * (j))
#define XB_XSUB(j)  (1280 + 64 * (j))
#define XB_XGEN(j)  (2304 + 64 * (j))
#define XB_TOP      3328
#define XB_TOPGEN   3392
#define XCD_BAR_WORDS 3456
#define XB_SPIN_CAP (1u << 18)
__device__ __forceinline__ unsigned xb_ld(unsigned* p)              { return __hip_atomic_load(p, __ATOMIC_RELAXED, __HIP_MEMORY_SCOPE_AGENT); }
__device__ __forceinline__ unsigned xb_add(unsigned* p, unsigned v) { return __hip_atomic_fetch_add(p, v, __ATOMIC_RELAXED, __HIP_MEMORY_SCOPE_AGENT); }
__device__ __forceinline__ unsigned xb_xcc_id() { return (unsigned)__builtin_amdgcn_s_getreg((3 << 11) | 20) & 0xFu; }
#define XB_SPIN(cond, bar) do { unsigned _sp = 0; while (cond) { __builtin_amdgcn_s_sleep(1); \
    if ((++_sp & 255u) == 0u) { if (xb_ld(&(bar)[XB_TMO])) break; if (_sp > XB_SPIN_CAP) { atomicAdd(&(bar)[XB_TMO], 1u); break; } } } } while (0)
struct XcdBarrier { unsigned* bar; unsigned x; volatile LAS unsigned* st; };
__device__ __forceinline__ XcdBarrier xcd_barrier_post(unsigned* bar, volatile LAS unsigned* st) {
    XcdBarrier b; b.bar = bar; b.x = xb_xcc_id(); b.st = st;
    if (threadIdx.x == 0) (void)xb_add(&bar[XB_XCNT(b.x)], 1u);
    return b;
}
__device__ __forceinline__ void xcd_barrier_complete(unsigned* bar, unsigned x, unsigned& nloc, unsigned& nx) {
    const unsigned G = gridDim.x * gridDim.y * gridDim.z;
    unsigned sum, cnt, mine, sp = 0u;
    for (;;) {
        sum = 0u; cnt = 0u; mine = 0u;
#pragma unroll
        for (unsigned j = 0; j < 16; ++j) { const unsigned c = xb_ld(&bar[XB_XCNT(j)]); sum += c; cnt += (c > 0u) ? 1u : 0u; mine = (j == x) ? c : mine; }
        if (sum == G) break;
        __builtin_amdgcn_s_sleep(1);
        if ((++sp & 255u) == 0u) { if (xb_ld(&bar[XB_TMO])) break; if (sp > XB_SPIN_CAP) { atomicAdd(&bar[XB_TMO], 1u); break; } }
    }
    nloc = mine > 0u ? mine : 1u; nx = cnt > 0u ? cnt : 1u;
}
__device__ __forceinline__ void xcd_barrier(const XcdBarrier& b) {
    asm volatile("s_waitcnt vmcnt(0)" ::: "memory");
    __syncthreads();
    if (threadIdx.x == 0) {
        unsigned* bar = b.bar;
        __builtin_amdgcn_s_waitcnt(0);
        unsigned nloc = b.st[0], nx = b.st[1];
        if (nloc == 0u) { xcd_barrier_complete(bar, b.x, nloc, nx); b.st[0] = nloc; b.st[1] = nx; }
        const unsigned old = xb_add(&bar[XB_XSUB(b.x)], 1u);
        const unsigned gen = old / nloc;
        if (old + 1u == (gen + 1u) * nloc) {
            __builtin_amdgcn_fence(__ATOMIC_RELEASE, "agent");
            asm volatile("s_waitcnt vmcnt(0)" ::: "memory");
            const unsigned og = xb_add(&bar[XB_TOP], 1u);
            const unsigned tg = og / nx;
            if (og + 1u == (tg + 1u) * nx) xb_add(&bar[XB_TOPGEN], 1u);
            else XB_SPIN(xb_ld(&bar[XB_TOPGEN]) == tg, bar);
            __builtin_amdgcn_fence(__ATOMIC_ACQUIRE, "agent");
            xb_add(&bar[XB_XGEN(b.x)], 1u);
            asm volatile("s_waitcnt vmcnt(0)" ::: "memory");
        } else {
            XB_SPIN(xb_ld(&bar[XB_XGEN(b.x)]) == gen, bar);
            __builtin_amdgcn_fence(__ATOMIC_ACQUIRE, "agent");
            asm volatile("s_waitcnt vmcnt(0)" ::: "memory");
        }
    }
    __syncthreads();
}

constexpr int NSUB = 20, NPHASE = 1 + 4 * NSUB;

__device__ __forceinline__ void phase_rstd(const Params& p, int which) {
    const float* part = (const float*)(p.ws + O_SS) + (size_t)which * 16 * RP; float* rs = (float*)(p.ws + O_RSTD) + (size_t)which * RP;
    for (int r = blockIdx.x * 512 + ltid(); r < RP; r += gridDim.x * 512) rs[r] = rstd16(part, r);
}

__device__ __forceinline__ void phase_fold(const Params& p, const Ctx& c) {
    const int tid = ltid(); const int wave = __builtin_amdgcn_readfirstlane(tid >> 6), lane = tid & 63;
    const int gw = blockIdx.x * 8 + wave, NW = gridDim.x * 8; const int ch0 = lane * 16;
    const float* part = (const float*)(p.ws + O_SS) + (size_t)16 * RP;
    const int nrow = c.nseq * c.Tp, Th = c.T / 2;
    for (int q = gw; q < nrow; q += NW) {
        const int s = q / c.Tp, tf = q - s * c.Tp; float oc[16], os[16];
        if (tf > Th) {
#pragma unroll
            for (int i = 0; i < 16; ++i) { oc[i] = 0.f; os[i] = 0.f; }
        } else {
            const int r1 = s * c.T + tf; float a[16]; load16bf(slot(p, 0), (size_t)r1 * 1024 + ch0, a); const float rs1 = rsqrtf(wave_sum(lane < 16 ? part[(size_t)lane * RP + r1] : 0.f) * (1.f / 1024.f) + 1e-6f);
            if (tf == 0 || tf == Th) {
#pragma unroll
                for (int i = 0; i < 16; ++i) { oc[i] = a[i] * rs1; os[i] = 0.f; }
            } else {
                const int r2 = s * c.T + (c.T - tf); float b[16]; load16bf(slot(p, 0), (size_t)r2 * 1024 + ch0, b); const float rs2 = rsqrtf(wave_sum(lane < 16 ? part[(size_t)lane * RP + r2] : 0.f) * (1.f / 1024.f) + 1e-6f);
#pragma unroll
                for (int i = 0; i < 16; ++i) { const float x = a[i] * rs1, y = b[i] * rs2; oc[i] = x + y; os[i] = x - y; }
            }
        }
        store16bf(slot(p, 5), (size_t)q * 1024 + ch0, oc); store16bf(slot(p, 6), (size_t)q * 1024 + ch0, os);
    }
}

__device__ __forceinline__ void run_phase(LAS unsigned char* lds, const Params& p, int ph) {
    if (ph == 0) { prep_phase(lds, p); return; }
    const int g = (ph - 1) / NSUB, sp = (ph - 1) % NSUB; const Ctx c = get_ctx(p, g);
    GemmPh P; P.G = gridDim.x; P.c = blockIdx.x; P.A = nullptr; P.B = nullptr; P.O = nullptr; P.ss = nullptr; P.ssin = nullptr; P.ldo = 0; P.kind = -1;
    float* ssb = (float*)(p.ws + O_SS); const float* rsb = (const float*)(p.ws + O_RSTD);
    switch (sp) {
    case 1: P.kind = K_L1; P.nunits = MT * 15; P.lda = 1024; P.ldb = 1024; P.K = 1024; break;
    case 2: P.kind = K_L2; P.nunits = MT * 20; P.lda = 256; P.ldb = 256; P.K = 256; break;
    case 6: P.kind = K_RES; P.nunits = MT * 4; P.lda = 1024; P.ldb = 1024; P.K = 1024; P.A = (const char*)slot(p, 1); P.B = (const char*)p.ws + O_WO; P.O = slot(p, 0); P.ss = ssb; break;
    case 8: case 16: { const int l = sp == 8 ? 0 : 1; P.kind = K_U; P.nunits = MT * 22; P.lda = 1024; P.ldb = 1024; P.K = 1024; P.A = (const char*)slot(p, 0); P.B = (const char*)p.ws + O_WIN + (size_t)l * 5632 * 1024 * 2;
        P.O = slot(p, 1); P.ssin = rsb + (l ? 2 * RP : 0); } break;
    case 10: case 18: { const int l = sp == 10 ? 0 : 1; P.kind = K_RES; P.nunits = MT * 4; P.lda = DFF; P.ldb = DFF; P.K = DFF; P.A = (const char*)slot(p, 7); P.B = (const char*)p.ws + O_WOUT + (size_t)l * 1024 * DFF * 2;
        P.O = slot(p, 0); P.ss = l ? nullptr : ssb + 16 * RP; } break;
    case 12: P.kind = K_CH; P.nunits = (c.nseq * c.Tp / 256) * 8; P.lda = 1024; P.ldb = 1024; P.K = 256; P.A = (const char*)p.ws + O_CHD; P.B = (const char*)slot(p, 5); P.O = slot(p, 1); break;
    case 13: P.kind = K_TD; P.nunits = c.nseq * c.tm * 4; P.lda = 2 * c.Tp; P.ldb = 2 * c.Tp; P.K = 2 * c.Tp; P.A = (const char*)p.ws + (g < 2 ? O_DFTP : O_DFTS); P.B = (const char*)slot(p, 1); P.O = slot(p, 4); break;
    case 14: P.kind = K_RES; P.nunits = MT * 4; P.lda = 1024; P.ldb = 1024; P.K = 1024; P.A = (const char*)slot(p, 4); P.B = (const char*)p.ws + O_WF; P.O = slot(p, 0); P.ss = ssb + 2 * 16 * RP; break;
    default: break;
    }
    if (P.kind >= 0) {
        switch (P.kind) {
        case K_L1: gemm_phase<K_L1>(lds, P, p, c); break;
        case K_L2: gemm_phase<K_L2>(lds, P, p, c); break;
        case K_RES: gemm_phase<K_RES>(lds, P, p, c); break;
        case K_U: gemm_phase<K_U>(lds, P, p, c); break;
        case K_CH: gemm_phase<K_CH>(lds, P, p, c); break;
        default: gemm_phase<K_TD>(lds, P, p, c); break;
        }
        if (sp == 13) {
            const int tid = ltid(); const int wave = __builtin_amdgcn_readfirstlane(tid >> 6), lane = tid & 63; const int K2 = 2 * c.Tp;
            const bf16_t* drow = (const bf16_t*)P.A + (size_t)(NMETA - 1) * K2; const bf16_t* yT = (const bf16_t*)slot(p, 1); bf16_t* F = (bf16_t*)slot(p, 4);
            for (int it = blockIdx.x * 8 + wave; it < c.nseq * 1024; it += gridDim.x * 8) {
                const int s = it >> 10, ch = it & 1023; const bf16_t* yr = yT + ((size_t)s * 1024 + ch) * K2; float acc = 0.f;
                for (int kk = lane * 2; kk < K2; kk += 128) { const unsigned a = *(const unsigned*)(drow + kk), b = *(const unsigned*)(yr + kk); acc += bflo(a) * bflo(b) + bfhi(a) * bfhi(b); }
                acc = wave_sum(acc);
                if (lane == 0) F[((size_t)s * c.T + (NMETA - 1)) * 1024 + ch] = (bf16_t)(pk2(acc, 0.f) & 0xffffu);
            }
        }
        return;
    }
    if (sp == 0) phase_mix(p, c);
    else if (sp == 3) phase_prescan(p, c);
    else if (sp == 4) phase_scan(lds, p, c);
    else if (sp == 5) phase_postscan(p, c);
    else if (sp == 11) phase_fold(p, c);
    else if (sp == 7 || sp == 15) phase_rstd(p, sp == 7 ? 0 : 2);
    else if (sp == 9 || sp == 17) phase_glu(p, c, sp == 9 ? 0 : 1);
    else phase_final(p, c);
}

__global__ void __launch_bounds__(512, 2) mega(Params p, int ph_lo, int ph_hi) {
    extern __shared__ __attribute__((aligned(16))) unsigned char shm[];
    LAS unsigned char* lds = (LAS unsigned char*)shm;
    cg::grid_group grid = cg::this_grid();
    volatile LAS unsigned* st = (volatile LAS unsigned*)(lds + STAGE_BYTES);
    if (threadIdx.x == 0) { st[0] = 0u; st[1] = 0u; }
    __syncthreads();
    const XcdBarrier xb = xcd_barrier_post((unsigned*)(p.ws + O_BAR), st);
    for (int ph = ph_lo; ph < ph_hi; ++ph) {
        if (ph == ph_lo + 1) grid.sync();
        else if (ph > ph_lo) xcd_barrier(xb);
        run_phase(lds, p, ph);
    }
}

extern "C" void kernel_launch(void* const* d_in, const int* in_sizes, int n_in, void* d_out, int out_size, void* d_ws, size_t ws_size, hipStream_t stream) {
    static int grid = 0;
    if (grid == 0) {
        if (n_in != 27 || ws_size < WS_END) { fprintf(stderr, "kernel_launch: need 27 inputs and %zu B of workspace (got %d, %zu)\n", (size_t)WS_END, n_in, ws_size); grid = -1; return; }
        int dev = 0, cus = 0, per_cu = 0;
        hipGetDevice(&dev); hipDeviceGetAttribute(&cus, hipDeviceAttributeMultiprocessorCount, dev);
        if (hipFuncSetAttribute((const void*)mega, hipFuncAttributeMaxDynamicSharedMemorySize, STAGE_BYTES + 16) != hipSuccess) { fprintf(stderr, "hipFuncSetAttribute failed\n"); grid = -1; return; }
        hipOccupancyMaxActiveBlocksPerMultiprocessor(&per_cu, (const void*)mega, 512, STAGE_BYTES + 16);
        if (per_cu < 1) per_cu = 1;
        (void)hipGetLastError();
        grid = cus * 1;
    }
    if (grid < 0) return;
    Params p{};
    for (int i = 0; i < 27; ++i) p.in[i] = (const float*)d_in[i];
    p.out = (float*)d_out; p.ws = (unsigned char*)d_ws;
#if MK_PER_PHASE
    for (int ph = 0; ph < NPHASE; ++ph) hipLaunchKernelGGL(mega, dim3(grid), dim3(512), STAGE_BYTES + 16, stream, p, ph, ph + 1);
#else
    (void)hipMemsetAsync((unsigned char*)d_ws + O_BAR, 0, 16384, stream);
    int lo = 0, hi = NPHASE;
    void* args[] = {&p, &lo, &hi};
    hipError_t e = hipLaunchCooperativeKernel((const void*)mega, dim3(grid), dim3(512), args, STAGE_BYTES + 16, stream);
    if (e != hipSuccess) fprintf(stderr, "cooperative launch failed: %s (grid %d)\n", hipGetErrorString(e), grid);
#endif
}
```

```cpp
#include <hip/hip_runtime.h>
#include <hip/hip_cooperative_groups.h>
#include <cstdio>
namespace cg = cooperative_groups;

#ifndef MK_PER_PHASE
#define MK_PER_PHASE 0
#endif

#define LAS __attribute__((address_space(3)))
typedef unsigned short bf16_t;
typedef short bf16x8 __attribute__((ext_vector_type(8)));
typedef float f32x4 __attribute__((ext_vector_type(4)));
typedef unsigned u32x4 __attribute__((ext_vector_type(4)));
typedef unsigned u32x2 __attribute__((ext_vector_type(2)));
typedef float f32x2 __attribute__((ext_vector_type(2)));
typedef const __attribute__((address_space(4))) unsigned* cptr;

constexpr int D = 1024, DFF = 2816, NMETA = 16;
constexpr int RP = 33024;
constexpr int MT = RP / 256;
constexpr size_t SLOT = (size_t)RP * D * 2;
constexpr int NSLOT = 13;
constexpr size_t O_WRKV = NSLOT * SLOT;
constexpr size_t O_G1 = O_WRKV + (size_t)3072 * 1024 * 2;
constexpr size_t O_W1 = O_G1 + (size_t)256 * 1024 * 2;
constexpr size_t O_A1 = O_W1 + (size_t)256 * 1024 * 2;
constexpr size_t O_L2 = O_A1 + (size_t)256 * 1024 * 2;
constexpr size_t O_G2 = O_L2 + (size_t)4096 * 256 * 2;
constexpr size_t O_WO = O_G2 + (size_t)1024 * 256 * 2;
constexpr size_t O_WF = O_WO + (size_t)1024 * 1024 * 2;
constexpr size_t O_WIN = O_WF + (size_t)1024 * 1024 * 2;
constexpr size_t O_WOUT = O_WIN + (size_t)2 * 5632 * 1024 * 2;
constexpr size_t O_CHD = O_WOUT + (size_t)2 * 1024 * 2816 * 2;
constexpr int TP_P = 1088, TP_S = 2112, MP_P = 2304, MP_S = 4352;
constexpr size_t O_DFTP = O_CHD + (size_t)2048 * 1024 * 2;
constexpr size_t O_DFTS = O_DFTP + (size_t)MP_P * 2 * TP_P * 2;
constexpr size_t O_SS = O_DFTS + (size_t)MP_S * 2 * TP_S * 2;
constexpr size_t O_RSTD = O_SS + (size_t)3 * 16 * RP * 4;
constexpr size_t O_BONUS = O_RSTD + (size_t)3 * RP * 4;
constexpr size_t O_BAR = O_BONUS + (size_t)RP * 16 * 4;
constexpr size_t WS_END = O_BAR + 16384;

struct Params { const float* in[27]; float* out; unsigned char* ws; };
struct Ctx { int g, T, nseq, R, Tp, tm; const float* x; float* y; };

__device__ __forceinline__ Ctx get_ctx(const Params& p, int g) {
    Ctx c; c.g = g;
    if (g < 2) { c.T = 2064; c.nseq = 16; c.Tp = TP_P; c.tm = 8; c.x = p.in[0] + (size_t)g * 16 * 2048 * 1024; c.y = p.out + (size_t)g * 16 * 2048 * 1024; }
    else { c.T = 4112; c.nseq = 8; c.Tp = TP_S; c.tm = 16; c.x = p.in[1] + (size_t)(g - 2) * 8 * 4096 * 1024; c.y = p.out + (size_t)32 * 2048 * 1024 + (size_t)(g - 2) * 8 * 4096 * 1024; }
    c.R = c.nseq * c.T; return c;
}
__device__ __forceinline__ int ltid() { int t = threadIdx.x; asm volatile("" : "+v"(t)); return t; }
__device__ __forceinline__ unsigned char* slot(const Params& p, int i) { return p.ws + (size_t)i * SLOT; }

__device__ __forceinline__ unsigned pk2(float lo, float hi) { unsigned r; asm volatile("v_cvt_pk_bf16_f32 %0, %1, %2" : "=v"(r) : "v"(lo), "v"(hi)); return r; }
__device__ __forceinline__ float bflo(unsigned u) { return __uint_as_float(u << 16); }
__device__ __forceinline__ float bfhi(unsigned u) { return __uint_as_float(u & 0xffff0000u); }
__device__ __forceinline__ float wave_sum(float v) {
#pragma unroll
    for (int o = 1; o < 64; o <<= 1) v += __shfl_xor(v, o);
    return v;
}
__device__ __forceinline__ float sigmoidf_(float x) { return __builtin_amdgcn_rcpf(1.f + __expf(-x)); }
__device__ __forceinline__ void unpack16(const u32x4 a, const u32x4 b, float (&v)[16]) {
#pragma unroll
    for (int i = 0; i < 4; ++i) { v[2 * i] = bflo(a[i]); v[2 * i + 1] = bfhi(a[i]); v[8 + 2 * i] = bflo(b[i]); v[8 + 2 * i + 1] = bfhi(b[i]); }
}
__device__ __forceinline__ void load16bf(const unsigned char* base, size_t elem, float (&v)[16]) {
    const u32x4* q = (const u32x4*)(base + elem * 2); unpack16(q[0], q[1], v);
}
__device__ __forceinline__ void store16bf(unsigned char* base, size_t elem, const float (&v)[16]) {
    u32x4 a, b;
#pragma unroll
    for (int i = 0; i < 4; ++i) { a[i] = pk2(v[2 * i], v[2 * i + 1]); b[i] = pk2(v[8 + 2 * i], v[8 + 2 * i + 1]); }
    u32x4* q = (u32x4*)(base + elem * 2); q[0] = a; q[1] = b;
}
__device__ __forceinline__ void load16f(const float* src, float (&v)[16]) {
#pragma unroll
    for (int j = 0; j < 4; ++j) { f32x4 t = ((const f32x4*)src)[j]; v[4 * j] = t[0]; v[4 * j + 1] = t[1]; v[4 * j + 2] = t[2]; v[4 * j + 3] = t[3]; }
}

constexpr int BM = 256, BK = 64, HALF = 128, HTB = HALF * BK * 2, STAGE_BYTES = 8 * HTB;
__device__ __forceinline__ int lds_byte(int r, int c) { const int st = (r >> 4) * 2 + (c >> 5), rr = r & 15, cc = c & 31, ob = rr * 64 + cc * 2; return st * 1024 + (ob ^ (((ob >> 9) & 1) << 5)); }
__device__ __forceinline__ void stage_rc(int b, int& R, int& C) { const int st = b / 1024, sb = b % 1024, swz = sb ^ (((sb >> 9) & 1) << 5); R = (st >> 1) * 16 + swz / 64; C = (st & 1) * 32 + (swz % 64) / 2; }
__device__ __forceinline__ int perm32(int rho) { const int n = rho >> 4, i = rho & 15; return 8 * (i >> 2) + 4 * n + (i & 3); }

enum { K_L1 = 0, K_L2, K_RES, K_U, K_CH, K_TD };
struct Unit { const char* A; const char* B; int pm, pn, job, s; };
struct GemmPh {
    int kind, nunits, lda, ldb, K, G, c;
    const char* A; const char* B;
    unsigned char* O; float* ss; const float* ssin; int ldo;
};

__device__ __forceinline__ void xcd_order(int L, int nM, int nN, int& pm, int& pn) {
    const int nwg = nM * nN; int wgid = L; { const int q = nwg / 8, r = nwg % 8, xcd = wgid % 8, off = wgid / 8; wgid = (xcd < r ? xcd * (q + 1) : r * (q + 1) + (xcd - r) * q) + off; }
    const int nig = 8 * nN, gid = wgid / nig, fm = gid * 8, gsz = (nM - fm) < 8 ? (nM - fm) : 8;
    pm = fm + ((wgid % nig) % gsz); pn = (wgid % nig) / gsz;
}
__device__ __forceinline__ bool next_unit(const GemmPh& P, const Params& p, const Ctx& cx, int i, Unit& u) {
    const long Lg = (long)i * P.G + P.c; if (Lg >= P.nunits) return false;
    const int L = (int)Lg; u.s = 0; u.job = 0;
    if (P.kind == K_L1) {
        int pm, jn; xcd_order(L, MT, 15, pm, jn); int job, pn;
        if (jn < 12) { job = jn >> 2; pn = jn & 3; } else { job = 3 + (jn - 12); pn = 0; }
        const int aslot = job == 0 ? 1 : job == 1 ? 3 : job == 2 ? 4 : job == 3 ? 6 : job == 4 ? 2 : 5;
        u.A = (const char*)slot(p, aslot) + (size_t)pm * 256 * 2048;
        const size_t boff = job < 3 ? O_WRKV + ((size_t)job * 1024 + pn * 256) * 2048 : job == 3 ? O_G1 : job == 4 ? O_W1 : O_A1;
        u.B = (const char*)p.ws + boff; u.pm = pm; u.pn = pn; u.job = job;
    } else if (P.kind == K_L2) {
        int pm, jn; xcd_order(L, MT, 20, pm, jn); const int job = jn < 16 ? 0 : 1, pn = jn < 16 ? jn : jn - 16;
        u.A = (const char*)slot(p, 10) + (job == 0 ? (size_t)RP * 512 : 0) + (size_t)pm * 256 * 512;
        u.B = (const char*)p.ws + (job == 0 ? O_L2 : O_G2) + (size_t)pn * 256 * 512; u.pm = pm; u.pn = pn; u.job = job;
    } else if (P.kind == K_RES) {
        int pm, pn; xcd_order(L, MT, 4, pm, pn);
        u.A = P.A + (size_t)pm * 256 * P.lda * 2; u.B = P.B + (size_t)pn * 256 * P.ldb * 2; u.pm = pm; u.pn = pn;
    } else if (P.kind == K_U) {
        int pm, pn; xcd_order(L, MT, 22, pm, pn);
        u.A = P.A + (size_t)pm * 256 * 2048; u.B = P.B + (size_t)pn * 256 * 2048; u.pm = pm; u.pn = pn;
    } else if (P.kind == K_CH) {
        int pn, pm; xcd_order(L, P.nunits >> 3, 8, pn, pm);
        u.A = P.A + (size_t)pm * 256 * 2048 + (pm & 3) * 512; u.B = (const char*)slot(p, pm < 4 ? 5 : 6) + (size_t)pn * 256 * 2048 + (pm & 3) * 512; u.pm = pm; u.pn = pn;
    } else {
        int rt, pn; xcd_order(L, cx.nseq * cx.tm, 4, rt, pn); const int s = rt / cx.tm, pm = rt % cx.tm;
        u.A = P.A + (size_t)(NMETA + pm * 256) * P.lda * 2; u.B = P.B + ((size_t)s * 1024 + pn * 256) * P.ldb * 2; u.pm = pm; u.pn = pn; u.s = s;
    }
    return true;
}

__device__ __forceinline__ void st8(unsigned char* ptr, const f32x4 a, const f32x4 b) {
    u32x4 o; o[0] = pk2(a[0], a[1]); o[1] = pk2(a[2], a[3]); o[2] = pk2(b[0], b[1]); o[3] = pk2(b[2], b[3]); *(u32x4*)ptr = o;
}
__device__ __forceinline__ float decaymap(float w) {
    const float e = 0.6065306597f * __builtin_amdgcn_rcpf(1.f + __expf(-w)); return __expf(-e) - 1.f;
}
__device__ __forceinline__ float act_apply(int act, float x) {
    if (act == 1) return __builtin_amdgcn_rcpf(1.f + __expf(-x));
    if (act == 2) return 1.f - 2.f * __builtin_amdgcn_rcpf(__expf(2.f * x) + 1.f);
    if (act == 3) return decaymap(x);
    return x;
}

__device__ __forceinline__ float rstd16(const float* ss, int r) {
    float s = 0.f;
#pragma unroll
    for (int i = 0; i < 16; ++i) s += ss[(size_t)i * RP + r];
    return rsqrtf(s * (1.f / 1024.f) + 1e-6f);
}
__device__ __forceinline__ void epilogue(const GemmPh& P, const Params& p, const Ctx& cx, const f32x4 (&acc)[2][2][4][2], const Unit& u, int wr, int wc, int fr, int fq) {
    const int rbase = u.pm * 256 + wr * 64 + fr, cbase = u.pn * 256 + wc * 32 + 8 * fq;
    if (P.kind == K_L1 || P.kind == K_L2) {
        unsigned char* O; int ldo = 1024, coff = 0, act = 0, cvalid = 1 << 30; const float* bias = nullptr;
        if (P.kind == K_L1) {
            if (u.job < 3) { O = slot(p, 7 + u.job); }
            else if (u.job == 3) { O = slot(p, 10); ldo = 256; act = 1; }
            else if (u.job == 4) { O = slot(p, 10) + (size_t)RP * 512; ldo = 256; act = 2; cvalid = 128; }
            else { O = slot(p, 10) + (size_t)RP * 512; ldo = 256; coff = 128; cvalid = 128; }
        } else {
            if (u.job == 1) { O = slot(p, 5); }
            else { const int cb = u.pn >> 2; O = slot(p, 1 + cb); bias = (cb < 2 ? p.in[8] : p.in[11]) + (cb & 1) * 1024 - cb * 1024; coff = -cb * 1024; act = cb < 2 ? 3 : 1; }
        }
        f32x4 bv[2][2];
#pragma unroll
        for (int bj = 0; bj < 2; ++bj)
#pragma unroll
            for (int n = 0; n < 2; ++n) bv[bj][n] = bias ? *(const f32x4*)(bias + cbase + bj * 128 + 4 * n) : (f32x4){0.f, 0.f, 0.f, 0.f};
#pragma unroll
        for (int ai = 0; ai < 2; ++ai)
#pragma unroll
            for (int m = 0; m < 4; ++m) { if ((m & 1) == 0) __builtin_amdgcn_sched_barrier(0);
#pragma unroll
                for (int bj = 0; bj < 2; ++bj) { const int r = rbase + ai * 128 + m * 16; const int c0 = cbase + bj * 128;
                    f32x4 v0 = acc[ai][bj][m][0] + bv[bj][0], v1 = acc[ai][bj][m][1] + bv[bj][1];
#pragma unroll
                    for (int i = 0; i < 4; ++i) { v0[i] = act_apply(act, v0[i]); v1[i] = act_apply(act, v1[i]); }
                    if (c0 < cvalid) st8(O + ((size_t)r * ldo + coff + c0) * 2, v0, v1); } }
    } else if (P.kind == K_RES) {
        unsigned char* H = P.O;
#pragma unroll
        for (int ai = 0; ai < 2; ++ai)
#pragma unroll
            for (int m = 0; m < 4; ++m) { if ((m & 1) == 0) __builtin_amdgcn_sched_barrier(0); const int r = rbase + ai * 128 + m * 16; float sq = 0.f;
#pragma unroll
                for (int bj = 0; bj < 2; ++bj) { unsigned char* ptr = H + ((size_t)r * 1024 + cbase + bj * 128) * 2;
                    const u32x4 old = *(const u32x4*)ptr; u32x4 o; const f32x4 a0 = acc[ai][bj][m][0], a1 = acc[ai][bj][m][1];
                    o[0] = pk2(bflo(old[0]) + a0[0], bfhi(old[0]) + a0[1]); o[1] = pk2(bflo(old[1]) + a0[2], bfhi(old[1]) + a0[3]);
                    o[2] = pk2(bflo(old[2]) + a1[0], bfhi(old[2]) + a1[1]); o[3] = pk2(bflo(old[3]) + a1[2], bfhi(old[3]) + a1[3]);
#pragma unroll
                    for (int i = 0; i < 4; ++i) { const float rl = bflo(o[i]), rh = bfhi(o[i]); sq += rl * rl + rh * rh; }
                    *(u32x4*)ptr = o; }
                if (P.ss) { sq += __shfl_xor(sq, 16); sq += __shfl_xor(sq, 32); if (fq == 0) P.ss[(size_t)(u.pn * 4 + wc) * RP + r] = sq; } }
    } else if (P.kind == K_U) {
#pragma unroll
        for (int ai = 0; ai < 2; ++ai)
#pragma unroll
            for (int m = 0; m < 4; ++m) { if ((m & 1) == 0) __builtin_amdgcn_sched_barrier(0); const int r = rbase + ai * 128 + m * 16; const float rs = P.ssin[r];
#pragma unroll
                for (int bj = 0; bj < 2; ++bj) st8(P.O + ((size_t)r * 5632 + cbase + bj * 128) * 2, acc[ai][bj][m][0] * rs, acc[ai][bj][m][1] * rs); }
    } else if (P.kind == K_CH) {
#pragma unroll
        for (int bj = 0; bj < 2; ++bj) { const int n0 = cbase + bj * 128; const int s = n0 / cx.Tp, t = n0 - s * cx.Tp;
#pragma unroll
            for (int ai = 0; ai < 2; ++ai)
#pragma unroll
                for (int m = 0; m < 4; ++m) { if ((m & 1) == 0) __builtin_amdgcn_sched_barrier(0); const int rr = rbase + ai * 128 + m * 16; const int cs = rr >> 10, ch = rr & 1023;
                    st8(P.O + ((((size_t)s * 1024 + ch) * 2 + cs) * cx.Tp + t) * 2, acc[ai][bj][m][0], acc[ai][bj][m][1]); } }
    } else {
#pragma unroll
        for (int ai = 0; ai < 2; ++ai)
#pragma unroll
            for (int m = 0; m < 4; ++m) { if ((m & 1) == 0) __builtin_amdgcn_sched_barrier(0); const int k = NMETA + rbase + ai * 128 + m * 16; const size_t row = (size_t)u.s * cx.T + k;
#pragma unroll
                for (int bj = 0; bj < 2; ++bj) if (k < cx.T) st8(P.O + (row * 1024 + cbase + bj * 128) * 2, acc[ai][bj][m][0], acc[ai][bj][m][1]); }
    }
}

template <int KIND> __device__ __forceinline__ void gemm_phase(LAS unsigned char* lds, GemmPh P, const Params& p, const Ctx& cx) {
    P.kind = KIND;
    const int tid = ltid(), wid = __builtin_amdgcn_readfirstlane(tid >> 6), lane = tid & 63, wr = wid >> 2, wc = wid & 3, fr = lane & 15, fq = lane >> 4;
    const int nt = P.K / BK;
    unsigned voffA[2], voffB[2];
#pragma unroll
    for (int i = 0; i < 2; ++i) { int R, C; stage_rc(tid * 16 + i * 8192, R, C); const int Rb = (R & ~31) + perm32(R & 31);
        voffA[i] = (unsigned)(R * P.lda + C) * 2u; voffB[i] = (unsigned)(Rb * P.ldb + C) * 2u; }
    const size_t kstep = (size_t)(BK * 2);
    const size_t hstepA = (size_t)HALF * P.lda * 2, hstepB = (size_t)HALF * P.ldb * 2;
    const unsigned ldsw = (unsigned)wid * 1024u;
    const int aoff = lds_byte(wr * 64 + fr, fq * 8), boff = lds_byte(wc * 32 + fr, fq * 8);
#define PG8_SA(b, h) (((b) * 2 + (h)) * HTB)
#define PG8_SB(b, h) ((4 + (b) * 2 + (h)) * HTB)
#define PG8_STAGE(bufoff, gbase, voff) do { _Pragma("unroll") for (int _i = 0; _i < 2; ++_i) \
        __builtin_amdgcn_global_load_lds((const unsigned*)((const char*)(gbase) + (voff)[_i]), (LAS unsigned*)(lds + (bufoff) + ldsw + _i * 8192), 16, 0, 0); } while (0)
#define PG8_LDA(dst, b, h) do { _Pragma("unroll") for (int m = 0; m < 4; ++m) _Pragma("unroll") for (int k = 0; k < 2; ++k) dst[m][k] = *(const LAS bf16x8*)(lds + PG8_SA(b, h) + aoff + m * 2048 + k * 1024); } while (0)
#define PG8_LDB(dst, b, h) do { _Pragma("unroll") for (int n = 0; n < 2; ++n) _Pragma("unroll") for (int k = 0; k < 2; ++k) dst[n][k] = *(const LAS bf16x8*)(lds + PG8_SB(b, h) + boff + n * 2048 + k * 1024); } while (0)
#define PG8_MMA(ai, bj, At, Bt) do { __builtin_amdgcn_s_setprio(1); _Pragma("unroll") for (int m = 0; m < 4; ++m) _Pragma("unroll") for (int n = 0; n < 2; ++n) _Pragma("unroll") for (int k = 0; k < 2; ++k) \
        acc[ai][bj][m][n] = __builtin_amdgcn_mfma_f32_16x16x32_bf16(Bt[n][k], At[m][k], acc[ai][bj][m][n], 0, 0, 0); __builtin_amdgcn_s_setprio(0); } while (0)
#define PG8_WAIT_V(n) asm volatile("s_waitcnt vmcnt(" #n ")" ::: "memory")
#define PG8_WAIT_L(n) asm volatile("s_waitcnt lgkmcnt(" #n ")" ::: "memory")
#define PG8_BAR __builtin_amdgcn_s_barrier()
#define PG8_SCHED __builtin_amdgcn_sched_barrier(0)
    Unit cur, nxt; int ui = 0;
    if (!next_unit(P, p, cx, 0, cur)) return;
    f32x4 acc[2][2][4][2];
#pragma unroll
    for (int a = 0; a < 2; ++a)
#pragma unroll
        for (int b = 0; b < 2; ++b)
#pragma unroll
            for (int m = 0; m < 4; ++m)
#pragma unroll
                for (int n = 0; n < 2; ++n) acc[a][b][m][n] = (f32x4){0.f, 0.f, 0.f, 0.f};
    bf16x8 At[4][2], B0[2][2], B1[2][2];
    const char* cA = cur.A; const char* cB = cur.B;
    PG8_STAGE(PG8_SB(0, 0), cB, voffB); PG8_STAGE(PG8_SA(0, 0), cA, voffA); PG8_STAGE(PG8_SB(0, 1), cB + hstepB, voffB); PG8_STAGE(PG8_SA(0, 1), cA + hstepA, voffA);
    if (wr == 1) PG8_BAR;
    PG8_WAIT_V(4); PG8_BAR;
    PG8_STAGE(PG8_SB(1, 0), cB + kstep, voffB); PG8_STAGE(PG8_SA(1, 0), cA + kstep, voffA); PG8_STAGE(PG8_SB(1, 1), cB + hstepB + kstep, voffB);
    PG8_WAIT_V(6); PG8_BAR;
    for (;;) {
        const bool has_next = next_unit(P, p, cx, ui + 1, nxt);
        const char* nA = has_next ? nxt.A : cA; const char* nB = has_next ? nxt.B : cB;
        for (int t = 0; t < nt; t += 2) {
            const bool last = (t == nt - 2);
            const char* a1 = cA + (size_t)(t + 1) * kstep;
            const char* a2 = last ? nA : cA + (size_t)(t + 2) * kstep; const char* b2 = last ? nB : cB + (size_t)(t + 2) * kstep;
            const char* a3 = a2 + kstep; const char* b3 = b2 + kstep;
            PG8_LDB(B0, 0, 0); PG8_SCHED; PG8_LDA(At, 0, 0); PG8_STAGE(PG8_SA(1, 1), a1 + hstepA, voffA);
            PG8_WAIT_L(8); PG8_BAR; PG8_WAIT_L(0); PG8_MMA(0, 0, At, B0); PG8_BAR; PG8_SCHED;
            PG8_LDB(B1, 0, 1); PG8_STAGE(PG8_SB(0, 0), b2, voffB);
            PG8_BAR; PG8_WAIT_L(0); PG8_MMA(0, 1, At, B1); PG8_BAR;
            PG8_LDA(At, 0, 1); PG8_STAGE(PG8_SA(0, 0), a2, voffA);
            PG8_BAR; PG8_WAIT_L(0); PG8_MMA(1, 0, At, B0); PG8_BAR; PG8_SCHED;
            PG8_STAGE(PG8_SB(0, 1), b2 + hstepB, voffB);
            PG8_WAIT_V(6); PG8_BAR; PG8_MMA(1, 1, At, B1); PG8_BAR;
            PG8_LDB(B0, 1, 0); PG8_SCHED; PG8_LDA(At, 1, 0); PG8_STAGE(PG8_SA(0, 1), a2 + hstepA, voffA);
            PG8_WAIT_L(8); PG8_BAR; PG8_WAIT_L(0); PG8_MMA(0, 0, At, B0); PG8_BAR; PG8_SCHED;
            PG8_LDB(B1, 1, 1); PG8_STAGE(PG8_SB(1, 0), b3, voffB);
            PG8_BAR; PG8_WAIT_L(0); PG8_MMA(0, 1, At, B1); PG8_BAR;
            PG8_LDA(At, 1, 1); PG8_STAGE(PG8_SA(1, 0), a3, voffA);
            PG8_BAR; PG8_WAIT_L(0); PG8_MMA(1, 0, At, B0); PG8_BAR; PG8_SCHED;
            PG8_STAGE(PG8_SB(1, 1), b3 + hstepB, voffB);
            PG8_WAIT_V(6); PG8_BAR; PG8_MMA(1, 1, At, B1); PG8_BAR;
        }
        epilogue(P, p, cx, acc, cur, wr, wc, fr, fq);
        if (!has_next) break;
#pragma unroll
        for (int a = 0; a < 2; ++a)
#pragma unroll
            for (int b = 0; b < 2; ++b)
#pragma unroll
                for (int m = 0; m < 4; ++m)
#pragma unroll
                    for (int n = 0; n < 2; ++n) acc[a][b][m][n] = (f32x4){0.f, 0.f, 0.f, 0.f};
        cur = nxt; cA = nA; cB = nB; ++ui;
    }
    PG8_WAIT_V(0);
    if (wr == 0) PG8_BAR;
    PG8_BAR;
#undef PG8_SA
#undef PG8_SB
#undef PG8_STAGE
#undef PG8_LDA
#undef PG8_LDB
#undef PG8_MMA
#undef PG8_WAIT_V
#undef PG8_WAIT_L
#undef PG8_BAR
#undef PG8_SCHED
}

__device__ __forceinline__ void tr_job(LAS float* tile, const float* src, int K, int N, unsigned char* dst, int ldk, int koff, int Kpad, int Npad, const float* scale, int& cnt, int stride_start, int G) {
    const int tk = Kpad / 64, tn = Npad / 64, ntile = tk * tn; const int tid = ltid();
    for (int it = 0; it < ntile; ++it, ++cnt) {
        if ((cnt % G) != stride_start) continue;
        const int k0 = (it / tn) * 64, n0 = (it % tn) * 64;
        __syncthreads();
        { const int tx = tid & 63, ty = tid >> 6;
#pragma unroll
            for (int i = 0; i < 8; ++i) { const int kd = k0 + ty + 8 * i, ks = kd - koff, n = n0 + tx; float v = 0.f;
                if (ks >= 0 && ks < K && n < N) { v = src[(size_t)ks * N + n]; if (scale) v *= scale[ks]; }
                tile[(ty + 8 * i) * 65 + tx] = v; } }
        __syncthreads();
        { const int n = tid >> 3, kc = (tid & 7) * 8; u32x4 o;
#pragma unroll
            for (int i = 0; i < 4; ++i) o[i] = pk2(tile[(kc + 2 * i) * 65 + n], tile[(kc + 2 * i + 1) * 65 + n]);
            *(u32x4*)(dst + ((size_t)(n0 + n) * ldk + k0 + kc) * 2) = o; }
    }
}

__device__ __forceinline__ void prep_phase(LAS unsigned char* lds, const Params& p) {
    LAS float* tile = (LAS float*)lds; unsigned char* ws = p.ws; int cnt = 0; const int b = blockIdx.x, G = gridDim.x;
    for (int i = 0; i < 3; ++i) tr_job(tile, p.in[7] + (size_t)i * D * D, D, D, ws + O_WRKV + (size_t)i * D * D * 2, 1024, 0, 1024, 1024, nullptr, cnt, b, G);
    tr_job(tile, p.in[14], D, 160, ws + O_G1, 1024, 0, 1024, 256, nullptr, cnt, b, G);
    tr_job(tile, p.in[9], D, 64, ws + O_W1, 1024, 0, 1024, 64, nullptr, cnt, b, G);
    tr_job(tile, p.in[9] + D * 64, D, 64, ws + O_W1 + (size_t)64 * 1024 * 2, 1024, 0, 1024, 192, nullptr, cnt, b, G);
    tr_job(tile, p.in[12], D, 64, ws + O_A1, 1024, 0, 1024, 64, nullptr, cnt, b, G);
    tr_job(tile, p.in[12] + D * 64, D, 64, ws + O_A1 + (size_t)64 * 1024 * 2, 1024, 0, 1024, 192, nullptr, cnt, b, G);
    for (int z = 0; z < 2; ++z) {
        tr_job(tile, p.in[10] + (size_t)z * 64 * D, 64, D, ws + O_L2 + (size_t)z * 1024 * 256 * 2, 256, z * 64, 256, 1024, nullptr, cnt, b, G);
        tr_job(tile, p.in[13] + (size_t)z * 64 * D, 64, D, ws + O_L2 + (size_t)(2 + z) * 1024 * 256 * 2, 256, (2 + z) * 64, 256, 1024, nullptr, cnt, b, G);
    }
    tr_job(tile, p.in[15], 160, D, ws + O_G2, 256, 0, 256, 1024, nullptr, cnt, b, G);
    tr_job(tile, p.in[21], D, D, ws + O_WO, 1024, 0, 1024, 1024, nullptr, cnt, b, G);
    tr_job(tile, p.in[22], D, D, ws + O_WF, 1024, 0, 1024, 1024, nullptr, cnt, b, G);
    for (int l = 0; l < 2; ++l) {
        tr_job(tile, p.in[23] + (size_t)l * D * 5632, D, 5632, ws + O_WIN + (size_t)l * 5632 * 1024 * 2, 1024, 0, 1024, 5632, p.in[4] + l * D, cnt, b, G);
        tr_job(tile, p.in[26] + (size_t)l * DFF * D, DFF, D, ws + O_WOUT + (size_t)l * 1024 * DFF * 2, DFF, 0, DFF, 1024, nullptr, cnt, b, G);
    }
    const size_t gt = (size_t)blockIdx.x * 512 + ltid(), NT = (size_t)gridDim.x * 512;
    const float* nm1 = p.in[3] + D;
    for (size_t e = gt; e < (size_t)2048 * 128; e += NT) {
        const int rr = (int)(e >> 7), c0 = (int)(e & 127) * 8; const int cs = rr >> 10, ch = rr & 1023; float v[8];
#pragma unroll
        for (int i = 0; i < 8; ++i) { const int c = c0 + i; float val = 0.f;
            if ((c >> 7) == (ch >> 7)) { const int m = ((ch & 127) * (c & 127)) & 127; float sn, cn; sincospif((float)m * (1.f / 64.f), &sn, &cn); val = (cs ? sn : cn) * nm1[c] * 0.08838834764831845f; }
            v[i] = val; }
        u32x4 o; o[0] = pk2(v[0], v[1]); o[1] = pk2(v[2], v[3]); o[2] = pk2(v[4], v[5]); o[3] = pk2(v[6], v[7]);
        *(u32x4*)(ws + O_CHD + e * 16) = o;
    }
    for (int ty = 0; ty < 2; ++ty) {
        const int T = ty ? 4112 : 2064, Tp = ty ? TP_S : TP_P, Mp = ty ? MP_S : MP_P; const int rowv = 2 * Tp / 8;
        unsigned char* dst = ws + (ty ? O_DFTS : O_DFTP); const float isq = rsqrtf((float)T), invT = 2.f / (float)T;
        for (size_t e = gt; e < (size_t)Mp * rowv; e += NT) {
            const int k = (int)(e / rowv), kk0 = (int)(e % rowv) * 8; float v[8];
#pragma unroll
            for (int i = 0; i < 8; ++i) { const int kk = kk0 + i; const int issin = kk >= Tp, t = issin ? kk - Tp : kk; float val = 0.f;
                if (k < T && (issin ? (t >= 1 && t <= T / 2 - 1) : (t <= T / 2))) { const int m = (int)(((long)k * t) % T); float sn, cn; sincospif((float)m * invT, &sn, &cn); val = (issin ? -sn : cn) * isq; }
                v[i] = val; }
            u32x4 o; o[0] = pk2(v[0], v[1]); o[1] = pk2(v[2], v[3]); o[2] = pk2(v[4], v[5]); o[3] = pk2(v[6], v[7]);
            *(u32x4*)(dst + e * 16) = o;
        }
    }
}

__device__ __forceinline__ void ea_load_row(const Params& p, const Ctx& c, int s, int pos, int lane, float (&v)[16]) {
    if (pos < 0 || pos >= c.T) {
#pragma unroll
        for (int i = 0; i < 16; ++i) v[i] = 0.f;
        return; }
    const float* src = pos < NMETA ? p.in[2] + (size_t)pos * D : c.x + ((size_t)s * (c.T - NMETA) + (pos - NMETA)) * D;
#pragma unroll
    for (int j = 0; j < 4; ++j) { const f32x4 t = *(const f32x4*)(src + j * 256 + lane * 4); v[4 * j] = t[0]; v[4 * j + 1] = t[1]; v[4 * j + 2] = t[2]; v[4 * j + 3] = t[3]; }
}
__device__ __forceinline__ void ea_store_row(unsigned char* base, size_t row, int lane, const float (&v)[16]) {
#pragma unroll
    for (int j = 0; j < 4; ++j) { u32x2 o; o[0] = pk2(v[4 * j], v[4 * j + 1]); o[1] = pk2(v[4 * j + 2], v[4 * j + 3]); *(u32x2*)(base + (row * 1024 + j * 256 + lane * 4) * 2) = o; }
}
__device__ __forceinline__ void ea_norm(float (&v)[16], const float (&nw)[16]) {
    float ss = 0.f;
#pragma unroll
    for (int i = 0; i < 16; ++i) ss += v[i] * v[i];
    ss = wave_sum(ss); const float rs = rsqrtf(ss * (1.f / 1024.f) + 1e-6f);
#pragma unroll
    for (int i = 0; i < 16; ++i) v[i] = v[i] * rs * nw[i];
}
__device__ __forceinline__ void phase_mix(const Params& p, const Ctx& c) {
    const int wave = __builtin_amdgcn_readfirstlane(ltid() >> 6), lane = ltid() & 63;
    const int gw = blockIdx.x * 8 + wave, NW = gridDim.x * 8;
    float nw[16];
#pragma unroll
    for (int j = 0; j < 4; ++j) { const f32x4 t = *(const f32x4*)(p.in[3] + j * 256 + lane * 4); nw[4 * j] = t[0]; nw[4 * j + 1] = t[1]; nw[4 * j + 2] = t[2]; nw[4 * j + 3] = t[3]; }
    const int nstrips = c.R / 16, spq = c.T / 16;
    for (int st = gw; st < nstrips; st += NW) {
        const int s = st / spq, pos0 = (st - s * spq) * 16; const size_t row0 = (size_t)st * 16;
        float prev[16], cur[16], nx[16];
        ea_load_row(p, c, s, pos0 - 1, lane, prev); ea_norm(prev, nw);
        ea_load_row(p, c, s, pos0, lane, cur); ea_store_row(slot(p, 0), row0, lane, cur); ea_norm(cur, nw);
        for (int i = 0; i < 16; ++i) {
            ea_load_row(p, c, s, pos0 + i + 1, lane, nx);
            if (i < 15) ea_store_row(slot(p, 0), row0 + i + 1, lane, nx);
            ea_norm(nx, nw);
            float xx[16], o[16];
#pragma unroll
            for (int e = 0; e < 16; ++e) xx[e] = 0.5f * (prev[e] + nx[e]) - cur[e];
            for (int m = 0; m < 6; ++m) {
#pragma unroll
                for (int j = 0; j < 4; ++j) { const f32x4 t = *(const f32x4*)(p.in[6] + m * D + j * 256 + lane * 4);
#pragma unroll
                    for (int e = 0; e < 4; ++e) o[4 * j + e] = cur[4 * j + e] + xx[4 * j + e] * t[e]; }
                ea_store_row(slot(p, 1 + m), row0 + i, lane, o); }
#pragma unroll
            for (int e = 0; e < 16; ++e) { prev[e] = cur[e]; cur[e] = nx[e]; }
        }
    }
}

__device__ __forceinline__ void phase_prescan(const Params& p, const Ctx& c) {
    const int wave = __builtin_amdgcn_readfirstlane(ltid() >> 6), lane = ltid() & 63;
    const int gw = blockIdx.x * 8 + wave, NW = gridDim.x * 8; const int ch0 = lane * 16;
    float kkw[16], kaw[16], rkw[16];
    load16f(p.in[16] + ch0, kkw); load16f(p.in[17] + ch0, kaw); load16f(p.in[18] + ch0, rkw);
    float* bonus = (float*)(p.ws + O_BONUS);
    for (int row = gw; row < c.R; row += NW) {
        const size_t e = (size_t)row * 1024 + ch0;
        float k[16], a0[16], a1[16], r[16];
        load16bf(slot(p, 8), e, k); load16bf(slot(p, 3), e, a0); load16bf(slot(p, 4), e, a1); load16bf(slot(p, 7), e, r);
        float kk[16], n2 = 0.f;
#pragma unroll
        for (int i = 0; i < 16; ++i) { kk[i] = k[i] * kkw[i]; n2 += kk[i] * kk[i]; }
        n2 += __shfl_xor(n2, 1); n2 += __shfl_xor(n2, 2);
        const float inv = 1.f / fmaxf(sqrtf(n2), 1e-12f);
        float bon = 0.f;
#pragma unroll
        for (int i = 0; i < 16; ++i) { kk[i] *= inv; const float kd0 = k[i] * (1.f + (a0[i] - 1.f) * kaw[i]), kd1 = k[i] * (1.f + (a1[i] - 1.f) * kaw[i]);
            bon += r[i] * (kd0 + kd1) * rkw[i]; }
        bon += __shfl_xor(bon, 1); bon += __shfl_xor(bon, 2);
        if ((lane & 3) == 0) bonus[(size_t)row * 16 + (lane >> 2)] = bon;
        store16bf(slot(p, 6), e, kk);
    }
}

__device__ __forceinline__ float half_sum(float x) {
    const unsigned a = __float_as_uint(x); auto r = __builtin_amdgcn_permlane32_swap(a, a, false, false);
    return __uint_as_float(r[0]) + __uint_as_float(r[1]);
}
__device__ __forceinline__ float ldbf(const unsigned char* base, int idx) { return __uint_as_float(((unsigned)((const bf16_t*)base)[idx]) << 16); }
__device__ __forceinline__ float quarter_sum(float x) {
    const unsigned a = __float_as_uint(x); auto r = __builtin_amdgcn_permlane16_swap(a, a, false, false);
    return half_sum(__uint_as_float(r[0]) + __uint_as_float(r[1]));
}
template <int RPL, int JP, int RING>
__device__ __forceinline__ void scan_items(LAS unsigned char* lds, const Params& p, const Ctx& c) {
    constexpr int LR = 64 / JP, NJ = 64 / JP, ROWS = LR * RPL, WPS = 64 / ROWS, NQ = NJ / 4, BQ = RPL == 2 ? 1 : 2, NB = NQ / BQ;
    const int tid = ltid(); const int wave = __builtin_amdgcn_readfirstlane(tid >> 6), lane = tid & 63;
    const int nitem = c.nseq * 32 * WPS; const int lr = lane % LR, jp = lane / LR;
    LAS float* wb = (LAS float*)(lds + wave * 16384);
    LAS float* oring = wb + 1024;
    for (int w = blockIdx.x + gridDim.x * wave; w < nitem; w += gridDim.x * 8) {
        const int q = w / WPS, rq = w % WPS; const int dir = q & 1, hh = (q >> 1) & 15, s = q >> 5;
        const size_t e0 = (size_t)s * c.T * 1024 + hh * 64;
        const unsigned char* Rb = slot(p, 7) + e0 * 2; const unsigned char* Kkb = slot(p, 6) + e0 * 2; const unsigned char* Vb = slot(p, 9) + e0 * 2;
        const unsigned char* Ngb = slot(p, 1 + dir) + e0 * 2; const unsigned char* Bdb = slot(p, 3 + dir) + e0 * 2;
        const unsigned char* Kdb = slot(p, 8) + e0 * 2; unsigned char* Ob = slot(p, 11 + dir) + e0 * 2;
        const float kaj = p.in[17][hh * 64 + lane];
        const int vrow0 = rq * ROWS + lr;
        const int step = dir ? -2048 : 2048; const long ro0 = dir ? (long)(c.T - 1) * 2048 : 0;
        f32x2 S2[RPL][NJ / 2];
#pragma unroll
        for (int a_ = 0; a_ < RPL; ++a_)
#pragma unroll
            for (int j = 0; j < NJ / 2; ++j) S2[a_][j] = (f32x2){0.f, 0.f};
        float xr[RING][5 + RPL];
#define SCAN_LD(dst, tt) do { const int _t = (tt) < c.T ? (tt) : c.T - 1; const long _r = ro0 + (long)_t * step; \
            dst[0] = ldbf(Kkb + _r, lane); dst[1] = ldbf(Ngb + _r, lane); dst[2] = ldbf(Bdb + _r, lane); dst[3] = ldbf(Kdb + _r, lane); dst[4] = ldbf(Rb + _r, lane); \
            _Pragma("unroll") for (int _a = 0; _a < RPL; ++_a) dst[5 + _a] = ldbf(Vb + _r, vrow0 + _a * LR); } while (0)
#define SCAN_RD4(dst, base, jj) do { _Pragma("unroll") for (int _h = 0; _h < BQ; ++_h) { dst[4 * _h] = ((const LAS f32x4*)((base) + 64))[(jj) + _h]; dst[4 * _h + 1] = ((const LAS f32x4*)((base) + 128))[(jj) + _h]; \
            dst[4 * _h + 2] = ((const LAS f32x4*)((base) + 192))[(jj) + _h]; dst[4 * _h + 3] = ((const LAS f32x4*)((base) + 256))[(jj) + _h]; } } while (0)
        float vi[RPL];
        { float x[5 + RPL]; SCAN_LD(x, 0); wb[lane] = x[0]; wb[64 + lane] = x[1]; wb[128 + lane] = x[0] * x[2]; wb[192 + lane] = x[3] * (1.f + (x[2] - 1.f) * kaj); wb[256 + lane] = x[4];
#pragma unroll
          for (int a_ = 0; a_ < RPL; ++a_) vi[a_] = x[5 + a_]; }
#pragma unroll
        for (int k = 1; k < RING; ++k) SCAN_LD(xr[k], k);
        SCAN_LD(xr[0], RING);
        f32x4 kq[NQ];
#pragma unroll
        for (int j = 0; j < NQ; ++j) kq[j] = ((const LAS f32x4*)(wb + jp * NJ))[j];
        int fstart = 0;
        for (int tb = 0; tb < c.T; tb += RING) {
#pragma unroll
            for (int k = 0; k < RING; ++k) {
                const int t = tb + k;
                const LAS float* sb = wb + (k & 1) * 512 + jp * NJ; LAS float* sn = wb + ((k + 1) & 1) * 512;
                f32x4 PQ[2][4 * BQ];
                SCAN_RD4(PQ[0], sb, 0);
                __builtin_amdgcn_sched_barrier(0);
                float sa[RPL];
#pragma unroll
                for (int a_ = 0; a_ < RPL; ++a_) { f32x2 a0 = (f32x2){0.f, 0.f}, a1 = (f32x2){0.f, 0.f};
#pragma unroll
                    for (int j = 0; j < NQ; ++j) { a0 = __builtin_elementwise_fma(S2[a_][2 * j], (f32x2){kq[j][0], kq[j][1]}, a0); a1 = __builtin_elementwise_fma(S2[a_][2 * j + 1], (f32x2){kq[j][2], kq[j][3]}, a1); }
                    sa[a_] = (a0[0] + a0[1]) + (a1[0] + a1[1]); }
                float (&xs)[5 + RPL] = xr[(k + 1) % RING];
                sn[lane] = xs[0]; sn[64 + lane] = xs[1]; sn[128 + lane] = xs[0] * xs[2]; sn[192 + lane] = xs[3] * (1.f + (xs[2] - 1.f) * kaj); sn[256 + lane] = xs[4];
                float vcur[RPL];
#pragma unroll
                for (int a_ = 0; a_ < RPL; ++a_) { vcur[a_] = vi[a_]; vi[a_] = xs[5 + a_]; }
                SCAN_LD(xs, t + 1 + RING);
                f32x2 sa2[RPL], v2[RPL], oa0[RPL], oa1[RPL];
#pragma unroll
                for (int a_ = 0; a_ < RPL; ++a_) { const float sr = -(JP == 2 ? half_sum(sa[a_]) : quarter_sum(sa[a_])); sa2[a_] = (f32x2){sr, sr}; v2[a_] = (f32x2){vcur[a_], vcur[a_]};
                    oa0[a_] = (f32x2){0.f, 0.f}; oa1[a_] = (f32x2){0.f, 0.f}; }
#pragma unroll
                for (int b_ = 0; b_ < NB; ++b_) {
                    if (b_ + 1 < NB) { SCAN_RD4(PQ[(b_ + 1) & 1], sb, BQ * (b_ + 1)); }
                    else {
#pragma unroll
                        for (int j = 0; j < NQ; ++j) kq[j] = ((const LAS f32x4*)(sn + jp * NJ))[j];
                    }
                    __builtin_amdgcn_sched_barrier(0);
#pragma unroll
                    for (int h_ = 0; h_ < BQ; ++h_) { const f32x4 g4 = PQ[b_ & 1][4 * h_], b4 = PQ[b_ & 1][4 * h_ + 1], d4 = PQ[b_ & 1][4 * h_ + 2], r4 = PQ[b_ & 1][4 * h_ + 3]; const int j_ = 2 * (BQ * b_ + h_);
#pragma unroll
                        for (int a_ = 0; a_ < RPL; ++a_) { f32x2 s0 = S2[a_][j_], s1 = S2[a_][j_ + 1];
                            s0 = __builtin_elementwise_fma(s0, (f32x2){g4[0], g4[1]}, s0); s1 = __builtin_elementwise_fma(s1, (f32x2){g4[2], g4[3]}, s1);
                            s0 = __builtin_elementwise_fma(sa2[a_], (f32x2){b4[0], b4[1]}, s0); s1 = __builtin_elementwise_fma(sa2[a_], (f32x2){b4[2], b4[3]}, s1);
                            s0 = __builtin_elementwise_fma(v2[a_], (f32x2){d4[0], d4[1]}, s0); s1 = __builtin_elementwise_fma(v2[a_], (f32x2){d4[2], d4[3]}, s1);
                            S2[a_][j_] = s0; S2[a_][j_ + 1] = s1;
                            oa0[a_] = __builtin_elementwise_fma(s0, (f32x2){r4[0], r4[1]}, oa0[a_]); oa1[a_] = __builtin_elementwise_fma(s1, (f32x2){r4[2], r4[3]}, oa1[a_]); } }
                    __builtin_amdgcn_sched_barrier(0);
                }
#pragma unroll
                for (int a_ = 0; a_ < RPL; ++a_) { const float os_ = (oa0[a_][0] + oa0[a_][1]) + (oa1[a_][0] + oa1[a_][1]); const float ov = JP == 2 ? half_sum(os_) : quarter_sum(os_);
                    if (jp == 0) oring[(t & 63) * ROWS + a_ * LR + lr] = ov; }
            }
            const int tend = tb + RING, nfl = tend - fstart;
            if (nfl == 64 || tend >= c.T) {
                for (int idx = lane; idx < nfl * ROWS; idx += 64) { const int st = idx / ROWS, row = idx % ROWS;
                    ((bf16_t*)(Ob + ro0 + (long)(fstart + st) * step))[rq * ROWS + row] = (bf16_t)(pk2(oring[idx], 0.f) & 0xffffu); }
                fstart = tend;
            }
        }
#undef SCAN_LD
#undef SCAN_RD4
    }
}
__device__ __forceinline__ void phase_scan(LAS unsigned char* lds, const Params& p, const Ctx& c) {
    if (c.g < 2) scan_items<1, 2, 8>(lds, p, c); else scan_items<1, 4, 8>(lds, p, c);
}

__device__ __forceinline__ void phase_postscan(const Params& p, const Ctx& c) {
    const int wave = __builtin_amdgcn_readfirstlane(ltid() >> 6), lane = ltid() & 63;
    const int gw = blockIdx.x * 8 + wave, NW = gridDim.x * 8; const int ch0 = lane * 16;
    float gw_[16], gb_[16]; load16f(p.in[19] + ch0, gw_); load16f(p.in[20] + ch0, gb_);
    const float* bonus = (const float*)(p.ws + O_BONUS);
    for (int row = gw; row < c.R; row += NW) {
        const size_t e = (size_t)row * 1024 + ch0;
        float of[16], ob[16], v[16], g[16];
        load16bf(slot(p, 11), e, of); load16bf(slot(p, 12), e, ob); load16bf(slot(p, 9), e, v); load16bf(slot(p, 5), e, g);
        float sum = 0.f;
#pragma unroll
        for (int i = 0; i < 16; ++i) { of[i] += ob[i]; sum += of[i]; }
        sum += __shfl_xor(sum, 1); sum += __shfl_xor(sum, 2); const float mean = sum * (1.f / 64.f);
        float var = 0.f;
#pragma unroll
        for (int i = 0; i < 16; ++i) { of[i] -= mean; var += of[i] * of[i]; }
        var += __shfl_xor(var, 1); var += __shfl_xor(var, 2); const float rs = rsqrtf(var * (1.f / 64.f) + 64e-5f);
        const float bon = bonus[(size_t)row * 16 + (lane >> 2)];
#pragma unroll
        for (int i = 0; i < 16; ++i) of[i] = (of[i] * rs * gw_[i] + gb_[i] + bon * v[i]) * g[i];
        store16bf(slot(p, 1), e, of);
    }
}

__device__ __forceinline__ void phase_glu(const Params& p, const Ctx& c, int layer) {
    const size_t gt = (size_t)blockIdx.x * 512 + ltid(), NT = (size_t)gridDim.x * 512;
    const unsigned char* U = slot(p, 1); unsigned char* Aout = slot(p, 7);
    const float* cw = p.in[24] + (size_t)layer * 3 * DFF; const float* cb = p.in[25] + (size_t)layer * DFF;
    const size_t nitem = (size_t)(c.R / 16) * 352;
    for (size_t it = gt; it < nitem; it += NT) {
        const int strip = (int)(it / 352), cc = (int)(it % 352) * 8; const int row0 = strip * 16, pos0 = row0 % c.T;
        float w0[8], w1[8], w2[8], bb[8];
#pragma unroll
        for (int h = 0; h < 2; ++h) { const f32x4 a = *(const f32x4*)(cw + cc + 4 * h), b = *(const f32x4*)(cw + DFF + cc + 4 * h), d = *(const f32x4*)(cw + 2 * DFF + cc + 4 * h), e = *(const f32x4*)(cb + cc + 4 * h);
#pragma unroll
            for (int i = 0; i < 4; ++i) { w0[4 * h + i] = a[i]; w1[4 * h + i] = b[i]; w2[4 * h + i] = d[i]; bb[4 * h + i] = e[i]; } }
        const unsigned char* ur = U + (size_t)row0 * 5632 * 2 + cc * 2;
        const u32x4 z = (u32x4){0u, 0u, 0u, 0u};
        u32x4 pm = pos0 > 0 ? *(const u32x4*)(ur - 5632 * 2) : z, pc = *(const u32x4*)ur;
#pragma unroll 4
        for (int i = 0; i < 16; ++i) {
            const u32x4 pp = (pos0 + i < c.T - 1) ? *(const u32x4*)(ur + 5632 * 2) : z;
            const u32x4 ln = *(const u32x4*)(ur + DFF * 2);
            u32x4 o;
#pragma unroll
            for (int e = 0; e < 4; ++e) {
                const float c0 = bflo(pm[e]) * w0[2 * e] + bflo(pc[e]) * w1[2 * e] + bflo(pp[e]) * w2[2 * e] + bb[2 * e];
                const float c1 = bfhi(pm[e]) * w0[2 * e + 1] + bfhi(pc[e]) * w1[2 * e + 1] + bfhi(pp[e]) * w2[2 * e + 1] + bb[2 * e + 1];
                o[e] = pk2(c0 * sigmoidf_(c0) * bflo(ln[e]), c1 * sigmoidf_(c1) * bfhi(ln[e])); }
            *(u32x4*)(Aout + ((size_t)(row0 + i) * DFF + cc) * 2) = o;
            pm = pc; pc = pp; ur += 5632 * 2;
        }
    }
}

__device__ __forceinline__ void phase_final(const Params& p, const Ctx& c) {
    const int wave = __builtin_amdgcn_readfirstlane(ltid() >> 6), lane = ltid() & 63;
    const int gw = blockIdx.x * 8 + wave, NW = gridDim.x * 8; const int ch0 = lane * 16;
    float nf[16]; load16f(p.in[5] + ch0, nf);
    const int To = c.T - NMETA, nrow = c.nseq * To;
    for (int q = gw; q < nrow; q += NW) {
        const int s = q / To, po = q - s * To; const size_t row = (size_t)s * c.T + NMETA + po;
        float h[16]; load16bf(slot(p, 0), row * 1024 + ch0, h);
        float ss = 0.f;
#pragma unroll
        for (int i = 0; i < 16; ++i) ss += h[i] * h[i];
        ss = wave_sum(ss); const float rs = rsqrtf(ss * (1.f / 1024.f) + 1e-6f);
        float* dst = c.y + (size_t)q * 1024 + ch0;
#pragma unroll
        for (int j = 0; j < 4; ++j) { f32x4 o; o[0] = h[4 * j] * rs * nf[4 * j]; o[1] = h[4 * j + 1] * rs * nf[4 * j + 1]; o[2] = h[4 * j + 2] * rs * nf[4 * j + 2]; o[3] = h[4 * j + 3] * rs * nf[4 * j + 3]; ((f32x4*)dst)[j] = o; }
    }
}


#define XB_TMO      128
#define XB_XCNT(j)  (256  + 64 * (j))
#define XB_XSUB(j)  (1280 + 64 * (j))
#define XB_XGEN(j)  (2304 + 64 * (j))
#define XB_TOP      3328
#define XB_TOPGEN   3392
#define XCD_BAR_WORDS 3456
#define XB_SPIN_CAP (1u << 18)
__device__ __forceinline__ unsigned xb_ld(unsigned* p)              { return __hip_atomic_load(p, __ATOMIC_RELAXED, __HIP_MEMORY_SCOPE_AGENT); }
__device__ __forceinline__ unsigned xb_add(unsigned* p, unsigned v) { return __hip_atomic_fetch_add(p, v, __ATOMIC_RELAXED, __HIP_MEMORY_SCOPE_AGENT); }
__device__ __forceinline__ unsigned xb_xcc_id() { return (unsigned)__builtin_amdgcn_s_getreg((3 << 11) | 20) & 0xFu; }
#define XB_SPIN(cond, bar) do { unsigned _sp = 0; while (cond) { __builtin_amdgcn_s_sleep(1); \
    if ((++_sp & 255u) == 0u) { if (xb_ld(&(bar)[XB_TMO])) break; if (_sp > XB_SPIN_CAP) { atomicAdd(&(bar)[XB_TMO], 1u); break; } } } } while (0)
struct XcdBarrier { unsigned* bar; unsigned x; volatile LAS unsigned* st; };
__device__ __forceinline__ XcdBarrier xcd_barrier_post(unsigned* bar, volatile LAS unsigned* st) {
    XcdBarrier b; b.bar = bar; b.x = xb_xcc_id(); b.st = st;
    if (threadIdx.x == 0) (void)xb_add(&bar[XB_XCNT(b.x)], 1u);
    return b;
}
__device__ __forceinline__ void xcd_barrier_complete(unsigned* bar, unsigned x, unsigned& nloc, unsigned& nx) {
    const unsigned G = gridDim.x * gridDim.y * gridDim.z;
    unsigned sum, cnt, mine, sp = 0u;
    for (;;) {
        sum = 0u; cnt = 0u; mine = 0u;
#pragma unroll
        for (unsigned j = 0; j < 16; ++j) { const unsigned c = xb_ld(&bar[XB_XCNT(j)]); sum += c; cnt += (c > 0u) ? 1u : 0u; mine = (j == x) ? c : mine; }
        if (sum == G) break;
        __builtin_amdgcn_s_sleep(1);
        if ((++sp & 255u) == 0u) { if (xb_ld(&bar[XB_TMO])) break; if (sp > XB_SPIN_CAP) { atomicAdd(&bar[XB_TMO], 1u); break; } }
    }
    nloc = mine > 0u ? mine : 1u; nx = cnt > 0u ? cnt : 1u;
}
__device__ __forceinline__ void xcd_barrier(const XcdBarrier& b) {
    asm volatile("s_waitcnt vmcnt(0)" ::: "memory");
    __syncthreads();
    if (threadIdx.x == 0) {
        unsigned* bar = b.bar;
        __builtin_amdgcn_s_waitcnt(0);
        unsigned nloc = b.st[0], nx = b.st[1];
        if (nloc == 0u) { xcd_barrier_complete(bar, b.x, nloc, nx); b.st[0] = nloc; b.st[1] = nx; }
        const unsigned old = xb_add(&bar[XB_XSUB(b.x)], 1u);
        const unsigned gen = old / nloc;
        if (old + 1u == (gen + 1u) * nloc) {
            __builtin_amdgcn_fence(__ATOMIC_RELEASE, "agent");
            asm volatile("s_waitcnt vmcnt(0)" ::: "memory");
            const unsigned og = xb_add(&bar[XB_TOP], 1u);
            const unsigned tg = og / nx;
            if (og + 1u == (tg + 1u) * nx) xb_add(&bar[XB_TOPGEN], 1u);
            else XB_SPIN(xb_ld(&bar[XB_TOPGEN]) == tg, bar);
            __builtin_amdgcn_fence(__ATOMIC_ACQUIRE, "agent");
            xb_add(&bar[XB_XGEN(b.x)], 1u);
            asm volatile("s_waitcnt vmcnt(0)" ::: "memory");
        } else {
            XB_SPIN(xb_ld(&bar[XB_XGEN(b.x)]) == gen, bar);
            __builtin_amdgcn_fence(__ATOMIC_ACQUIRE, "agent");
            asm volatile("s_waitcnt vmcnt(0)" ::: "memory");
        }
    }
    __syncthreads();
}

constexpr int NSUB = 20, NPHASE = 1 + 4 * NSUB;

__device__ __forceinline__ void phase_rstd(const Params& p, int which) {
    const float* part = (const float*)(p.ws + O_SS) + (size_t)which * 16 * RP; float* rs = (float*)(p.ws + O_RSTD) + (size_t)which * RP;
    for (int r = blockIdx.x * 512 + ltid(); r < RP; r += gridDim.x * 512) rs[r] = rstd16(part, r);
}

__device__ __forceinline__ void phase_fold(const Params& p, const Ctx& c) {
    const int tid = ltid(); const int wave = __builtin_amdgcn_readfirstlane(tid >> 6), lane = tid & 63;
    const int gw = blockIdx.x * 8 + wave, NW = gridDim.x * 8; const int ch0 = lane * 16;
    const float* part = (const float*)(p.ws + O_SS) + (size_t)16 * RP;
    const int nrow = c.nseq * c.Tp, Th = c.T / 2;
    for (int q = gw; q < nrow; q += NW) {
        const int s = q / c.Tp, tf = q - s * c.Tp; float oc[16], os[16];
        if (tf > Th) {
#pragma unroll
            for (int i = 0; i < 16; ++i) { oc[i] = 0.f; os[i] = 0.f; }
        } else {
            const int r1 = s * c.T + tf; float a[16]; load16bf(slot(p, 0), (size_t)r1 * 1024 + ch0, a); const float rs1 = rsqrtf(wave_sum(lane < 16 ? part[(size_t)lane * RP + r1] : 0.f) * (1.f / 1024.f) + 1e-6f);
            if (tf == 0 || tf == Th) {
#pragma unroll
                for (int i = 0; i < 16; ++i) { oc[i] = a[i] * rs1; os[i] = 0.f; }
            } else {
                const int r2 = s * c.T + (c.T - tf); float b[16]; load16bf(slot(p, 0), (size_t)r2 * 1024 + ch0, b); const float rs2 = rsqrtf(wave_sum(lane < 16 ? part[(size_t)lane * RP + r2] : 0.f) * (1.f / 1024.f) + 1e-6f);
#pragma unroll
                for (int i = 0; i < 16; ++i) { const float x = a[i] * rs1, y = b[i] * rs2; oc[i] = x + y; os[i] = x - y; }
            }
        }
        store16bf(slot(p, 5), (size_t)q * 1024 + ch0, oc); store16bf(slot(p, 6), (size_t)q * 1024 + ch0, os);
    }
}

__device__ __forceinline__ void run_phase(LAS unsigned char* lds, const Params& p, int ph) {
    if (ph == 0) { prep_phase(lds, p); return; }
    const int g = (ph - 1) / NSUB, sp = (ph - 1) % NSUB; const Ctx c = get_ctx(p, g);
    GemmPh P; P.G = gridDim.x; P.c = blockIdx.x; P.A = nullptr; P.B = nullptr; P.O = nullptr; P.ss = nullptr; P.ssin = nullptr; P.ldo = 0; P.kind = -1;
    float* ssb = (float*)(p.ws + O_SS); const float* rsb = (const float*)(p.ws + O_RSTD);
    switch (sp) {
    case 1: P.kind = K_L1; P.nunits = MT * 15; P.lda = 1024; P.ldb = 1024; P.K = 1024; break;
    case 2: P.kind = K_L2; P.nunits = MT * 20; P.lda = 256; P.ldb = 256; P.K = 256; break;
    case 6: P.kind = K_RES; P.nunits = MT * 4; P.lda = 1024; P.ldb = 1024; P.K = 1024; P.A = (const char*)slot(p, 1); P.B = (const char*)p.ws + O_WO; P.O = slot(p, 0); P.ss = ssb; break;
    case 8: case 16: { const int l = sp == 8 ? 0 : 1; P.kind = K_U; P.nunits = MT * 22; P.lda = 1024; P.ldb = 1024; P.K = 1024; P.A = (const char*)slot(p, 0); P.B = (const char*)p.ws + O_WIN + (size_t)l * 5632 * 1024 * 2;
        P.O = slot(p, 1); P.ssin = rsb + (l ? 2 * RP : 0); } break;
    case 10: case 18: { const int l = sp == 10 ? 0 : 1; P.kind = K_RES; P.nunits = MT * 4; P.lda = DFF; P.ldb = DFF; P.K = DFF; P.A = (const char*)slot(p, 7); P.B = (const char*)p.ws + O_WOUT + (size_t)l * 1024 * DFF * 2;
        P.O = slot(p, 0); P.ss = l ? nullptr : ssb + 16 * RP; } break;
    case 12: P.kind = K_CH; P.nunits = (c.nseq * c.Tp / 256) * 8; P.lda = 1024; P.ldb = 1024; P.K = 256; P.A = (const char*)p.ws + O_CHD; P.B = (const char*)slot(p, 5); P.O = slot(p, 1); break;
    case 13: P.kind = K_TD; P.nunits = c.nseq * c.tm * 4; P.lda = 2 * c.Tp; P.ldb = 2 * c.Tp; P.K = 2 * c.Tp; P.A = (const char*)p.ws + (g < 2 ? O_DFTP : O_DFTS); P.B = (const char*)slot(p, 1); P.O = slot(p, 4); break;
    case 14: P.kind = K_RES; P.nunits = MT * 4; P.lda = 1024; P.ldb = 1024; P.K = 1024; P.A = (const char*)slot(p, 4); P.B = (const char*)p.ws + O_WF; P.O = slot(p, 0); P.ss = ssb + 2 * 16 * RP; break;
    default: break;
    }
    if (P.kind >= 0) {
        switch (P.kind) {
        case K_L1: gemm_phase<K_L1>(lds, P, p, c); break;
        case K_L2: gemm_phase<K_L2>(lds, P, p, c); break;
        case K_RES: gemm_phase<K_RES>(lds, P, p, c); break;
        case K_U: gemm_phase<K_U>(lds, P, p, c); break;
        case K_CH: gemm_phase<K_CH>(lds, P, p, c); break;
        default: gemm_phase<K_TD>(lds, P, p, c); break;
        }
        if (sp == 13) {
            const int tid = ltid(); const int wave = __builtin_amdgcn_readfirstlane(tid >> 6), lane = tid & 63; const int K2 = 2 * c.Tp;
            const bf16_t* drow = (const bf16_t*)P.A + (size_t)(NMETA - 1) * K2; const bf16_t* yT = (const bf16_t*)slot(p, 1); bf16_t* F = (bf16_t*)slot(p, 4);
            for (int it = blockIdx.x * 8 + wave; it < c.nseq * 1024; it += gridDim.x * 8) {
                const int s = it >> 10, ch = it & 1023; const bf16_t* yr = yT + ((size_t)s * 1024 + ch) * K2; float acc = 0.f;
                for (int kk = lane * 2; kk < K2; kk += 128) { const unsigned a = *(const unsigned*)(drow + kk), b = *(const unsigned*)(yr + kk); acc += bflo(a) * bflo(b) + bfhi(a) * bfhi(b); }
                acc = wave_sum(acc);
                if (lane == 0) F[((size_t)s * c.T + (NMETA - 1)) * 1024 + ch] = (bf16_t)(pk2(acc, 0.f) & 0xffffu);
            }
        }
        return;
    }
    if (sp == 0) phase_mix(p, c);
    else if (sp == 3) phase_prescan(p, c);
    else if (sp == 4) phase_scan(lds, p, c);
    else if (sp == 5) phase_postscan(p, c);
    else if (sp == 11) phase_fold(p, c);
    else if (sp == 7 || sp == 15) phase_rstd(p, sp == 7 ? 0 : 2);
    else if (sp == 9 || sp == 17) phase_glu(p, c, sp == 9 ? 0 : 1);
    else phase_final(p, c);
}

__global__ void __launch_bounds__(512, 2) mega(Params p, int ph_lo, int ph_hi) {
    extern __shared__ __attribute__((aligned(16))) unsigned char shm[];
    LAS unsigned char* lds = (LAS unsigned char*)shm;
    cg::grid_group grid = cg::this_grid();
    volatile LAS unsigned* st = (volatile LAS unsigned*)(lds + STAGE_BYTES);
    if (threadIdx.x == 0) { st[0] = 0u; st[1] = 0u; }
    __syncthreads();
    const XcdBarrier xb = xcd_barrier_post((unsigned*)(p.ws + O_BAR), st);
    for (int ph = ph_lo; ph < ph_hi; ++ph) {
        if (ph_hi < 0) grid.sync();
        if (ph > ph_lo) xcd_barrier(xb);
        run_phase(lds, p, ph);
    }
}

extern "C" void kernel_launch(void* const* d_in, const int* in_sizes, int n_in, void* d_out, int out_size, void* d_ws, size_t ws_size, hipStream_t stream) {
    static int grid = 0;
    if (grid == 0) {
        if (n_in != 27 || ws_size < WS_END) { fprintf(stderr, "kernel_launch: need 27 inputs and %zu B of workspace (got %d, %zu)\n", (size_t)WS_END, n_in, ws_size); grid = -1; return; }
        int dev = 0, cus = 0, per_cu = 0;
        hipGetDevice(&dev); hipDeviceGetAttribute(&cus, hipDeviceAttributeMultiprocessorCount, dev);
        if (hipFuncSetAttribute((const void*)mega, hipFuncAttributeMaxDynamicSharedMemorySize, STAGE_BYTES + 16) != hipSuccess) { fprintf(stderr, "hipFuncSetAttribute failed\n"); grid = -1; return; }
        hipOccupancyMaxActiveBlocksPerMultiprocessor(&per_cu, (const void*)mega, 512, STAGE_BYTES + 16);
        if (per_cu < 1) per_cu = 1;
        (void)hipGetLastError();
        grid = cus * 1;
    }
    if (grid < 0) return;
    Params p{};
    for (int i = 0; i < 27; ++i) p.in[i] = (const float*)d_in[i];
    p.out = (float*)d_out; p.ws = (unsigned char*)d_ws;
#if MK_PER_PHASE
    for (int ph = 0; ph < NPHASE; ++ph) hipLaunchKernelGGL(mega, dim3(grid), dim3(512), STAGE_BYTES + 16, stream, p, ph, ph + 1);
#else
    (void)hipMemsetAsync((unsigned char*)d_ws + O_BAR, 0, 16384, stream);
    int lo = 0, hi = NPHASE;
    void* args[] = {&p, &lo, &hi};
    hipError_t e = hipLaunchCooperativeKernel((const void*)mega, dim3(grid), dim3(512), args, STAGE_BYTES + 16, stream);
    if (e != hipSuccess) fprintf(stderr, "cooperative launch failed: %s (grid %d)\n", hipGetErrorString(e), grid);
#endif
}
```

```cpp
#include <hip/hip_runtime.h>
#include <hip/hip_cooperative_groups.h>
#include <cstdio>
namespace cg = cooperative_groups;

#ifndef MK_PER_PHASE
#define MK_PER_PHASE 0
#endif

#define LAS __attribute__((address_space(3)))
typedef unsigned short bf16_t;
typedef short bf16x8 __attribute__((ext_vector_type(8)));
typedef float f32x4 __attribute__((ext_vector_type(4)));
typedef unsigned u32x4 __attribute__((ext_vector_type(4)));
typedef unsigned u32x2 __attribute__((ext_vector_type(2)));
typedef float f32x2 __attribute__((ext_vector_type(2)));
typedef const __attribute__((address_space(4))) unsigned* cptr;

constexpr int D = 1024, DFF = 2816, NMETA = 16;
constexpr int RP = 33024;
constexpr int MT = RP / 256;
constexpr size_t SLOT = (size_t)RP * D * 2;
constexpr int NSLOT = 13;
constexpr size_t O_WRKV = NSLOT * SLOT;
constexpr size_t O_G1 = O_WRKV + (size_t)3072 * 1024 * 2;
constexpr size_t O_W1 = O_G1 + (size_t)256 * 1024 * 2;
constexpr size_t O_A1 = O_W1 + (size_t)256 * 1024 * 2;
constexpr size_t O_L2 = O_A1 + (size_t)256 * 1024 * 2;
constexpr size_t O_G2 = O_L2 + (size_t)4096 * 256 * 2;
constexpr size_t O_WO = O_G2 + (size_t)1024 * 256 * 2;
constexpr size_t O_WF = O_WO + (size_t)1024 * 1024 * 2;
constexpr size_t O_WIN = O_WF + (size_t)1024 * 1024 * 2;
constexpr size_t O_WOUT = O_WIN + (size_t)2 * 5632 * 1024 * 2;
constexpr size_t O_CHD = O_WOUT + (size_t)2 * 1024 * 2816 * 2;
constexpr int TP_P = 1088, TP_S = 2112, MP_P = 2304, MP_S = 4352;
constexpr size_t O_DFTP = O_CHD + (size_t)2048 * 1024 * 2;
constexpr size_t O_DFTS = O_DFTP + (size_t)MP_P * 2 * TP_P * 2;
constexpr size_t O_SS = O_DFTS + (size_t)MP_S * 2 * TP_S * 2;
constexpr size_t O_RSTD = O_SS + (size_t)3 * 16 * RP * 4;
constexpr size_t O_BONUS = O_RSTD + (size_t)3 * RP * 4;
constexpr size_t O_BAR = O_BONUS + (size_t)RP * 16 * 4;
constexpr size_t WS_END = O_BAR + 16384;

struct Params { const float* in[27]; float* out; unsigned char* ws; };
struct Ctx { int g, T, nseq, R, Tp, tm; const float* x; float* y; };

__device__ __forceinline__ Ctx get_ctx(const Params& p, int g) {
    Ctx c; c.g = g;
    if (g < 2) { c.T = 2064; c.nseq = 16; c.Tp = TP_P; c.tm = 8; c.x = p.in[0] + (size_t)g * 16 * 2048 * 1024; c.y = p.out + (size_t)g * 16 * 2048 * 1024; }
    else { c.T = 4112; c.nseq = 8; c.Tp = TP_S; c.tm = 16; c.x = p.in[1] + (size_t)(g - 2) * 8 * 4096 * 1024; c.y = p.out + (size_t)32 * 2048 * 1024 + (size_t)(g - 2) * 8 * 4096 * 1024; }
    c.R = c.nseq * c.T; return c;
}
__device__ __forceinline__ int ltid() { int t = threadIdx.x; asm volatile("" : "+v"(t)); return t; }
__device__ __forceinline__ unsigned char* slot(const Params& p, int i) { return p.ws + (size_t)i * SLOT; }

__device__ __forceinline__ unsigned pk2(float lo, float hi) { unsigned r; asm volatile("v_cvt_pk_bf16_f32 %0, %1, %2" : "=v"(r) : "v"(lo), "v"(hi)); return r; }
__device__ __forceinline__ float bflo(unsigned u) { return __uint_as_float(u << 16); }
__device__ __forceinline__ float bfhi(unsigned u) { return __uint_as_float(u & 0xffff0000u); }
__device__ __forceinline__ float wave_sum(float v) {
#pragma unroll
    for (int o = 1; o < 64; o <<= 1) v += __shfl_xor(v, o);
    return v;
}
__device__ __forceinline__ float sigmoidf_(float x) { return __builtin_amdgcn_rcpf(1.f + __expf(-x)); }
__device__ __forceinline__ void unpack16(const u32x4 a, const u32x4 b, float (&v)[16]) {
#pragma unroll
    for (int i = 0; i < 4; ++i) { v[2 * i] = bflo(a[i]); v[2 * i + 1] = bfhi(a[i]); v[8 + 2 * i] = bflo(b[i]); v[8 + 2 * i + 1] = bfhi(b[i]); }
}
__device__ __forceinline__ void load16bf(const unsigned char* base, size_t elem, float (&v)[16]) {
    const u32x4* q = (const u32x4*)(base + elem * 2); unpack16(q[0], q[1], v);
}
__device__ __forceinline__ void store16bf(unsigned char* base, size_t elem, const float (&v)[16]) {
    u32x4 a, b;
#pragma unroll
    for (int i = 0; i < 4; ++i) { a[i] = pk2(v[2 * i], v[2 * i + 1]); b[i] = pk2(v[8 + 2 * i], v[8 + 2 * i + 1]); }
    u32x4* q = (u32x4*)(base + elem * 2); q[0] = a; q[1] = b;
}
__device__ __forceinline__ void load16f(const float* src, float (&v)[16]) {
#pragma unroll
    for (int j = 0; j < 4; ++j) { f32x4 t = ((const f32x4*)src)[j]; v[4 * j] = t[0]; v[4 * j + 1] = t[1]; v[4 * j + 2] = t[2]; v[4 * j + 3] = t[3]; }
}

constexpr int BM = 256, BK = 64, HALF = 128, HTB = HALF * BK * 2, STAGE_BYTES = 8 * HTB;
__device__ __forceinline__ int lds_byte(int r, int c) { const int st = (r >> 4) * 2 + (c >> 5), rr = r & 15, cc = c & 31, ob = rr * 64 + cc * 2; return st * 1024 + (ob ^ (((ob >> 9) & 1) << 5)); }
__device__ __forceinline__ void stage_rc(int b, int& R, int& C) { const int st = b / 1024, sb = b % 1024, swz = sb ^ (((sb >> 9) & 1) << 5); R = (st >> 1) * 16 + swz / 64; C = (st & 1) * 32 + (swz % 64) / 2; }
__device__ __forceinline__ int perm32(int rho) { const int n = rho >> 4, i = rho & 15; return 8 * (i >> 2) + 4 * n + (i & 3); }

enum { K_L1 = 0, K_L2, K_RES, K_U, K_CH, K_TD };
struct Unit { const char* A; const char* B; int pm, pn, job, s; };
struct GemmPh {
    int kind, nunits, lda, ldb, K, G, c;
    const char* A; const char* B;
    unsigned char* O; float* ss; const float* ssin; int ldo;
};

__device__ __forceinline__ void xcd_order(int L, int nM, int nN, int& pm, int& pn) {
    const int nwg = nM * nN; int wgid = L; { const int q = nwg / 8, r = nwg % 8, xcd = wgid % 8, off = wgid / 8; wgid = (xcd < r ? xcd * (q + 1) : r * (q + 1) + (xcd - r) * q) + off; }
    const int nig = 8 * nN, gid = wgid / nig, fm = gid * 8, gsz = (nM - fm) < 8 ? (nM - fm) : 8;
    pm = fm + ((wgid % nig) % gsz); pn = (wgid % nig) / gsz;
}
__device__ __forceinline__ bool next_unit(const GemmPh& P, const Params& p, const Ctx& cx, int i, Unit& u) {
    const long Lg = (long)i * P.G + P.c; if (Lg >= P.nunits) return false;
    const int L = (int)Lg; u.s = 0; u.job = 0;
    if (P.kind == K_L1) {
        int pm, jn; xcd_order(L, MT, 15, pm, jn); int job, pn;
        if (jn < 12) { job = jn >> 2; pn = jn & 3; } else { job = 3 + (jn - 12); pn = 0; }
        const int aslot = job == 0 ? 1 : job == 1 ? 3 : job == 2 ? 4 : job == 3 ? 6 : job == 4 ? 2 : 5;
        u.A = (const char*)slot(p, aslot) + (size_t)pm * 256 * 2048;
        const size_t boff = job < 3 ? O_WRKV + ((size_t)job * 1024 + pn * 256) * 2048 : job == 3 ? O_G1 : job == 4 ? O_W1 : O_A1;
        u.B = (const char*)p.ws + boff; u.pm = pm; u.pn = pn; u.job = job;
    } else if (P.kind == K_L2) {
        int pm, jn; xcd_order(L, MT, 20, pm, jn); const int job = jn < 16 ? 0 : 1, pn = jn < 16 ? jn : jn - 16;
        u.A = (const char*)slot(p, 10) + (job == 0 ? (size_t)RP * 512 : 0) + (size_t)pm * 256 * 512;
        u.B = (const char*)p.ws + (job == 0 ? O_L2 : O_G2) + (size_t)pn * 256 * 512; u.pm = pm; u.pn = pn; u.job = job;
    } else if (P.kind == K_RES) {
        int pm, pn; xcd_order(L, MT, 4, pm, pn);
        u.A = P.A + (size_t)pm * 256 * P.lda * 2; u.B = P.B + (size_t)pn * 256 * P.ldb * 2; u.pm = pm; u.pn = pn;
    } else if (P.kind == K_U) {
        int pm, pn; xcd_order(L, MT, 22, pm, pn);
        u.A = P.A + (size_t)pm * 256 * 2048; u.B = P.B + (size_t)pn * 256 * 2048; u.pm = pm; u.pn = pn;
    } else if (P.kind == K_CH) {
        int pn, pm; xcd_order(L, P.nunits >> 3, 8, pn, pm);
        u.A = P.A + (size_t)pm * 256 * 2048 + (pm & 3) * 512; u.B = (const char*)slot(p, pm < 4 ? 5 : 6) + (size_t)pn * 256 * 2048 + (pm & 3) * 512; u.pm = pm; u.pn = pn;
    } else {
        int rt, pn; xcd_order(L, cx.nseq * cx.tm, 4, rt, pn); const int s = rt / cx.tm, pm = rt % cx.tm;
        u.A = P.A + (size_t)(NMETA + pm * 256) * P.lda * 2; u.B = P.B + ((size_t)s * 1024 + pn * 256) * P.ldb * 2; u.pm = pm; u.pn = pn; u.s = s;
    }
    return true;
}

__device__ __forceinline__ void st8(unsigned char* ptr, const f32x4 a, const f32x4 b) {
    u32x4 o; o[0] = pk2(a[0], a[1]); o[1] = pk2(a[2], a[3]); o[2] = pk2(b[0], b[1]); o[3] = pk2(b[2], b[3]); *(u32x4*)ptr = o;
}
__device__ __forceinline__ float decaymap(float w) {
    const float e = 0.6065306597f * __builtin_amdgcn_rcpf(1.f + __expf(-w)); return __expf(-e) - 1.f;
}
__device__ __forceinline__ float act_apply(int act, float x) {
    if (act == 1) return __builtin_amdgcn_rcpf(1.f + __expf(-x));
    if (act == 2) return 1.f - 2.f * __builtin_amdgcn_rcpf(__expf(2.f * x) + 1.f);
    if (act == 3) return decaymap(x);
    return x;
}

__device__ __forceinline__ float rstd16(const float* ss, int r) {
    float s = 0.f;
#pragma unroll
    for (int i = 0; i < 16; ++i) s += ss[(size_t)i * RP + r];
    return rsqrtf(s * (1.f / 1024.f) + 1e-6f);
}
__device__ __forceinline__ void epilogue(const GemmPh& P, const Params& p, const Ctx& cx, const f32x4 (&acc)[2][2][4][2], const Unit& u, int wr, int wc, int fr, int fq) {
    const int rbase = u.pm * 256 + wr * 64 + fr, cbase = u.pn * 256 + wc * 32 + 8 * fq;
    if (P.kind == K_L1 || P.kind == K_L2) {
        unsigned char* O; int ldo = 1024, coff = 0, act = 0, cvalid = 1 << 30; const float* bias = nullptr;
        if (P.kind == K_L1) {
            if (u.job < 3) { O = slot(p, 7 + u.job); }
            else if (u.job == 3) { O = slot(p, 10); ldo = 256; act = 1; }
            else if (u.job == 4) { O = slot(p, 10) + (size_t)RP * 512; ldo = 256; act = 2; cvalid = 128; }
            else { O = slot(p, 10) + (size_t)RP * 512; ldo = 256; coff = 128; cvalid = 128; }
        } else {
            if (u.job == 1) { O = slot(p, 5); }
            else { const int cb = u.pn >> 2; O = slot(p, 1 + cb); bias = (cb < 2 ? p.in[8] : p.in[11]) + (cb & 1) * 1024 - cb * 1024; coff = -cb * 1024; act = cb < 2 ? 3 : 1; }
        }
        f32x4 bv[2][2];
#pragma unroll
        for (int bj = 0; bj < 2; ++bj)
#pragma unroll
            for (int n = 0; n < 2; ++n) bv[bj][n] = bias ? *(const f32x4*)(bias + cbase + bj * 128 + 4 * n) : (f32x4){0.f, 0.f, 0.f, 0.f};
#pragma unroll
        for (int ai = 0; ai < 2; ++ai)
#pragma unroll
            for (int m = 0; m < 4; ++m) { if ((m & 1) == 0) __builtin_amdgcn_sched_barrier(0);
#pragma unroll
                for (int bj = 0; bj < 2; ++bj) { const int r = rbase + ai * 128 + m * 16; const int c0 = cbase + bj * 128;
                    f32x4 v0 = acc[ai][bj][m][0] + bv[bj][0], v1 = acc[ai][bj][m][1] + bv[bj][1];
#pragma unroll
                    for (int i = 0; i < 4; ++i) { v0[i] = act_apply(act, v0[i]); v1[i] = act_apply(act, v1[i]); }
                    if (c0 < cvalid) st8(O + ((size_t)r * ldo + coff + c0) * 2, v0, v1); } }
    } else if (P.kind == K_RES) {
        unsigned char* H = P.O;
#pragma unroll
        for (int ai = 0; ai < 2; ++ai)
#pragma unroll
            for (int m = 0; m < 4; ++m) { if ((m & 1) == 0) __builtin_amdgcn_sched_barrier(0); const int r = rbase + ai * 128 + m * 16; float sq = 0.f;
#pragma unroll
                for (int bj = 0; bj < 2; ++bj) { unsigned char* ptr = H + ((size_t)r * 1024 + cbase + bj * 128) * 2;
                    const u32x4 old = *(const u32x4*)ptr; u32x4 o; const f32x4 a0 = acc[ai][bj][m][0], a1 = acc[ai][bj][m][1];
                    o[0] = pk2(bflo(old[0]) + a0[0], bfhi(old[0]) + a0[1]); o[1] = pk2(bflo(old[1]) + a0[2], bfhi(old[1]) + a0[3]);
                    o[2] = pk2(bflo(old[2]) + a1[0], bfhi(old[2]) + a1[1]); o[3] = pk2(bflo(old[3]) + a1[2], bfhi(old[3]) + a1[3]);
#pragma unroll
                    for (int i = 0; i < 4; ++i) { const float rl = bflo(o[i]), rh = bfhi(o[i]); sq += rl * rl + rh * rh; }
                    *(u32x4*)ptr = o; }
                if (P.ss) { sq += __shfl_xor(sq, 16); sq += __shfl_xor(sq, 32); if (fq == 0) P.ss[(size_t)(u.pn * 4 + wc) * RP + r] = sq; } }
    } else if (P.kind == K_U) {
#pragma unroll
        for (int ai = 0; ai < 2; ++ai)
#pragma unroll
            for (int m = 0; m < 4; ++m) { if ((m & 1) == 0) __builtin_amdgcn_sched_barrier(0); const int r = rbase + ai * 128 + m * 16; const float rs = P.ssin[r];
#pragma unroll
                for (int bj = 0; bj < 2; ++bj) st8(P.O + ((size_t)r * 5632 + cbase + bj * 128) * 2, acc[ai][bj][m][0] * rs, acc[ai][bj][m][1] * rs); }
    } else if (P.kind == K_CH) {
#pragma unroll
        for (int bj = 0; bj < 2; ++bj) { const int n0 = cbase + bj * 128; const int s = n0 / cx.Tp, t = n0 - s * cx.Tp;
#pragma unroll
            for (int ai = 0; ai < 2; ++ai)
#pragma unroll
                for (int m = 0; m < 4; ++m) { if ((m & 1) == 0) __builtin_amdgcn_sched_barrier(0); const int rr = rbase + ai * 128 + m * 16; const int cs = rr >> 10, ch = rr & 1023;
                    st8(P.O + ((((size_t)s * 1024 + ch) * 2 + cs) * cx.Tp + t) * 2, acc[ai][bj][m][0], acc[ai][bj][m][1]); } }
    } else {
#pragma unroll
        for (int ai = 0; ai < 2; ++ai)
#pragma unroll
            for (int m = 0; m < 4; ++m) { if ((m & 1) == 0) __builtin_amdgcn_sched_barrier(0); const int k = NMETA + rbase + ai * 128 + m * 16; const size_t row = (size_t)u.s * cx.T + k;
#pragma unroll
                for (int bj = 0; bj < 2; ++bj) if (k < cx.T) st8(P.O + (row * 1024 + cbase + bj * 128) * 2, acc[ai][bj][m][0], acc[ai][bj][m][1]); }
    }
}

template <int KIND> __device__ __forceinline__ void gemm_phase(LAS unsigned char* lds, GemmPh P, const Params& p, const Ctx& cx) {
    P.kind = KIND;
    const int tid = ltid(), wid = __builtin_amdgcn_readfirstlane(tid >> 6), lane = tid & 63, wr = wid >> 2, wc = wid & 3, fr = lane & 15, fq = lane >> 4;
    const int nt = P.K / BK;
    unsigned voffA[2], voffB[2];
#pragma unroll
    for (int i = 0; i < 2; ++i) { int R, C; stage_rc(tid * 16 + i * 8192, R, C); const int Rb = (R & ~31) + perm32(R & 31);
        voffA[i] = (unsigned)(R * P.lda + C) * 2u; voffB[i] = (unsigned)(Rb * P.ldb + C) * 2u; }
    const size_t kstep = (size_t)(BK * 2);
    const size_t hstepA = (size_t)HALF * P.lda * 2, hstepB = (size_t)HALF * P.ldb * 2;
    const unsigned ldsw = (unsigned)wid * 1024u;
    const int aoff = lds_byte(wr * 64 + fr, fq * 8), boff = lds_byte(wc * 32 + fr, fq * 8);
#define PG8_SA(b, h) (((b) * 2 + (h)) * HTB)
#define PG8_SB(b, h) ((4 + (b) * 2 + (h)) * HTB)
#define PG8_STAGE(bufoff, gbase, voff) do { _Pragma("unroll") for (int _i = 0; _i < 2; ++_i) \
        __builtin_amdgcn_global_load_lds((const unsigned*)((const char*)(gbase) + (voff)[_i]), (LAS unsigned*)(lds + (bufoff) + ldsw + _i * 8192), 16, 0, 0); } while (0)
#define PG8_LDA(dst, b, h) do { _Pragma("unroll") for (int m = 0; m < 4; ++m) _Pragma("unroll") for (int k = 0; k < 2; ++k) dst[m][k] = *(const LAS bf16x8*)(lds + PG8_SA(b, h) + aoff + m * 2048 + k * 1024); } while (0)
#define PG8_LDB(dst, b, h) do { _Pragma("unroll") for (int n = 0; n < 2; ++n) _Pragma("unroll") for (int k = 0; k < 2; ++k) dst[n][k] = *(const LAS bf16x8*)(lds + PG8_SB(b, h) + boff + n * 2048 + k * 1024); } while (0)
#define PG8_MMA(ai, bj, At, Bt) do { __builtin_amdgcn_s_setprio(1); _Pragma("unroll") for (int m = 0; m < 4; ++m) _Pragma("unroll") for (int n = 0; n < 2; ++n) _Pragma("unroll") for (int k = 0; k < 2; ++k) \
        acc[ai][bj][m][n] = __builtin_amdgcn_mfma_f32_16x16x32_bf16(Bt[n][k], At[m][k], acc[ai][bj][m][n], 0, 0, 0); __builtin_amdgcn_s_setprio(0); } while (0)
#define PG8_WAIT_V(n) asm volatile("s_waitcnt vmcnt(" #n ")" ::: "memory")
#define PG8_WAIT_L(n) asm volatile("s_waitcnt lgkmcnt(" #n ")" ::: "memory")
#define PG8_BAR __builtin_amdgcn_s_barrier()
#define PG8_SCHED __builtin_amdgcn_sched_barrier(0)
    Unit cur, nxt; int ui = 0;
    if (!next_unit(P, p, cx, 0, cur)) return;
    f32x4 acc[2][2][4][2];
#pragma unroll
    for (int a = 0; a < 2; ++a)
#pragma unroll
        for (int b = 0; b < 2; ++b)
#pragma unroll
            for (int m = 0; m < 4; ++m)
#pragma unroll
                for (int n = 0; n < 2; ++n) acc[a][b][m][n] = (f32x4){0.f, 0.f, 0.f, 0.f};
    bf16x8 At[4][2], B0[2][2], B1[2][2];
    const char* cA = cur.A; const char* cB = cur.B;
    PG8_STAGE(PG8_SB(0, 0), cB, voffB); PG8_STAGE(PG8_SA(0, 0), cA, voffA); PG8_STAGE(PG8_SB(0, 1), cB + hstepB, voffB); PG8_STAGE(PG8_SA(0, 1), cA + hstepA, voffA);
    if (wr == 1) PG8_BAR;
    PG8_WAIT_V(4); PG8_BAR;
    PG8_STAGE(PG8_SB(1, 0), cB + kstep, voffB); PG8_STAGE(PG8_SA(1, 0), cA + kstep, voffA); PG8_STAGE(PG8_SB(1, 1), cB + hstepB + kstep, voffB);
    PG8_WAIT_V(6); PG8_BAR;
    for (;;) {
        const bool has_next = next_unit(P, p, cx, ui + 1, nxt);
        const char* nA = has_next ? nxt.A : cA; const char* nB = has_next ? nxt.B : cB;
        for (int t = 0; t < nt; t += 2) {
            const bool last = (t == nt - 2);
            const char* a1 = cA + (size_t)(t + 1) * kstep;
            const char* a2 = last ? nA : cA + (size_t)(t + 2) * kstep; const char* b2 = last ? nB : cB + (size_t)(t + 2) * kstep;
            const char* a3 = a2 + kstep; const char* b3 = b2 + kstep;
            PG8_LDB(B0, 0, 0); PG8_SCHED; PG8_LDA(At, 0, 0); PG8_STAGE(PG8_SA(1, 1), a1 + hstepA, voffA);
            PG8_WAIT_L(8); PG8_BAR; PG8_WAIT_L(0); PG8_MMA(0, 0, At, B0); PG8_BAR; PG8_SCHED;
            PG8_LDB(B1, 0, 1); PG8_STAGE(PG8_SB(0, 0), b2, voffB);
            PG8_BAR; PG8_WAIT_L(0); PG8_MMA(0, 1, At, B1); PG8_BAR;
            PG8_LDA(At, 0, 1); PG8_STAGE(PG8_SA(0, 0), a2, voffA);
            PG8_BAR; PG8_WAIT_L(0); PG8_MMA(1, 0, At, B0); PG8_BAR; PG8_SCHED;
            PG8_STAGE(PG8_SB(0, 1), b2 + hstepB, voffB);
            PG8_WAIT_V(6); PG8_BAR; PG8_MMA(1, 1, At, B1); PG8_BAR;
            PG8_LDB(B0, 1, 0); PG8_SCHED; PG8_LDA(At, 1, 0); PG8_STAGE(PG8_SA(0, 1), a2 + hstepA, voffA);
            PG8_WAIT_L(8); PG8_BAR; PG8_WAIT_L(0); PG8_MMA(0, 0, At, B0); PG8_BAR; PG8_SCHED;
            PG8_LDB(B1, 1, 1); PG8_STAGE(PG8_SB(1, 0), b3, voffB);
            PG8_BAR; PG8_WAIT_L(0); PG8_MMA(0, 1, At, B1); PG8_BAR;
            PG8_LDA(At, 1, 1); PG8_STAGE(PG8_SA(1, 0), a3, voffA);
            PG8_BAR; PG8_WAIT_L(0); PG8_MMA(1, 0, At, B0); PG8_BAR; PG8_SCHED;
            PG8_STAGE(PG8_SB(1, 1), b3 + hstepB, voffB);
            PG8_WAIT_V(6); PG8_BAR; PG8_MMA(1, 1, At, B1); PG8_BAR;
        }
        epilogue(P, p, cx, acc, cur, wr, wc, fr, fq);
        if (!has_next) break;
#pragma unroll
        for (int a = 0; a < 2; ++a)
#pragma unroll
            for (int b = 0; b < 2; ++b)
#pragma unroll
                for (int m = 0; m < 4; ++m)
#pragma unroll
                    for (int n = 0; n < 2; ++n) acc[a][b][m][n] = (f32x4){0.f, 0.f, 0.f, 0.f};
        cur = nxt; cA = nA; cB = nB; ++ui;
    }
    PG8_WAIT_V(0);
    if (wr == 0) PG8_BAR;
    PG8_BAR;
#undef PG8_SA
#undef PG8_SB
#undef PG8_STAGE
#undef PG8_LDA
#undef PG8_LDB
#undef PG8_MMA
#undef PG8_WAIT_V
#undef PG8_WAIT_L
#undef PG8_BAR
#undef PG8_SCHED
}

__device__ __forceinline__ void tr_job(LAS float* tile, const float* src, int K, int N, unsigned char* dst, int ldk, int koff, int Kpad, int Npad, const float* scale, int& cnt, int stride_start, int G) {
    const int tk = Kpad / 64, tn = Npad / 64, ntile = tk * tn; const int tid = ltid();
    for (int it = 0; it < ntile; ++it, ++cnt) {
        if ((cnt % G) != stride_start) continue;
        const int k0 = (it / tn) * 64, n0 = (it % tn) * 64;
        __syncthreads();
        { const int tx = tid & 63, ty = tid >> 6;
#pragma unroll
            for (int i = 0; i < 8; ++i) { const int kd = k0 + ty + 8 * i, ks = kd - koff, n = n0 + tx; float v = 0.f;
                if (ks >= 0 && ks < K && n < N) { v = src[(size_t)ks * N + n]; if (scale) v *= scale[ks]; }
                tile[(ty + 8 * i) * 65 + tx] = v; } }
        __syncthreads();
        { const int n = tid >> 3, kc = (tid & 7) * 8; u32x4 o;
#pragma unroll
            for (int i = 0; i < 4; ++i) o[i] = pk2(tile[(kc + 2 * i) * 65 + n], tile[(kc + 2 * i + 1) * 65 + n]);
            *(u32x4*)(dst + ((size_t)(n0 + n) * ldk + k0 + kc) * 2) = o; }
    }
}

__device__ __forceinline__ void prep_phase(LAS unsigned char* lds, const Params& p) {
    LAS float* tile = (LAS float*)lds; unsigned char* ws = p.ws; int cnt = 0; const int b = blockIdx.x, G = gridDim.x;
    for (int i = 0; i < 3; ++i) tr_job(tile, p.in[7] + (size_t)i * D * D, D, D, ws + O_WRKV + (size_t)i * D * D * 2, 1024, 0, 1024, 1024, nullptr, cnt, b, G);
    tr_job(tile, p.in[14], D, 160, ws + O_G1, 1024, 0, 1024, 256, nullptr, cnt, b, G);
    tr_job(tile, p.in[9], D, 64, ws + O_W1, 1024, 0, 1024, 64, nullptr, cnt, b, G);
    tr_job(tile, p.in[9] + D * 64, D, 64, ws + O_W1 + (size_t)64 * 1024 * 2, 1024, 0, 1024, 192, nullptr, cnt, b, G);
    tr_job(tile, p.in[12], D, 64, ws + O_A1, 1024, 0, 1024, 64, nullptr, cnt, b, G);
    tr_job(tile, p.in[12] + D * 64, D, 64, ws + O_A1 + (size_t)64 * 1024 * 2, 1024, 0, 1024, 192, nullptr, cnt, b, G);
    for (int z = 0; z < 2; ++z) {
        tr_job(tile, p.in[10] + (size_t)z * 64 * D, 64, D, ws + O_L2 + (size_t)z * 1024 * 256 * 2, 256, z * 64, 256, 1024, nullptr, cnt, b, G);
        tr_job(tile, p.in[13] + (size_t)z * 64 * D, 64, D, ws + O_L2 + (size_t)(2 + z) * 1024 * 256 * 2, 256, (2 + z) * 64, 256, 1024, nullptr, cnt, b, G);
    }
    tr_job(tile, p.in[15], 160, D, ws + O_G2, 256, 0, 256, 1024, nullptr, cnt, b, G);
    tr_job(tile, p.in[21], D, D, ws + O_WO, 1024, 0, 1024, 1024, nullptr, cnt, b, G);
    tr_job(tile, p.in[22], D, D, ws + O_WF, 1024, 0, 1024, 1024, nullptr, cnt, b, G);
    for (int l = 0; l < 2; ++l) {
        tr_job(tile, p.in[23] + (size_t)l * D * 5632, D, 5632, ws + O_WIN + (size_t)l * 5632 * 1024 * 2, 1024, 0, 1024, 5632, p.in[4] + l * D, cnt, b, G);
        tr_job(tile, p.in[26] + (size_t)l * DFF * D, DFF, D, ws + O_WOUT + (size_t)l * 1024 * DFF * 2, DFF, 0, DFF, 1024, nullptr, cnt, b, G);
    }
    const size_t gt = (size_t)blockIdx.x * 512 + ltid(), NT = (size_t)gridDim.x * 512;
    const float* nm1 = p.in[3] + D;
    for (size_t e = gt; e < (size_t)2048 * 128; e += NT) {
        const int rr = (int)(e >> 7), c0 = (int)(e & 127) * 8; const int cs = rr >> 10, ch = rr & 1023; float v[8];
#pragma unroll
        for (int i = 0; i < 8; ++i) { const int c = c0 + i; float val = 0.f;
            if ((c >> 7) == (ch >> 7)) { const int m = ((ch & 127) * (c & 127)) & 127; float sn, cn; sincospif((float)m * (1.f / 64.f), &sn, &cn); val = (cs ? sn : cn) * nm1[c] * 0.08838834764831845f; }
            v[i] = val; }
        u32x4 o; o[0] = pk2(v[0], v[1]); o[1] = pk2(v[2], v[3]); o[2] = pk2(v[4], v[5]); o[3] = pk2(v[6], v[7]);
        *(u32x4*)(ws + O_CHD + e * 16) = o;
    }
    for (int ty = 0; ty < 2; ++ty) {
        const int T = ty ? 4112 : 2064, Tp = ty ? TP_S : TP_P, Mp = ty ? MP_S : MP_P; const int rowv = 2 * Tp / 8;
        unsigned char* dst = ws + (ty ? O_DFTS : O_DFTP); const float isq = rsqrtf((float)T), invT = 2.f / (float)T;
        for (size_t e = gt; e < (size_t)Mp * rowv; e += NT) {
            const int k = (int)(e / rowv), kk0 = (int)(e % rowv) * 8; float v[8];
#pragma unroll
            for (int i = 0; i < 8; ++i) { const int kk = kk0 + i; const int issin = kk >= Tp, t = issin ? kk - Tp : kk; float val = 0.f;
                if (k < T && (issin ? (t >= 1 && t <= T / 2 - 1) : (t <= T / 2))) { const int m = (int)(((long)k * t) % T); float sn, cn; sincospif((float)m * invT, &sn, &cn); val = (issin ? -sn : cn) * isq; }
                v[i] = val; }
            u32x4 o; o[0] = pk2(v[0], v[1]); o[1] = pk2(v[2], v[3]); o[2] = pk2(v[4], v[5]); o[3] = pk2(v[6], v[7]);
            *(u32x4*)(dst + e * 16) = o;
        }
    }
}

__device__ __forceinline__ void ea_load_row(const Params& p, const Ctx& c, int s, int pos, int lane, float (&v)[16]) {
    if (pos < 0 || pos >= c.T) {
#pragma unroll
        for (int i = 0; i < 16; ++i) v[i] = 0.f;
        return; }
    const float* src = pos < NMETA ? p.in[2] + (size_t)pos * D : c.x + ((size_t)s * (c.T - NMETA) + (pos - NMETA)) * D;
#pragma unroll
    for (int j = 0; j < 4; ++j) { const f32x4 t = *(const f32x4*)(src + j * 256 + lane * 4); v[4 * j] = t[0]; v[4 * j + 1] = t[1]; v[4 * j + 2] = t[2]; v[4 * j + 3] = t[3]; }
}
__device__ __forceinline__ void ea_store_row(unsigned char* base, size_t row, int lane, const float (&v)[16]) {
#pragma unroll
    for (int j = 0; j < 4; ++j) { u32x2 o; o[0] = pk2(v[4 * j], v[4 * j + 1]); o[1] = pk2(v[4 * j + 2], v[4 * j + 3]); *(u32x2*)(base + (row * 1024 + j * 256 + lane * 4) * 2) = o; }
}
__device__ __forceinline__ void ea_norm(float (&v)[16], const float (&nw)[16]) {
    float ss = 0.f;
#pragma unroll
    for (int i = 0; i < 16; ++i) ss += v[i] * v[i];
    ss = wave_sum(ss); const float rs = rsqrtf(ss * (1.f / 1024.f) + 1e-6f);
#pragma unroll
    for (int i = 0; i < 16; ++i) v[i] = v[i] * rs * nw[i];
}
__device__ __forceinline__ void phase_mix(const Params& p, const Ctx& c) {
    const int wave = __builtin_amdgcn_readfirstlane(ltid() >> 6), lane = ltid() & 63;
    const int gw = blockIdx.x * 8 + wave, NW = gridDim.x * 8;
    float nw[16];
#pragma unroll
    for (int j = 0; j < 4; ++j) { const f32x4 t = *(const f32x4*)(p.in[3] + j * 256 + lane * 4); nw[4 * j] = t[0]; nw[4 * j + 1] = t[1]; nw[4 * j + 2] = t[2]; nw[4 * j + 3] = t[3]; }
    const int nstrips = c.R / 16, spq = c.T / 16;
    for (int st = gw; st < nstrips; st += NW) {
        const int s = st / spq, pos0 = (st - s * spq) * 16; const size_t row0 = (size_t)st * 16;
        float prev[16], cur[16], nx[16];
        ea_load_row(p, c, s, pos0 - 1, lane, prev); ea_norm(prev, nw);
        ea_load_row(p, c, s, pos0, lane, cur); ea_store_row(slot(p, 0), row0, lane, cur); ea_norm(cur, nw);
        for (int i = 0; i < 16; ++i) {
            ea_load_row(p, c, s, pos0 + i + 1, lane, nx);
            if (i < 15) ea_store_row(slot(p, 0), row0 + i + 1, lane, nx);
            ea_norm(nx, nw);
            float xx[16], o[16];
#pragma unroll
            for (int e = 0; e < 16; ++e) xx[e] = 0.5f * (prev[e] + nx[e]) - cur[e];
            for (int m = 0; m < 6; ++m) {
#pragma unroll
                for (int j = 0; j < 4; ++j) { const f32x4 t = *(const f32x4*)(p.in[6] + m * D + j * 256 + lane * 4);
#pragma unroll
                    for (int e = 0; e < 4; ++e) o[4 * j + e] = cur[4 * j + e] + xx[4 * j + e] * t[e]; }
                ea_store_row(slot(p, 1 + m), row0 + i, lane, o); }
#pragma unroll
            for (int e = 0; e < 16; ++e) { prev[e] = cur[e]; cur[e] = nx[e]; }
        }
    }
}

__device__ __forceinline__ void phase_prescan(const Params& p, const Ctx& c) {
    const int wave = __builtin_amdgcn_readfirstlane(ltid() >> 6), lane = ltid() & 63;
    const int gw = blockIdx.x * 8 + wave, NW = gridDim.x * 8; const int ch0 = lane * 16;
    float kkw[16], kaw[16], rkw[16];
    load16f(p.in[16] + ch0, kkw); load16f(p.in[17] + ch0, kaw); load16f(p.in[18] + ch0, rkw);
    float* bonus = (float*)(p.ws + O_BONUS);
    for (int row = gw; row < c.R; row += NW) {
        const size_t e = (size_t)row * 1024 + ch0;
        float k[16], a0[16], a1[16], r[16];
        load16bf(slot(p, 8), e, k); load16bf(slot(p, 3), e, a0); load16bf(slot(p, 4), e, a1); load16bf(slot(p, 7), e, r);
        float kk[16], n2 = 0.f;
#pragma unroll
        for (int i = 0; i < 16; ++i) { kk[i] = k[i] * kkw[i]; n2 += kk[i] * kk[i]; }
        n2 += __shfl_xor(n2, 1); n2 += __shfl_xor(n2, 2);
        const float inv = 1.f / fmaxf(sqrtf(n2), 1e-12f);
        float kd0[16], kd1[16], bon = 0.f;
#pragma unroll
        for (int i = 0; i < 16; ++i) { kk[i] *= inv; kd0[i] = k[i] * (1.f + (a0[i] - 1.f) * kaw[i]); kd1[i] = k[i] * (1.f + (a1[i] - 1.f) * kaw[i]);
            bon += r[i] * (kd0[i] + kd1[i]) * rkw[i]; a0[i] *= kk[i]; a1[i] *= kk[i]; }
        bon += __shfl_xor(bon, 1); bon += __shfl_xor(bon, 2);
        if ((lane & 3) == 0) bonus[(size_t)row * 16 + (lane >> 2)] = bon;
        store16bf(slot(p, 8), e, kk); store16bf(slot(p, 3), e, a0); store16bf(slot(p, 4), e, a1);
        store16bf(slot(p, 6), e, kd0); store16bf(slot(p, 10), e, kd1);
    }
}

__device__ __forceinline__ float half_sum(float x) {
    const unsigned a = __float_as_uint(x); auto r = __builtin_amdgcn_permlane32_swap(a, a, false, false);
    return __uint_as_float(r[0]) + __uint_as_float(r[1]);
}
__device__ __forceinline__ float ldbf(const unsigned char* base, int idx) { return __uint_as_float(((unsigned)((const bf16_t*)base)[idx]) << 16); }
__device__ __forceinline__ float quarter_sum(float x) {
    const unsigned a = __float_as_uint(x); auto r = __builtin_amdgcn_permlane16_swap(a, a, false, false);
    return half_sum(__uint_as_float(r[0]) + __uint_as_float(r[1]));
}
template <int RPL, int JP, int RING>
__device__ __forceinline__ void scan_items(LAS unsigned char* lds, const Params& p, const Ctx& c) {
    constexpr int LR = 64 / JP, NJ = 64 / JP, ROWS = LR * RPL, WPS = 64 / ROWS, NQ = NJ / 4, BQ = RPL == 2 ? 1 : 2, NB = NQ / BQ;
    const int tid = ltid(); const int wave = __builtin_amdgcn_readfirstlane(tid >> 6), lane = tid & 63;
    const int nitem = c.nseq * 32 * WPS; const int lr = lane % LR, jp = lane / LR;
    LAS float* wb = (LAS float*)(lds + wave * 16384);
    LAS float* oring = wb + 1024;
    for (int w = blockIdx.x + gridDim.x * wave; w < nitem; w += gridDim.x * 8) {
        const int q = w / WPS, rq = w % WPS; const int dir = q & 1, hh = (q >> 1) & 15, s = q >> 5;
        const size_t e0 = (size_t)s * c.T * 1024 + hh * 64;
        const unsigned char* Rb = slot(p, 7) + e0 * 2; const unsigned char* Kkb = slot(p, 8) + e0 * 2; const unsigned char* Vb = slot(p, 9) + e0 * 2;
        const unsigned char* Ngb = slot(p, 1 + dir) + e0 * 2; const unsigned char* Bdb = slot(p, 3 + dir) + e0 * 2;
        const unsigned char* Kdb = slot(p, dir ? 10 : 6) + e0 * 2; unsigned char* Ob = slot(p, 11 + dir) + e0 * 2;
        const int vec = lane >> 3, chunk = lane & 7;
        const unsigned char* lb = (vec == 0 ? Kkb : vec == 1 ? Ngb : vec == 2 ? Bdb : vec == 3 ? Kdb : vec == 4 ? Rb : Vb) + chunk * 16;
        const int vrow0 = rq * ROWS + lr;
        const int step = dir ? -2048 : 2048; const long ro0 = dir ? (long)(c.T - 1) * 2048 : 0;
        f32x2 S2[RPL][NJ / 2];
#pragma unroll
        for (int a_ = 0; a_ < RPL; ++a_)
#pragma unroll
            for (int j = 0; j < NJ / 2; ++j) S2[a_][j] = (f32x2){0.f, 0.f};
        u32x4 xr[RING];
#define SCAN_LD(dst, tt) do { const int _t = (tt) < c.T ? (tt) : c.T - 1; const long _r = ro0 + (long)_t * step; dst = *(const u32x4*)(lb + _r); } while (0)
#define SCAN_PARK(x, buf) do { if (vec < 6) { f32x4 _lo, _hi; _lo[0] = bflo(x[0]); _lo[1] = bfhi(x[0]); _lo[2] = bflo(x[1]); _lo[3] = bfhi(x[1]); _hi[0] = bflo(x[2]); _hi[1] = bfhi(x[2]); _hi[2] = bflo(x[3]); _hi[3] = bfhi(x[3]); \
            LAS f32x4* _d = (LAS f32x4*)((buf) + vec * 64 + chunk * 8); _d[0] = _lo; _d[1] = _hi; } } while (0)
#define SCAN_RD4(dst, base, jj) do { _Pragma("unroll") for (int _h = 0; _h < BQ; ++_h) { dst[4 * _h] = ((const LAS f32x4*)((base) + 64))[(jj) + _h]; dst[4 * _h + 1] = ((const LAS f32x4*)((base) + 128))[(jj) + _h]; \
            dst[4 * _h + 2] = ((const LAS f32x4*)((base) + 192))[(jj) + _h]; dst[4 * _h + 3] = ((const LAS f32x4*)((base) + 256))[(jj) + _h]; } } while (0)
        float vi[RPL];
        { u32x4 x; SCAN_LD(x, 0); SCAN_PARK(x, wb); }
#pragma unroll
        for (int k = 1; k < RING; ++k) SCAN_LD(xr[k], k);
        SCAN_LD(xr[0], RING);
        f32x4 kq[NQ];
#pragma unroll
        for (int j = 0; j < NQ; ++j) kq[j] = ((const LAS f32x4*)(wb + jp * NJ))[j];
#pragma unroll
        for (int a_ = 0; a_ < RPL; ++a_) vi[a_] = wb[320 + vrow0 + a_ * LR];
        int fstart = 0;
        for (int tb = 0; tb < c.T; tb += RING) {
#pragma unroll
            for (int k = 0; k < RING; ++k) {
                const int t = tb + k;
                const LAS float* sb = wb + (k & 1) * 512 + jp * NJ; LAS float* sn = wb + ((k + 1) & 1) * 512;
                f32x4 PQ[2][4 * BQ];
                SCAN_RD4(PQ[0], sb, 0);
                __builtin_amdgcn_sched_barrier(0);
                float sa[RPL];
#pragma unroll
                for (int a_ = 0; a_ < RPL; ++a_) { f32x2 a0 = (f32x2){0.f, 0.f}, a1 = (f32x2){0.f, 0.f};
#pragma unroll
                    for (int j = 0; j < NQ; ++j) { a0 = __builtin_elementwise_fma(S2[a_][2 * j], (f32x2){kq[j][0], kq[j][1]}, a0); a1 = __builtin_elementwise_fma(S2[a_][2 * j + 1], (f32x2){kq[j][2], kq[j][3]}, a1); }
                    sa[a_] = (a0[0] + a0[1]) + (a1[0] + a1[1]); }
                u32x4& xs = xr[(k + 1) % RING];
                SCAN_PARK(xs, sn);
                float vcur[RPL];
#pragma unroll
                for (int a_ = 0; a_ < RPL; ++a_) vcur[a_] = vi[a_];
                SCAN_LD(xs, t + 1 + RING);
                f32x2 sa2[RPL], v2[RPL], oa0[RPL], oa1[RPL];
#pragma unroll
                for (int a_ = 0; a_ < RPL; ++a_) { const float sr = -(JP == 2 ? half_sum(sa[a_]) : quarter_sum(sa[a_])); sa2[a_] = (f32x2){sr, sr}; v2[a_] = (f32x2){vcur[a_], vcur[a_]};
                    oa0[a_] = (f32x2){0.f, 0.f}; oa1[a_] = (f32x2){0.f, 0.f}; }
#pragma unroll
                for (int b_ = 0; b_ < NB; ++b_) {
                    if (b_ + 1 < NB) { SCAN_RD4(PQ[(b_ + 1) & 1], sb, BQ * (b_ + 1)); }
                    else {
#pragma unroll
                        for (int j = 0; j < NQ; ++j) kq[j] = ((const LAS f32x4*)(sn + jp * NJ))[j];
#pragma unroll
                        for (int a_ = 0; a_ < RPL; ++a_) vi[a_] = sn[320 + vrow0 + a_ * LR];
                    }
                    __builtin_amdgcn_sched_barrier(0);
#pragma unroll
                    for (int h_ = 0; h_ < BQ; ++h_) { const f32x4 g4 = PQ[b_ & 1][4 * h_], b4 = PQ[b_ & 1][4 * h_ + 1], d4 = PQ[b_ & 1][4 * h_ + 2], r4 = PQ[b_ & 1][4 * h_ + 3]; const int j_ = 2 * (BQ * b_ + h_);
#pragma unroll
                        for (int a_ = 0; a_ < RPL; ++a_) { f32x2 s0 = S2[a_][j_], s1 = S2[a_][j_ + 1];
                            s0 = __builtin_elementwise_fma(s0, (f32x2){g4[0], g4[1]}, s0); s1 = __builtin_elementwise_fma(s1, (f32x2){g4[2], g4[3]}, s1);
                            s0 = __builtin_elementwise_fma(sa2[a_], (f32x2){b4[0], b4[1]}, s0); s1 = __builtin_elementwise_fma(sa2[a_], (f32x2){b4[2], b4[3]}, s1);
                            s0 = __builtin_elementwise_fma(v2[a_], (f32x2){d4[0], d4[1]}, s0); s1 = __builtin_elementwise_fma(v2[a_], (f32x2){d4[2], d4[3]}, s1);
                            S2[a_][j_] = s0; S2[a_][j_ + 1] = s1;
                            oa0[a_] = __builtin_elementwise_fma(s0, (f32x2){r4[0], r4[1]}, oa0[a_]); oa1[a_] = __builtin_elementwise_fma(s1, (f32x2){r4[2], r4[3]}, oa1[a_]); } }
                    __builtin_amdgcn_sched_barrier(0);
                }
#pragma unroll
                for (int a_ = 0; a_ < RPL; ++a_) { const float os_ = (oa0[a_][0] + oa0[a_][1]) + (oa1[a_][0] + oa1[a_][1]); const float ov = JP == 2 ? half_sum(os_) : quarter_sum(os_);
                    if (jp == 0) oring[(t & 63) * ROWS + a_ * LR + lr] = ov; }
            }
            const int tend = tb + RING, nfl = tend - fstart;
            if (nfl == 64 || tend >= c.T) {
                for (int idx = lane; idx < nfl * ROWS; idx += 64) { const int st = idx / ROWS, row = idx % ROWS;
                    ((bf16_t*)(Ob + ro0 + (long)(fstart + st) * step))[rq * ROWS + row] = (bf16_t)(pk2(oring[idx], 0.f) & 0xffffu); }
                fstart = tend;
            }
        }
#undef SCAN_LD
#undef SCAN_PARK
#undef SCAN_RD4
    }
}
__device__ __forceinline__ void phase_scan(LAS unsigned char* lds, const Params& p, const Ctx& c) {
    if (c.g < 2) scan_items<1, 2, 8>(lds, p, c); else scan_items<1, 4, 8>(lds, p, c);
}

__device__ __forceinline__ void phase_postscan(const Params& p, const Ctx& c) {
    const int wave = __builtin_amdgcn_readfirstlane(ltid() >> 6), lane = ltid() & 63;
    const int gw = blockIdx.x * 8 + wave, NW = gridDim.x * 8; const int ch0 = lane * 16;
    float gw_[16], gb_[16]; load16f(p.in[19] + ch0, gw_); load16f(p.in[20] + ch0, gb_);
    const float* bonus = (const float*)(p.ws + O_BONUS);
    for (int row = gw; row < c.R; row += NW) {
        const size_t e = (size_t)row * 1024 + ch0;
        float of[16], ob[16], v[16], g[16];
        load16bf(slot(p, 11), e, of); load16bf(slot(p, 12), e, ob); load16bf(slot(p, 9), e, v); load16bf(slot(p, 5), e, g);
        float sum = 0.f;
#pragma unroll
        for (int i = 0; i < 16; ++i) { of[i] += ob[i]; sum += of[i]; }
        sum += __shfl_xor(sum, 1); sum += __shfl_xor(sum, 2); const float mean = sum * (1.f / 64.f);
        float var = 0.f;
#pragma unroll
        for (int i = 0; i < 16; ++i) { of[i] -= mean; var += of[i] * of[i]; }
        var += __shfl_xor(var, 1); var += __shfl_xor(var, 2); const float rs = rsqrtf(var * (1.f / 64.f) + 64e-5f);
        const float bon = bonus[(size_t)row * 16 + (lane >> 2)];
#pragma unroll
        for (int i = 0; i < 16; ++i) of[i] = (of[i] * rs * gw_[i] + gb_[i] + bon * v[i]) * g[i];
        store16bf(slot(p, 1), e, of);
    }
}

__device__ __forceinline__ void phase_glu(const Params& p, const Ctx& c, int layer) {
    const size_t gt = (size_t)blockIdx.x * 512 + ltid(), NT = (size_t)gridDim.x * 512;
    const unsigned char* U = slot(p, 1); unsigned char* Aout = slot(p, 7);
    const float* cw = p.in[24] + (size_t)layer * 3 * DFF; const float* cb = p.in[25] + (size_t)layer * DFF;
    const size_t nitem = (size_t)(c.R / 16) * 352;
    for (size_t it = gt; it < nitem; it += NT) {
        const int strip = (int)(it / 352), cc = (int)(it % 352) * 8; const int row0 = strip * 16, pos0 = row0 % c.T;
        float w0[8], w1[8], w2[8], bb[8];
#pragma unroll
        for (int h = 0; h < 2; ++h) { const f32x4 a = *(const f32x4*)(cw + cc + 4 * h), b = *(const f32x4*)(cw + DFF + cc + 4 * h), d = *(const f32x4*)(cw + 2 * DFF + cc + 4 * h), e = *(const f32x4*)(cb + cc + 4 * h);
#pragma unroll
            for (int i = 0; i < 4; ++i) { w0[4 * h + i] = a[i]; w1[4 * h + i] = b[i]; w2[4 * h + i] = d[i]; bb[4 * h + i] = e[i]; } }
        const unsigned char* ur = U + (size_t)row0 * 5632 * 2 + cc * 2;
        const u32x4 z = (u32x4){0u, 0u, 0u, 0u};
        u32x4 pm = pos0 > 0 ? *(const u32x4*)(ur - 5632 * 2) : z, pc = *(const u32x4*)ur;
#pragma unroll 4
        for (int i = 0; i < 16; ++i) {
            const u32x4 pp = (pos0 + i < c.T - 1) ? *(const u32x4*)(ur + 5632 * 2) : z;
            const u32x4 ln = *(const u32x4*)(ur + DFF * 2);
            u32x4 o;
#pragma unroll
            for (int e = 0; e < 4; ++e) {
                const float c0 = bflo(pm[e]) * w0[2 * e] + bflo(pc[e]) * w1[2 * e] + bflo(pp[e]) * w2[2 * e] + bb[2 * e];
                const float c1 = bfhi(pm[e]) * w0[2 * e + 1] + bfhi(pc[e]) * w1[2 * e + 1] + bfhi(pp[e]) * w2[2 * e + 1] + bb[2 * e + 1];
                o[e] = pk2(c0 * sigmoidf_(c0) * bflo(ln[e]), c1 * sigmoidf_(c1) * bfhi(ln[e])); }
            *(u32x4*)(Aout + ((size_t)(row0 + i) * DFF + cc) * 2) = o;
            pm = pc; pc = pp; ur += 5632 * 2;
        }
    }
}

__device__ __forceinline__ void phase_final(const Params& p, const Ctx& c) {
    const int wave = __builtin_amdgcn_readfirstlane(ltid() >> 6), lane = ltid() & 63;
    const int gw = blockIdx.x * 8 + wave, NW = gridDim.x * 8; const int ch0 = lane * 16;
    float nf[16]; load16f(p.in[5] + ch0, nf);
    const int To = c.T - NMETA, nrow = c.nseq * To;
    for (int q = gw; q < nrow; q += NW) {
        const int s = q / To, po = q - s * To; const size_t row = (size_t)s * c.T + NMETA + po;
        float h[16]; load16bf(slot(p, 0), row * 1024 + ch0, h);
        float ss = 0.f;
#pragma unroll
        for (int i = 0; i < 16; ++i) ss += h[i] * h[i];
        ss = wave_sum(ss); const float rs = rsqrtf(ss * (1.f / 1024.f) + 1e-6f);
        float* dst = c.y + (size_t)q * 1024 + ch0;
#pragma unroll
        for (int j = 0; j < 4; ++j) { f32x4 o; o[0] = h[4 * j] * rs * nf[4 * j]; o[1] = h[4 * j + 1] * rs * nf[4 * j + 1]; o[2] = h[4 * j + 2] * rs * nf[4 * j + 2]; o[3] = h[4 * j + 3] * rs * nf[4 * j + 3]; ((f32x4*)dst)[j] = o; }
    }
}


#define XB_TMO      128
#define XB_XCNT(j)  (256  + 64 * (j))
#define XB_XSUB(j)  (1280 + 64 * (j))
#define XB_XGEN(j)  (2304 + 64 * (j))
#define XB_TOP      3328
#define XB_TOPGEN   3392
#define XCD_BAR_WORDS 3456
#define XB_SPIN_CAP (1u << 18)
__device__ __forceinline__ unsigned xb_ld(unsigned* p)              { return __hip_atomic_load(p, __ATOMIC_RELAXED, __HIP_MEMORY_SCOPE_AGENT); }
__device__ __forceinline__ unsigned xb_add(unsigned* p, unsigned v) { return __hip_atomic_fetch_add(p, v, __ATOMIC_RELAXED, __HIP_MEMORY_SCOPE_AGENT); }
__device__ __forceinline__ unsigned xb_xcc_id() { return (unsigned)__builtin_amdgcn_s_getreg((3 << 11) | 20) & 0xFu; }
#define XB_SPIN(cond, bar) do { unsigned _sp = 0; while (cond) { __builtin_amdgcn_s_sleep(1); \
    if ((++_sp & 255u) == 0u) { if (xb_ld(&(bar)[XB_TMO])) break; if (_sp > XB_SPIN_CAP) { atomicAdd(&(bar)[XB_TMO], 1u); break; } } } } while (0)
struct XcdBarrier { unsigned* bar; unsigned x; volatile LAS unsigned* st; };
__device__ __forceinline__ XcdBarrier xcd_barrier_post(unsigned* bar, volatile LAS unsigned* st) {
    XcdBarrier b; b.bar = bar; b.x = xb_xcc_id(); b.st = st;
    if (threadIdx.x == 0) (void)xb_add(&bar[XB_XCNT(b.x)], 1u);
    return b;
}
__device__ __forceinline__ void xcd_barrier_complete(unsigned* bar, unsigned x, unsigned& nloc, unsigned& nx) {
    const unsigned G = gridDim.x * gridDim.y * gridDim.z;
    unsigned sum, cnt, mine, sp = 0u;
    for (;;) {
        sum = 0u; cnt = 0u; mine = 0u;
#pragma unroll
        for (unsigned j = 0; j < 16; ++j) { const unsigned c = xb_ld(&bar[XB_XCNT(j)]); sum += c; cnt += (c > 0u) ? 1u : 0u; mine = (j == x) ? c : mine; }
        if (sum == G) break;
        __builtin_amdgcn_s_sleep(1);
        if ((++sp & 255u) == 0u) { if (xb_ld(&bar[XB_TMO])) break; if (sp > XB_SPIN_CAP) { atomicAdd(&bar[XB_TMO], 1u); break; } }
    }
    nloc = mine > 0u ? mine : 1u; nx = cnt > 0u ? cnt : 1u;
}
__device__ __forceinline__ void xcd_barrier(const XcdBarrier& b) {
    asm volatile("s_waitcnt vmcnt(0)" ::: "memory");
    __syncthreads();
    if (threadIdx.x == 0) {
        unsigned* bar = b.bar;
        __builtin_amdgcn_s_waitcnt(0);
        unsigned nloc = b.st[0], nx = b.st[1];
        if (nloc == 0u) { xcd_barrier_complete(bar, b.x, nloc, nx); b.st[0] = nloc; b.st[1] = nx; }
        const unsigned old = xb_add(&bar[XB_XSUB(b.x)], 1u);
        const unsigned gen = old / nloc;
        if (old + 1u == (gen + 1u) * nloc) {
            __builtin_amdgcn_fence(__ATOMIC_RELEASE, "agent");
            asm volatile("s_waitcnt vmcnt(0)" ::: "memory");
            const unsigned og = xb_add(&bar[XB_TOP], 1u);
            const unsigned tg = og / nx;
            if (og + 1u == (tg + 1u) * nx) xb_add(&bar[XB_TOPGEN], 1u);
            else XB_SPIN(xb_ld(&bar[XB_TOPGEN]) == tg, bar);
            __builtin_amdgcn_fence(__ATOMIC_ACQUIRE, "agent");
            xb_add(&bar[XB_XGEN(b.x)], 1u);
            asm volatile("s_waitcnt vmcnt(0)" ::: "memory");
        } else {
            XB_SPIN(xb_ld(&bar[XB_XGEN(b.x)]) == gen, bar);
            __builtin_amdgcn_fence(__ATOMIC_ACQUIRE, "agent");
            asm volatile("s_waitcnt vmcnt(0)" ::: "memory");
        }
    }
    __syncthreads();
}

constexpr int NSUB = 20, NPHASE = 1 + 4 * NSUB;

__device__ __forceinline__ void phase_rstd(const Params& p, int which) {
    const float* part = (const float*)(p.ws + O_SS) + (size_t)which * 16 * RP; float* rs = (float*)(p.ws + O_RSTD) + (size_t)which * RP;
    for (int r = blockIdx.x * 512 + ltid(); r < RP; r += gridDim.x * 512) rs[r] = rstd16(part, r);
}

__device__ __forceinline__ void phase_fold(const Params& p, const Ctx& c) {
    const int tid = ltid(); const int wave = __builtin_amdgcn_readfirstlane(tid >> 6), lane = tid & 63;
    const int gw = blockIdx.x * 8 + wave, NW = gridDim.x * 8; const int ch0 = lane * 16;
    const float* part = (const float*)(p.ws + O_SS) + (size_t)16 * RP;
    const int nrow = c.nseq * c.Tp, Th = c.T / 2;
    for (int q = gw; q < nrow; q += NW) {
        const int s = q / c.Tp, tf = q - s * c.Tp; float oc[16], os[16];
        if (tf > Th) {
#pragma unroll
            for (int i = 0; i < 16; ++i) { oc[i] = 0.f; os[i] = 0.f; }
        } else {
            const int r1 = s * c.T + tf; float a[16]; load16bf(slot(p, 0), (size_t)r1 * 1024 + ch0, a); const float rs1 = rsqrtf(wave_sum(lane < 16 ? part[(size_t)lane * RP + r1] : 0.f) * (1.f / 1024.f) + 1e-6f);
            if (tf == 0 || tf == Th) {
#pragma unroll
                for (int i = 0; i < 16; ++i) { oc[i] = a[i] * rs1; os[i] = 0.f; }
            } else {
                const int r2 = s * c.T + (c.T - tf); float b[16]; load16bf(slot(p, 0), (size_t)r2 * 1024 + ch0, b); const float rs2 = rsqrtf(wave_sum(lane < 16 ? part[(size_t)lane * RP + r2] : 0.f) * (1.f / 1024.f) + 1e-6f);
#pragma unroll
                for (int i = 0; i < 16; ++i) { const float x = a[i] * rs1, y = b[i] * rs2; oc[i] = x + y; os[i] = x - y; }
            }
        }
        store16bf(slot(p, 5), (size_t)q * 1024 + ch0, oc); store16bf(slot(p, 6), (size_t)q * 1024 + ch0, os);
    }
}

__device__ __forceinline__ void run_phase(LAS unsigned char* lds, const Params& p, int ph) {
    if (ph == 0) { prep_phase(lds, p); return; }
    const int g = (ph - 1) / NSUB, sp = (ph - 1) % NSUB; const Ctx c = get_ctx(p, g);
    GemmPh P; P.G = gridDim.x; P.c = blockIdx.x; P.A = nullptr; P.B = nullptr; P.O = nullptr; P.ss = nullptr; P.ssin = nullptr; P.ldo = 0; P.kind = -1;
    float* ssb = (float*)(p.ws + O_SS); const float* rsb = (const float*)(p.ws + O_RSTD);
    switch (sp) {
    case 1: P.kind = K_L1; P.nunits = MT * 15; P.lda = 1024; P.ldb = 1024; P.K = 1024; break;
    case 2: P.kind = K_L2; P.nunits = MT * 20; P.lda = 256; P.ldb = 256; P.K = 256; break;
    case 6: P.kind = K_RES; P.nunits = MT * 4; P.lda = 1024; P.ldb = 1024; P.K = 1024; P.A = (const char*)slot(p, 1); P.B = (const char*)p.ws + O_WO; P.O = slot(p, 0); P.ss = ssb; break;
    case 8: case 16: { const int l = sp == 8 ? 0 : 1; P.kind = K_U; P.nunits = MT * 22; P.lda = 1024; P.ldb = 1024; P.K = 1024; P.A = (const char*)slot(p, 0); P.B = (const char*)p.ws + O_WIN + (size_t)l * 5632 * 1024 * 2;
        P.O = slot(p, 1); P.ssin = rsb + (l ? 2 * RP : 0); } break;
    case 10: case 18: { const int l = sp == 10 ? 0 : 1; P.kind = K_RES; P.nunits = MT * 4; P.lda = DFF; P.ldb = DFF; P.K = DFF; P.A = (const char*)slot(p, 7); P.B = (const char*)p.ws + O_WOUT + (size_t)l * 1024 * DFF * 2;
        P.O = slot(p, 0); P.ss = l ? nullptr : ssb + 16 * RP; } break;
    case 12: P.kind = K_CH; P.nunits = (c.nseq * c.Tp / 256) * 8; P.lda = 1024; P.ldb = 1024; P.K = 256; P.A = (const char*)p.ws + O_CHD; P.B = (const char*)slot(p, 5); P.O = slot(p, 1); break;
    case 13: P.kind = K_TD; P.nunits = c.nseq * c.tm * 4; P.lda = 2 * c.Tp; P.ldb = 2 * c.Tp; P.K = 2 * c.Tp; P.A = (const char*)p.ws + (g < 2 ? O_DFTP : O_DFTS); P.B = (const char*)slot(p, 1); P.O = slot(p, 4); break;
    case 14: P.kind = K_RES; P.nunits = MT * 4; P.lda = 1024; P.ldb = 1024; P.K = 1024; P.A = (const char*)slot(p, 4); P.B = (const char*)p.ws + O_WF; P.O = slot(p, 0); P.ss = ssb + 2 * 16 * RP; break;
    default: break;
    }
    if (P.kind >= 0) {
        switch (P.kind) {
        case K_L1: gemm_phase<K_L1>(lds, P, p, c); break;
        case K_L2: gemm_phase<K_L2>(lds, P, p, c); break;
        case K_RES: gemm_phase<K_RES>(lds, P, p, c); break;
        case K_U: gemm_phase<K_U>(lds, P, p, c); break;
        case K_CH: gemm_phase<K_CH>(lds, P, p, c); break;
        default: gemm_phase<K_TD>(lds, P, p, c); break;
        }
        if (sp == 13) {
            const int tid = ltid(); const int wave = __builtin_amdgcn_readfirstlane(tid >> 6), lane = tid & 63; const int K2 = 2 * c.Tp;
            const bf16_t* drow = (const bf16_t*)P.A + (size_t)(NMETA - 1) * K2; const bf16_t* yT = (const bf16_t*)slot(p, 1); bf16_t* F = (bf16_t*)slot(p, 4);
            for (int it = blockIdx.x * 8 + wave; it < c.nseq * 1024; it += gridDim.x * 8) {
                const int s = it >> 10, ch = it & 1023; const bf16_t* yr = yT + ((size_t)s * 1024 + ch) * K2; float acc = 0.f;
                for (int kk = lane * 2; kk < K2; kk += 128) { const unsigned a = *(const unsigned*)(drow + kk), b = *(const unsigned*)(yr + kk); acc += bflo(a) * bflo(b) + bfhi(a) * bfhi(b); }
                acc = wave_sum(acc);
                if (lane == 0) F[((size_t)s * c.T + (NMETA - 1)) * 1024 + ch] = (bf16_t)(pk2(acc, 0.f) & 0xffffu);
            }
        }
        return;
    }
    if (sp == 0) phase_mix(p, c);
    else if (sp == 3) phase_prescan(p, c);
    else if (sp == 4) phase_scan(lds, p, c);
    else if (sp == 5) phase_postscan(p, c);
    else if (sp == 11) phase_fold(p, c);
    else if (sp == 7 || sp == 15) phase_rstd(p, sp == 7 ? 0 : 2);
    else if (sp == 9 || sp == 17) phase_glu(p, c, sp == 9 ? 0 : 1);
    else phase_final(p, c);
}

__global__ void __launch_bounds__(512, 2) mega(Params p, int ph_lo, int ph_hi) {
    extern __shared__ __attribute__((aligned(16))) unsigned char shm[];
    LAS unsigned char* lds = (LAS unsigned char*)shm;
    cg::grid_group grid = cg::this_grid();
    volatile LAS unsigned* st = (volatile LAS unsigned*)(lds + STAGE_BYTES);
    if (threadIdx.x == 0) { st[0] = 0u; st[1] = 0u; }
    __syncthreads();
    const XcdBarrier xb = xcd_barrier_post((unsigned*)(p.ws + O_BAR), st);
    for (int ph = ph_lo; ph < ph_hi; ++ph) {
        if (ph_hi < 0) grid.sync();
        if (ph > ph_lo) xcd_barrier(xb);
        run_phase(lds, p, ph);
    }
}

extern "C" void kernel_launch(void* const* d_in, const int* in_sizes, int n_in, void* d_out, int out_size, void* d_ws, size_t ws_size, hipStream_t stream) {
    static int grid = 0;
    if (grid == 0) {
        if (n_in != 27 || ws_size < WS_END) { fprintf(stderr, "kernel_launch: need 27 inputs and %zu B of workspace (got %d, %zu)\n", (size_t)WS_END, n_in, ws_size); grid = -1; return; }
        int dev = 0, cus = 0, per_cu = 0;
        hipGetDevice(&dev); hipDeviceGetAttribute(&cus, hipDeviceAttributeMultiprocessorCount, dev);
        if (hipFuncSetAttribute((const void*)mega, hipFuncAttributeMaxDynamicSharedMemorySize, STAGE_BYTES + 16) != hipSuccess) { fprintf(stderr, "hipFuncSetAttribute failed\n"); grid = -1; return; }
        hipOccupancyMaxActiveBlocksPerMultiprocessor(&per_cu, (const void*)mega, 512, STAGE_BYTES + 16);
        if (per_cu < 1) per_cu = 1;
        (void)hipGetLastError();
        grid = cus * 1;
    }
    if (grid < 0) return;
    Params p{};
    for (int i = 0; i < 27; ++i) p.in[i] = (const float*)d_in[i];
    p.out = (float*)d_out; p.ws = (unsigned char*)d_ws;
#if MK_PER_PHASE
    for (int ph = 0; ph < NPHASE; ++ph) hipLaunchKernelGGL(mega, dim3(grid), dim3(512), STAGE_BYTES + 16, stream, p, ph, ph + 1);
#else
    (void)hipMemsetAsync((unsigned char*)d_ws + O_BAR, 0, 16384, stream);
    int lo = 0, hi = NPHASE;
    void* args[] = {&p, &lo, &hi};
    hipError_t e = hipLaunchCooperativeKernel((const void*)mega, dim3(grid), dim3(512), args, STAGE_BYTES + 16, stream);
    if (e != hipSuccess) fprintf(stderr, "cooperative launch failed: %s (grid %d)\n", hipGetErrorString(e), grid);
#endif
}
```

```cpp
#include <hip/hip_runtime.h>
#include <hip/hip_cooperative_groups.h>
#include <cstdio>
namespace cg = cooperative_groups;

#ifndef MK_PER_PHASE
#define MK_PER_PHASE 0
#endif

#define LAS __attribute__((address_space(3)))
typedef unsigned short bf16_t;
typedef short bf16x8 __attribute__((ext_vector_type(8)));
typedef float f32x4 __attribute__((ext_vector_type(4)));
typedef unsigned u32x4 __attribute__((ext_vector_type(4)));
typedef unsigned u32x2 __attribute__((ext_vector_type(2)));
typedef float f32x2 __attribute__((ext_vector_type(2)));
typedef const __attribute__((address_space(4))) unsigned* cptr;

constexpr int D = 1024, DFF = 2816, NMETA = 16;
constexpr int RP = 33024;
constexpr int MT = RP / 256;
constexpr size_t SLOT = (size_t)RP * D * 2;
constexpr int NSLOT = 13;
constexpr size_t O_WRKV = NSLOT * SLOT;
constexpr size_t O_G1 = O_WRKV + (size_t)3072 * 1024 * 2;
constexpr size_t O_W1 = O_G1 + (size_t)256 * 1024 * 2;
constexpr size_t O_A1 = O_W1 + (size_t)256 * 1024 * 2;
constexpr size_t O_L2 = O_A1 + (size_t)256 * 1024 * 2;
constexpr size_t O_G2 = O_L2 + (size_t)4096 * 256 * 2;
constexpr size_t O_WO = O_G2 + (size_t)1024 * 256 * 2;
constexpr size_t O_WF = O_WO + (size_t)1024 * 1024 * 2;
constexpr size_t O_WIN = O_WF + (size_t)1024 * 1024 * 2;
constexpr size_t O_WOUT = O_WIN + (size_t)2 * 5632 * 1024 * 2;
constexpr size_t O_CHD = O_WOUT + (size_t)2 * 1024 * 2816 * 2;
constexpr int TP_P = 1088, TP_S = 2112, MP_P = 2304, MP_S = 4352;
constexpr size_t O_DFTP = O_CHD + (size_t)2048 * 1024 * 2;
constexpr size_t O_DFTS = O_DFTP + (size_t)MP_P * 2 * TP_P * 2;
constexpr size_t O_SS = O_DFTS + (size_t)MP_S * 2 * TP_S * 2;
constexpr size_t O_RSTD = O_SS + (size_t)3 * 16 * RP * 4;
constexpr size_t O_BONUS = O_RSTD + (size_t)3 * RP * 4;
constexpr size_t O_BAR = O_BONUS + (size_t)RP * 16 * 4;
constexpr size_t WS_END = O_BAR + 16384;

struct Params { const float* in[27]; float* out; unsigned char* ws; };
struct Ctx { int g, T, nseq, R, Tp, tm; const float* x; float* y; };

__device__ __forceinline__ Ctx get_ctx(const Params& p, int g) {
    Ctx c; c.g = g;
    if (g < 2) { c.T = 2064; c.nseq = 16; c.Tp = TP_P; c.tm = 8; c.x = p.in[0] + (size_t)g * 16 * 2048 * 1024; c.y = p.out + (size_t)g * 16 * 2048 * 1024; }
    else { c.T = 4112; c.nseq = 8; c.Tp = TP_S; c.tm = 16; c.x = p.in[1] + (size_t)(g - 2) * 8 * 4096 * 1024; c.y = p.out + (size_t)32 * 2048 * 1024 + (size_t)(g - 2) * 8 * 4096 * 1024; }
    c.R = c.nseq * c.T; return c;
}
__device__ __forceinline__ int ltid() { int t = threadIdx.x; asm volatile("" : "+v"(t)); return t; }
__device__ __forceinline__ unsigned char* slot(const Params& p, int i) { return p.ws + (size_t)i * SLOT; }

__device__ __forceinline__ unsigned pk2(float lo, float hi) { unsigned r; asm volatile("v_cvt_pk_bf16_f32 %0, %1, %2" : "=v"(r) : "v"(lo), "v"(hi)); return r; }
__device__ __forceinline__ float bflo(unsigned u) { return __uint_as_float(u << 16); }
__device__ __forceinline__ float bfhi(unsigned u) { return __uint_as_float(u & 0xffff0000u); }
__device__ __forceinline__ float wave_sum(float v) {
#pragma unroll
    for (int o = 1; o < 64; o <<= 1) v += __shfl_xor(v, o);
    return v;
}
__device__ __forceinline__ float sigmoidf_(float x) { return __builtin_amdgcn_rcpf(1.f + __expf(-x)); }
__device__ __forceinline__ void unpack16(const u32x4 a, const u32x4 b, float (&v)[16]) {
#pragma unroll
    for (int i = 0; i < 4; ++i) { v[2 * i] = bflo(a[i]); v[2 * i + 1] = bfhi(a[i]); v[8 + 2 * i] = bflo(b[i]); v[8 + 2 * i + 1] = bfhi(b[i]); }
}
__device__ __forceinline__ void load16bf(const unsigned char* base, size_t elem, float (&v)[16]) {
    const u32x4* q = (const u32x4*)(base + elem * 2); unpack16(q[0], q[1], v);
}
__device__ __forceinline__ void store16bf(unsigned char* base, size_t elem, const float (&v)[16]) {
    u32x4 a, b;
#pragma unroll
    for (int i = 0; i < 4; ++i) { a[i] = pk2(v[2 * i], v[2 * i + 1]); b[i] = pk2(v[8 + 2 * i], v[8 + 2 * i + 1]); }
    u32x4* q = (u32x4*)(base + elem * 2); q[0] = a; q[1] = b;
}
__device__ __forceinline__ void load16f(const float* src, float (&v)[16]) {
#pragma unroll
    for (int j = 0; j < 4; ++j) { f32x4 t = ((const f32x4*)src)[j]; v[4 * j] = t[0]; v[4 * j + 1] = t[1]; v[4 * j + 2] = t[2]; v[4 * j + 3] = t[3]; }
}

constexpr int BM = 256, BK = 64, HALF = 128, HTB = HALF * BK * 2, STAGE_BYTES = 8 * HTB;
__device__ __forceinline__ int lds_byte(int r, int c) { const int st = (r >> 4) * 2 + (c >> 5), rr = r & 15, cc = c & 31, ob = rr * 64 + cc * 2; return st * 1024 + (ob ^ (((ob >> 9) & 1) << 5)); }
__device__ __forceinline__ void stage_rc(int b, int& R, int& C) { const int st = b / 1024, sb = b % 1024, swz = sb ^ (((sb >> 9) & 1) << 5); R = (st >> 1) * 16 + swz / 64; C = (st & 1) * 32 + (swz % 64) / 2; }
__device__ __forceinline__ int perm32(int rho) { const int n = rho >> 4, i = rho & 15; return 8 * (i >> 2) + 4 * n + (i & 3); }

enum { K_L1 = 0, K_L2, K_RES, K_U, K_CH, K_TD };
struct Unit { const char* A; const char* B; int pm, pn, job, s; };
struct GemmPh {
    int kind, nunits, lda, ldb, K, G, c;
    const char* A; const char* B;
    unsigned char* O; float* ss; const float* ssin; int ldo;
};

__device__ __forceinline__ void xcd_order(int L, int nM, int nN, int& pm, int& pn) {
    const int nwg = nM * nN; int wgid = L; { const int q = nwg / 8, r = nwg % 8, xcd = wgid % 8, off = wgid / 8; wgid = (xcd < r ? xcd * (q + 1) : r * (q + 1) + (xcd - r) * q) + off; }
    const int nig = 8 * nN, gid = wgid / nig, fm = gid * 8, gsz = (nM - fm) < 8 ? (nM - fm) : 8;
    pm = fm + ((wgid % nig) % gsz); pn = (wgid % nig) / gsz;
}
__device__ __forceinline__ bool next_unit(const GemmPh& P, const Params& p, const Ctx& cx, int i, Unit& u) {
    const long Lg = (long)i * P.G + P.c; if (Lg >= P.nunits) return false;
    const int L = (int)Lg; u.s = 0; u.job = 0;
    if (P.kind == K_L1) {
        int pm, jn; xcd_order(L, MT, 15, pm, jn); int job, pn;
        if (jn < 12) { job = jn >> 2; pn = jn & 3; } else { job = 3 + (jn - 12); pn = 0; }
        const int aslot = job == 0 ? 1 : job == 1 ? 3 : job == 2 ? 4 : job == 3 ? 6 : job == 4 ? 2 : 5;
        u.A = (const char*)slot(p, aslot) + (size_t)pm * 256 * 2048;
        const size_t boff = job < 3 ? O_WRKV + ((size_t)job * 1024 + pn * 256) * 2048 : job == 3 ? O_G1 : job == 4 ? O_W1 : O_A1;
        u.B = (const char*)p.ws + boff; u.pm = pm; u.pn = pn; u.job = job;
    } else if (P.kind == K_L2) {
        int pm, jn; xcd_order(L, MT, 20, pm, jn); const int job = jn < 16 ? 0 : 1, pn = jn < 16 ? jn : jn - 16;
        u.A = (const char*)slot(p, 10) + (job == 0 ? (size_t)RP * 512 : 0) + (size_t)pm * 256 * 512;
        u.B = (const char*)p.ws + (job == 0 ? O_L2 : O_G2) + (size_t)pn * 256 * 512; u.pm = pm; u.pn = pn; u.job = job;
    } else if (P.kind == K_RES) {
        int pm, pn; xcd_order(L, MT, 4, pm, pn);
        u.A = P.A + (size_t)pm * 256 * P.lda * 2; u.B = P.B + (size_t)pn * 256 * P.ldb * 2; u.pm = pm; u.pn = pn;
    } else if (P.kind == K_U) {
        int pm, pn; xcd_order(L, MT, 22, pm, pn);
        u.A = P.A + (size_t)pm * 256 * 2048; u.B = P.B + (size_t)pn * 256 * 2048; u.pm = pm; u.pn = pn;
    } else if (P.kind == K_CH) {
        int pn, pm; xcd_order(L, P.nunits >> 3, 8, pn, pm);
        u.A = P.A + (size_t)pm * 256 * 2048 + (pm & 3) * 512; u.B = (const char*)slot(p, pm < 4 ? 5 : 6) + (size_t)pn * 256 * 2048 + (pm & 3) * 512; u.pm = pm; u.pn = pn;
    } else {
        int rt, pn; xcd_order(L, cx.nseq * cx.tm, 4, rt, pn); const int s = rt / cx.tm, pm = rt % cx.tm;
        u.A = P.A + (size_t)(NMETA + pm * 256) * P.lda * 2; u.B = P.B + ((size_t)s * 1024 + pn * 256) * P.ldb * 2; u.pm = pm; u.pn = pn; u.s = s;
    }
    return true;
}

__device__ __forceinline__ void st8(unsigned char* ptr, const f32x4 a, const f32x4 b) {
    u32x4 o; o[0] = pk2(a[0], a[1]); o[1] = pk2(a[2], a[3]); o[2] = pk2(b[0], b[1]); o[3] = pk2(b[2], b[3]); *(u32x4*)ptr = o;
}
__device__ __forceinline__ float decaymap(float w) {
    const float e = 0.6065306597f * __builtin_amdgcn_rcpf(1.f + __expf(-w)); return __expf(-e) - 1.f;
}
__device__ __forceinline__ float act_apply(int act, float x) {
    if (act == 1) return __builtin_amdgcn_rcpf(1.f + __expf(-x));
    if (act == 2) return 1.f - 2.f * __builtin_amdgcn_rcpf(__expf(2.f * x) + 1.f);
    if (act == 3) return decaymap(x);
    return x;
}

__device__ __forceinline__ float rstd16(const float* ss, int r) {
    float s = 0.f;
#pragma unroll
    for (int i = 0; i < 16; ++i) s += ss[(size_t)i * RP + r];
    return rsqrtf(s * (1.f / 1024.f) + 1e-6f);
}
__device__ __forceinline__ void epilogue(const GemmPh& P, const Params& p, const Ctx& cx, const f32x4 (&acc)[2][2][4][2], const Unit& u, int wr, int wc, int fr, int fq) {
    const int rbase = u.pm * 256 + wr * 64 + fr, cbase = u.pn * 256 + wc * 32 + 8 * fq;
    if (P.kind == K_L1 || P.kind == K_L2) {
        unsigned char* O; int ldo = 1024, coff = 0, act = 0, cvalid = 1 << 30; const float* bias = nullptr;
        if (P.kind == K_L1) {
            if (u.job < 3) { O = slot(p, 7 + u.job); }
            else if (u.job == 3) { O = slot(p, 10); ldo = 256; act = 1; }
            else if (u.job == 4) { O = slot(p, 10) + (size_t)RP * 512; ldo = 256; act = 2; cvalid = 128; }
            else { O = slot(p, 10) + (size_t)RP * 512; ldo = 256; coff = 128; cvalid = 128; }
        } else {
            if (u.job == 1) { O = slot(p, 5); }
            else { const int cb = u.pn >> 2; O = slot(p, 1 + cb); bias = (cb < 2 ? p.in[8] : p.in[11]) + (cb & 1) * 1024 - cb * 1024; coff = -cb * 1024; act = cb < 2 ? 3 : 1; }
        }
        f32x4 bv[2][2];
#pragma unroll
        for (int bj = 0; bj < 2; ++bj)
#pragma unroll
            for (int n = 0; n < 2; ++n) bv[bj][n] = bias ? *(const f32x4*)(bias + cbase + bj * 128 + 4 * n) : (f32x4){0.f, 0.f, 0.f, 0.f};
#pragma unroll
        for (int ai = 0; ai < 2; ++ai)
#pragma unroll
            for (int m = 0; m < 4; ++m) { if ((m & 1) == 0) __builtin_amdgcn_sched_barrier(0);
#pragma unroll
                for (int bj = 0; bj < 2; ++bj) { const int r = rbase + ai * 128 + m * 16; const int c0 = cbase + bj * 128;
                    f32x4 v0 = acc[ai][bj][m][0] + bv[bj][0], v1 = acc[ai][bj][m][1] + bv[bj][1];
#pragma unroll
                    for (int i = 0; i < 4; ++i) { v0[i] = act_apply(act, v0[i]); v1[i] = act_apply(act, v1[i]); }
                    if (c0 < cvalid) st8(O + ((size_t)r * ldo + coff + c0) * 2, v0, v1); } }
    } else if (P.kind == K_RES) {
        unsigned char* H = P.O;
        u32x4 oldall[2][4][2];
#pragma unroll
        for (int ai = 0; ai < 2; ++ai)
#pragma unroll
            for (int m = 0; m < 4; ++m)
#pragma unroll
                for (int bj = 0; bj < 2; ++bj) oldall[ai][m][bj] = *(const u32x4*)(H + ((size_t)(rbase + ai * 128 + m * 16) * 1024 + cbase + bj * 128) * 2);
        __builtin_amdgcn_sched_barrier(0);
#pragma unroll
        for (int ai = 0; ai < 2; ++ai) {
#pragma unroll
            for (int m = 0; m < 4; ++m) { const int r = rbase + ai * 128 + m * 16; float sq = 0.f;
#pragma unroll
                for (int bj = 0; bj < 2; ++bj) { unsigned char* ptr = H + ((size_t)r * 1024 + cbase + bj * 128) * 2;
                    const u32x4 old = oldall[ai][m][bj]; u32x4 o; const f32x4 a0 = acc[ai][bj][m][0], a1 = acc[ai][bj][m][1];
                    o[0] = pk2(bflo(old[0]) + a0[0], bfhi(old[0]) + a0[1]); o[1] = pk2(bflo(old[1]) + a0[2], bfhi(old[1]) + a0[3]);
                    o[2] = pk2(bflo(old[2]) + a1[0], bfhi(old[2]) + a1[1]); o[3] = pk2(bflo(old[3]) + a1[2], bfhi(old[3]) + a1[3]);
#pragma unroll
                    for (int i = 0; i < 4; ++i) { const float rl = bflo(o[i]), rh = bfhi(o[i]); sq += rl * rl + rh * rh; }
                    *(u32x4*)ptr = o; }
                if (P.ss) { sq += __shfl_xor(sq, 16); sq += __shfl_xor(sq, 32); if (fq == 0) P.ss[(size_t)(u.pn * 4 + wc) * RP + r] = sq; } }
            __builtin_amdgcn_sched_barrier(0);
        }
    } else if (P.kind == K_U) {
        float rsv[2][4];
#pragma unroll
        for (int ai = 0; ai < 2; ++ai)
#pragma unroll
            for (int m = 0; m < 4; ++m) rsv[ai][m] = P.ssin[rbase + ai * 128 + m * 16];
        __builtin_amdgcn_sched_barrier(0);
#pragma unroll
        for (int ai = 0; ai < 2; ++ai)
#pragma unroll
            for (int m = 0; m < 4; ++m) { if ((m & 1) == 0) __builtin_amdgcn_sched_barrier(0); const int r = rbase + ai * 128 + m * 16; const float rs = rsv[ai][m];
#pragma unroll
                for (int bj = 0; bj < 2; ++bj) st8(P.O + ((size_t)r * 5632 + cbase + bj * 128) * 2, acc[ai][bj][m][0] * rs, acc[ai][bj][m][1] * rs); }
    } else if (P.kind == K_CH) {
#pragma unroll
        for (int bj = 0; bj < 2; ++bj) { const int n0 = cbase + bj * 128; const int s = n0 / cx.Tp, t = n0 - s * cx.Tp;
#pragma unroll
            for (int ai = 0; ai < 2; ++ai)
#pragma unroll
                for (int m = 0; m < 4; ++m) { if ((m & 1) == 0) __builtin_amdgcn_sched_barrier(0); const int rr = rbase + ai * 128 + m * 16; const int cs = rr >> 10, ch = rr & 1023;
                    st8(P.O + ((((size_t)s * 1024 + ch) * 2 + cs) * cx.Tp + t) * 2, acc[ai][bj][m][0], acc[ai][bj][m][1]); } }
    } else {
#pragma unroll
        for (int ai = 0; ai < 2; ++ai)
#pragma unroll
            for (int m = 0; m < 4; ++m) { if ((m & 1) == 0) __builtin_amdgcn_sched_barrier(0); const int k = NMETA + rbase + ai * 128 + m * 16; const size_t row = (size_t)u.s * cx.T + k;
#pragma unroll
                for (int bj = 0; bj < 2; ++bj) if (k < cx.T) st8(P.O + (row * 1024 + cbase + bj * 128) * 2, acc[ai][bj][m][0], acc[ai][bj][m][1]); }
    }
}

template <int KIND> __device__ __forceinline__ void gemm_phase(LAS unsigned char* lds, GemmPh P, const Params& p, const Ctx& cx) {
    P.kind = KIND;
    const int tid = ltid(), wid = __builtin_amdgcn_readfirstlane(tid >> 6), lane = tid & 63, wr = wid >> 2, wc = wid & 3, fr = lane & 15, fq = lane >> 4;
    const int nt = P.K / BK;
    unsigned voffA[2], voffB[2];
#pragma unroll
    for (int i = 0; i < 2; ++i) { int R, C; stage_rc(tid * 16 + i * 8192, R, C); const int Rb = (R & ~31) + perm32(R & 31);
        voffA[i] = (unsigned)(R * P.lda + C) * 2u; voffB[i] = (unsigned)(Rb * P.ldb + C) * 2u; }
    const size_t kstep = (size_t)(BK * 2);
    const size_t hstepA = (size_t)HALF * P.lda * 2, hstepB = (size_t)HALF * P.ldb * 2;
    const unsigned ldsw = (unsigned)wid * 1024u;
    const int aoff = lds_byte(wr * 64 + fr, fq * 8), boff = lds_byte(wc * 32 + fr, fq * 8);
#define PG8_SA(b, h) (((b) * 2 + (h)) * HTB)
#define PG8_SB(b, h) ((4 + (b) * 2 + (h)) * HTB)
#define PG8_STAGE(bufoff, gbase, voff) do { _Pragma("unroll") for (int _i = 0; _i < 2; ++_i) \
        __builtin_amdgcn_global_load_lds((const unsigned*)((const char*)(gbase) + (voff)[_i]), (LAS unsigned*)(lds + (bufoff) + ldsw + _i * 8192), 16, 0, 0); } while (0)
#define PG8_LDA(dst, b, h) do { _Pragma("unroll") for (int m = 0; m < 4; ++m) _Pragma("unroll") for (int k = 0; k < 2; ++k) dst[m][k] = *(const LAS bf16x8*)(lds + PG8_SA(b, h) + aoff + m * 2048 + k * 1024); } while (0)
#define PG8_LDB(dst, b, h) do { _Pragma("unroll") for (int n = 0; n < 2; ++n) _Pragma("unroll") for (int k = 0; k < 2; ++k) dst[n][k] = *(const LAS bf16x8*)(lds + PG8_SB(b, h) + boff + n * 2048 + k * 1024); } while (0)
#define PG8_MMA(ai, bj, At, Bt) do { __builtin_amdgcn_s_setprio(1); _Pragma("unroll") for (int m = 0; m < 4; ++m) _Pragma("unroll") for (int n = 0; n < 2; ++n) _Pragma("unroll") for (int k = 0; k < 2; ++k) \
        acc[ai][bj][m][n] = __builtin_amdgcn_mfma_f32_16x16x32_bf16(Bt[n][k], At[m][k], acc[ai][bj][m][n], 0, 0, 0); __builtin_amdgcn_s_setprio(0); } while (0)
#define PG8_WAIT_V(n) asm volatile("s_waitcnt vmcnt(" #n ")" ::: "memory")
#define PG8_WAIT_L(n) asm volatile("s_waitcnt lgkmcnt(" #n ")" ::: "memory")
#define PG8_BAR __builtin_amdgcn_s_barrier()
#define PG8_SCHED __builtin_amdgcn_sched_barrier(0)
    Unit cur, nxt; int ui = 0;
    if (!next_unit(P, p, cx, 0, cur)) return;
    f32x4 acc[2][2][4][2];
#pragma unroll
    for (int a = 0; a < 2; ++a)
#pragma unroll
        for (int b = 0; b < 2; ++b)
#pragma unroll
            for (int m = 0; m < 4; ++m)
#pragma unroll
                for (int n = 0; n < 2; ++n) acc[a][b][m][n] = (f32x4){0.f, 0.f, 0.f, 0.f};
    bf16x8 At[4][2], B0[2][2], B1[2][2];
    const char* cA = cur.A; const char* cB = cur.B;
    PG8_STAGE(PG8_SB(0, 0), cB, voffB); PG8_STAGE(PG8_SA(0, 0), cA, voffA); PG8_STAGE(PG8_SB(0, 1), cB + hstepB, voffB); PG8_STAGE(PG8_SA(0, 1), cA + hstepA, voffA);
    if (wr == 1) PG8_BAR;
    PG8_WAIT_V(4); PG8_BAR;
    PG8_STAGE(PG8_SB(1, 0), cB + kstep, voffB); PG8_STAGE(PG8_SA(1, 0), cA + kstep, voffA); PG8_STAGE(PG8_SB(1, 1), cB + hstepB + kstep, voffB);
    PG8_WAIT_V(6); PG8_BAR;
    for (;;) {
        const bool has_next = next_unit(P, p, cx, ui + 1, nxt);
        const char* nA = has_next ? nxt.A : cA; const char* nB = has_next ? nxt.B : cB;
        for (int t = 0; t < nt; t += 2) {
            const bool last = (t == nt - 2);
            const char* a1 = cA + (size_t)(t + 1) * kstep;
            const char* a2 = last ? nA : cA + (size_t)(t + 2) * kstep; const char* b2 = last ? nB : cB + (size_t)(t + 2) * kstep;
            const char* a3 = a2 + kstep; const char* b3 = b2 + kstep;
            PG8_LDB(B0, 0, 0); PG8_SCHED; PG8_LDA(At, 0, 0); PG8_STAGE(PG8_SA(1, 1), a1 + hstepA, voffA);
            PG8_WAIT_L(8); PG8_BAR; PG8_WAIT_L(0); PG8_MMA(0, 0, At, B0); PG8_BAR; PG8_SCHED;
            PG8_LDB(B1, 0, 1); PG8_STAGE(PG8_SB(0, 0), b2, voffB);
            PG8_BAR; PG8_WAIT_L(0); PG8_MMA(0, 1, At, B1); PG8_BAR;
            PG8_LDA(At, 0, 1); PG8_STAGE(PG8_SA(0, 0), a2, voffA);
            PG8_BAR; PG8_WAIT_L(0); PG8_MMA(1, 0, At, B0); PG8_BAR; PG8_SCHED;
            PG8_STAGE(PG8_SB(0, 1), b2 + hstepB, voffB);
            PG8_WAIT_V(6); PG8_BAR; PG8_MMA(1, 1, At, B1); PG8_BAR;
            PG8_LDB(B0, 1, 0); PG8_SCHED; PG8_LDA(At, 1, 0); PG8_STAGE(PG8_SA(0, 1), a2 + hstepA, voffA);
            PG8_WAIT_L(8); PG8_BAR; PG8_WAIT_L(0); PG8_MMA(0, 0, At, B0); PG8_BAR; PG8_SCHED;
            PG8_LDB(B1, 1, 1); PG8_STAGE(PG8_SB(1, 0), b3, voffB);
            PG8_BAR; PG8_WAIT_L(0); PG8_MMA(0, 1, At, B1); PG8_BAR;
            PG8_LDA(At, 1, 1); PG8_STAGE(PG8_SA(1, 0), a3, voffA);
            PG8_BAR; PG8_WAIT_L(0); PG8_MMA(1, 0, At, B0); PG8_BAR; PG8_SCHED;
            PG8_STAGE(PG8_SB(1, 1), b3 + hstepB, voffB);
            PG8_WAIT_V(6); PG8_BAR; PG8_MMA(1, 1, At, B1); PG8_BAR;
        }
        epilogue(P, p, cx, acc, cur, wr, wc, fr, fq);
        if (!has_next) break;
#pragma unroll
        for (int a = 0; a < 2; ++a)
#pragma unroll
            for (int b = 0; b < 2; ++b)
#pragma unroll
                for (int m = 0; m < 4; ++m)
#pragma unroll
                    for (int n = 0; n < 2; ++n) acc[a][b][m][n] = (f32x4){0.f, 0.f, 0.f, 0.f};
        cur = nxt; cA = nA; cB = nB; ++ui;
    }
    PG8_WAIT_V(0);
    if (wr == 0) PG8_BAR;
    PG8_BAR;
#undef PG8_SA
#undef PG8_SB
#undef PG8_STAGE
#undef PG8_LDA
#undef PG8_LDB
#undef PG8_MMA
#undef PG8_WAIT_V
#undef PG8_WAIT_L
#undef PG8_BAR
#undef PG8_SCHED
}

__device__ __forceinline__ void tr_job(LAS float* tile, const float* src, int K, int N, unsigned char* dst, int ldk, int koff, int Kpad, int Npad, const float* scale, int& cnt, int stride_start, int G) {
    const int tk = Kpad / 64, tn = Npad / 64, ntile = tk * tn; const int tid = ltid();
    for (int it = 0; it < ntile; ++it, ++cnt) {
        if ((cnt % G) != stride_start) continue;
        const int k0 = (it / tn) * 64, n0 = (it % tn) * 64;
        __syncthreads();
        { const int tx = tid & 63, ty = tid >> 6;
#pragma unroll
            for (int i = 0; i < 8; ++i) { const int kd = k0 + ty + 8 * i, ks = kd - koff, n = n0 + tx; float v = 0.f;
                if (ks >= 0 && ks < K && n < N) { v = src[(size_t)ks * N + n]; if (scale) v *= scale[ks]; }
                tile[(ty + 8 * i) * 65 + tx] = v; } }
        __syncthreads();
        { const int n = tid >> 3, kc = (tid & 7) * 8; u32x4 o;
#pragma unroll
            for (int i = 0; i < 4; ++i) o[i] = pk2(tile[(kc + 2 * i) * 65 + n], tile[(kc + 2 * i + 1) * 65 + n]);
            *(u32x4*)(dst + ((size_t)(n0 + n) * ldk + k0 + kc) * 2) = o; }
    }
}

__device__ __forceinline__ void prep_phase(LAS unsigned char* lds, const Params& p) {
    LAS float* tile = (LAS float*)lds; unsigned char* ws = p.ws; int cnt = 0; const int b = blockIdx.x, G = gridDim.x;
    for (int i = 0; i < 3; ++i) tr_job(tile, p.in[7] + (size_t)i * D * D, D, D, ws + O_WRKV + (size_t)i * D * D * 2, 1024, 0, 1024, 1024, nullptr, cnt, b, G);
    tr_job(tile, p.in[14], D, 160, ws + O_G1, 1024, 0, 1024, 256, nullptr, cnt, b, G);
    tr_job(tile, p.in[9], D, 64, ws + O_W1, 1024, 0, 1024, 64, nullptr, cnt, b, G);
    tr_job(tile, p.in[9] + D * 64, D, 64, ws + O_W1 + (size_t)64 * 1024 * 2, 1024, 0, 1024, 192, nullptr, cnt, b, G);
    tr_job(tile, p.in[12], D, 64, ws + O_A1, 1024, 0, 1024, 64, nullptr, cnt, b, G);
    tr_job(tile, p.in[12] + D * 64, D, 64, ws + O_A1 + (size_t)64 * 1024 * 2, 1024, 0, 1024, 192, nullptr, cnt, b, G);
    for (int z = 0; z < 2; ++z) {
        tr_job(tile, p.in[10] + (size_t)z * 64 * D, 64, D, ws + O_L2 + (size_t)z * 1024 * 256 * 2, 256, z * 64, 256, 1024, nullptr, cnt, b, G);
        tr_job(tile, p.in[13] + (size_t)z * 64 * D, 64, D, ws + O_L2 + (size_t)(2 + z) * 1024 * 256 * 2, 256, (2 + z) * 64, 256, 1024, nullptr, cnt, b, G);
    }
    tr_job(tile, p.in[15], 160, D, ws + O_G2, 256, 0, 256, 1024, nullptr, cnt, b, G);
    tr_job(tile, p.in[21], D, D, ws + O_WO, 1024, 0, 1024, 1024, nullptr, cnt, b, G);
    tr_job(tile, p.in[22], D, D, ws + O_WF, 1024, 0, 1024, 1024, nullptr, cnt, b, G);
    for (int l = 0; l < 2; ++l) {
        tr_job(tile, p.in[23] + (size_t)l * D * 5632, D, 5632, ws + O_WIN + (size_t)l * 5632 * 1024 * 2, 1024, 0, 1024, 5632, p.in[4] + l * D, cnt, b, G);
        tr_job(tile, p.in[26] + (size_t)l * DFF * D, DFF, D, ws + O_WOUT + (size_t)l * 1024 * DFF * 2, DFF, 0, DFF, 1024, nullptr, cnt, b, G);
    }
    const size_t gt = (size_t)blockIdx.x * 512 + ltid(), NT = (size_t)gridDim.x * 512;
    const float* nm1 = p.in[3] + D;
    for (size_t e = gt; e < (size_t)2048 * 128; e += NT) {
        const int rr = (int)(e >> 7), c0 = (int)(e & 127) * 8; const int cs = rr >> 10, ch = rr & 1023; float v[8];
#pragma unroll
        for (int i = 0; i < 8; ++i) { const int c = c0 + i; float val = 0.f;
            if ((c >> 7) == (ch >> 7)) { const int m = ((ch & 127) * (c & 127)) & 127; float sn, cn; sincospif((float)m * (1.f / 64.f), &sn, &cn); val = (cs ? sn : cn) * nm1[c] * 0.08838834764831845f; }
            v[i] = val; }
        u32x4 o; o[0] = pk2(v[0], v[1]); o[1] = pk2(v[2], v[3]); o[2] = pk2(v[4], v[5]); o[3] = pk2(v[6], v[7]);
        *(u32x4*)(ws + O_CHD + e * 16) = o;
    }
    for (int ty = 0; ty < 2; ++ty) {
        const int T = ty ? 4112 : 2064, Tp = ty ? TP_S : TP_P, Mp = ty ? MP_S : MP_P; const int rowv = 2 * Tp / 8;
        unsigned char* dst = ws + (ty ? O_DFTS : O_DFTP); const float isq = rsqrtf((float)T), invT = 2.f / (float)T;
        for (size_t e = gt; e < (size_t)Mp * rowv; e += NT) {
            const int k = (int)(e / rowv), kk0 = (int)(e % rowv) * 8; float v[8];
#pragma unroll
            for (int i = 0; i < 8; ++i) { const int kk = kk0 + i; const int issin = kk >= Tp, t = issin ? kk - Tp : kk; float val = 0.f;
                if (k < T && (issin ? (t >= 1 && t <= T / 2 - 1) : (t <= T / 2))) { const int m = (int)(((long)k * t) % T); float sn, cn; sincospif((float)m * invT, &sn, &cn); val = (issin ? -sn : cn) * isq; }
                v[i] = val; }
            u32x4 o; o[0] = pk2(v[0], v[1]); o[1] = pk2(v[2], v[3]); o[2] = pk2(v[4], v[5]); o[3] = pk2(v[6], v[7]);
            *(u32x4*)(dst + e * 16) = o;
        }
    }
}

__device__ __forceinline__ void ea_load_row(const Params& p, const Ctx& c, int s, int pos, int lane, float (&v)[16]) {
    if (pos < 0 || pos >= c.T) {
#pragma unroll
        for (int i = 0; i < 16; ++i) v[i] = 0.f;
        return; }
    const float* src = pos < NMETA ? p.in[2] + (size_t)pos * D : c.x + ((size_t)s * (c.T - NMETA) + (pos - NMETA)) * D;
#pragma unroll
    for (int j = 0; j < 4; ++j) { const f32x4 t = *(const f32x4*)(src + j * 256 + lane * 4); v[4 * j] = t[0]; v[4 * j + 1] = t[1]; v[4 * j + 2] = t[2]; v[4 * j + 3] = t[3]; }
}
__device__ __forceinline__ void ea_store_row(unsigned char* base, size_t row, int lane, const float (&v)[16]) {
#pragma unroll
    for (int j = 0; j < 4; ++j) { u32x2 o; o[0] = pk2(v[4 * j], v[4 * j + 1]); o[1] = pk2(v[4 * j + 2], v[4 * j + 3]); *(u32x2*)(base + (row * 1024 + j * 256 + lane * 4) * 2) = o; }
}
__device__ __forceinline__ void ea_norm(float (&v)[16], const float (&nw)[16]) {
    float ss = 0.f;
#pragma unroll
    for (int i = 0; i < 16; ++i) ss += v[i] * v[i];
    ss = wave_sum(ss); const float rs = rsqrtf(ss * (1.f / 1024.f) + 1e-6f);
#pragma unroll
    for (int i = 0; i < 16; ++i) v[i] = v[i] * rs * nw[i];
}
__device__ __forceinline__ void phase_mix(const Params& p, const Ctx& c) {
    const int wave = __builtin_amdgcn_readfirstlane(ltid() >> 6), lane = ltid() & 63;
    const int gw = blockIdx.x * 8 + wave, NW = gridDim.x * 8;
    float nw[16];
#pragma unroll
    for (int j = 0; j < 4; ++j) { const f32x4 t = *(const f32x4*)(p.in[3] + j * 256 + lane * 4); nw[4 * j] = t[0]; nw[4 * j + 1] = t[1]; nw[4 * j + 2] = t[2]; nw[4 * j + 3] = t[3]; }
    const int nstrips = c.R / 16, spq = c.T / 16;
    for (int st = gw; st < nstrips; st += NW) {
        const int s = st / spq, pos0 = (st - s * spq) * 16; const size_t row0 = (size_t)st * 16;
        float prev[16], cur[16], nx[16];
        ea_load_row(p, c, s, pos0 - 1, lane, prev); ea_norm(prev, nw);
        ea_load_row(p, c, s, pos0, lane, cur); ea_store_row(slot(p, 0), row0, lane, cur); ea_norm(cur, nw);
        float ah[16];
        ea_load_row(p, c, s, pos0 + 1, lane, ah);
        for (int i = 0; i < 16; ++i) {
#pragma unroll
            for (int e = 0; e < 16; ++e) nx[e] = ah[e];
            if (i < 15) ea_load_row(p, c, s, pos0 + i + 2, lane, ah);
            if (i < 15) ea_store_row(slot(p, 0), row0 + i + 1, lane, nx);
            ea_norm(nx, nw);
            float xx[16], o[16];
#pragma unroll
            for (int e = 0; e < 16; ++e) xx[e] = 0.5f * (prev[e] + nx[e]) - cur[e];
            for (int m = 0; m < 6; ++m) {
#pragma unroll
                for (int j = 0; j < 4; ++j) { const f32x4 t = *(const f32x4*)(p.in[6] + m * D + j * 256 + lane * 4);
#pragma unroll
                    for (int e = 0; e < 4; ++e) o[4 * j + e] = cur[4 * j + e] + xx[4 * j + e] * t[e]; }
                ea_store_row(slot(p, 1 + m), row0 + i, lane, o); }
#pragma unroll
            for (int e = 0; e < 16; ++e) { prev[e] = cur[e]; cur[e] = nx[e]; }
        }
    }
}

__device__ __forceinline__ void ld2(const unsigned char* base, size_t elem, u32x4 (&d)[2]) { const u32x4* q = (const u32x4*)(base + elem * 2); d[0] = q[0]; d[1] = q[1]; }
__device__ __forceinline__ void phase_prescan(const Params& p, const Ctx& c) {
    const int wave = __builtin_amdgcn_readfirstlane(ltid() >> 6), lane = ltid() & 63;
    const int gw = blockIdx.x * 8 + wave, NW = gridDim.x * 8; const int ch0 = lane * 16;
    float kkw[16], kaw[16], rkw[16];
    load16f(p.in[16] + ch0, kkw); load16f(p.in[17] + ch0, kaw); load16f(p.in[18] + ch0, rkw);
    float* bonus = (float*)(p.ws + O_BONUS);
    u32x4 nk[2], na0[2], na1[2], nr[2];
    if (gw < c.R) { const size_t e = (size_t)gw * 1024 + ch0; ld2(slot(p, 8), e, nk); ld2(slot(p, 3), e, na0); ld2(slot(p, 4), e, na1); ld2(slot(p, 7), e, nr); }
    for (int row = gw; row < c.R; row += NW) {
        const size_t e = (size_t)row * 1024 + ch0;
        float k[16], a0[16], a1[16], r[16];
        unpack16(nk[0], nk[1], k); unpack16(na0[0], na0[1], a0); unpack16(na1[0], na1[1], a1); unpack16(nr[0], nr[1], r);
        if (row + NW < c.R) { const size_t e2 = (size_t)(row + NW) * 1024 + ch0; ld2(slot(p, 8), e2, nk); ld2(slot(p, 3), e2, na0); ld2(slot(p, 4), e2, na1); ld2(slot(p, 7), e2, nr); }
        float kk[16], n2 = 0.f;
#pragma unroll
        for (int i = 0; i < 16; ++i) { kk[i] = k[i] * kkw[i]; n2 += kk[i] * kk[i]; }
        n2 += __shfl_xor(n2, 1); n2 += __shfl_xor(n2, 2);
        const float inv = 1.f / fmaxf(sqrtf(n2), 1e-12f);
        float kd0[16], kd1[16], bon = 0.f;
#pragma unroll
        for (int i = 0; i < 16; ++i) { kk[i] *= inv; kd0[i] = k[i] * (1.f + (a0[i] - 1.f) * kaw[i]); kd1[i] = k[i] * (1.f + (a1[i] - 1.f) * kaw[i]);
            bon += r[i] * (kd0[i] + kd1[i]) * rkw[i]; a0[i] *= kk[i]; a1[i] *= kk[i]; }
        bon += __shfl_xor(bon, 1); bon += __shfl_xor(bon, 2);
        if ((lane & 3) == 0) bonus[(size_t)row * 16 + (lane >> 2)] = bon;
        store16bf(slot(p, 8), e, kk); store16bf(slot(p, 3), e, a0); store16bf(slot(p, 4), e, a1);
        store16bf(slot(p, 6), e, kd0); store16bf(slot(p, 10), e, kd1);
    }
}

__device__ __forceinline__ float half_sum(float x) {
    const unsigned a = __float_as_uint(x); auto r = __builtin_amdgcn_permlane32_swap(a, a, false, false);
    return __uint_as_float(r[0]) + __uint_as_float(r[1]);
}
__device__ __forceinline__ float ldbf(const unsigned char* base, int idx) { return __uint_as_float(((unsigned)((const bf16_t*)base)[idx]) << 16); }
__device__ __forceinline__ float quarter_sum(float x) {
    const unsigned a = __float_as_uint(x); auto r = __builtin_amdgcn_permlane16_swap(a, a, false, false);
    return half_sum(__uint_as_float(r[0]) + __uint_as_float(r[1]));
}
template <int RPL, int JP, int RING>
__device__ __forceinline__ void scan_items(LAS unsigned char* lds, const Params& p, const Ctx& c) {
    constexpr int LR = 64 / JP, NJ = 64 / JP, ROWS = LR * RPL, WPS = 64 / ROWS, NQ = NJ / 4, BQ = RPL == 2 ? 1 : 2, NB = NQ / BQ;
    const int tid = ltid(); const int wave = __builtin_amdgcn_readfirstlane(tid >> 6), lane = tid & 63;
    const int nitem = c.nseq * 32 * WPS; const int lr = lane % LR, jp = lane / LR;
    LAS float* wb = (LAS float*)(lds + wave * 16384);
    LAS float* oring = wb + 1024;
    for (int w = blockIdx.x + gridDim.x * wave; w < nitem; w += gridDim.x * 8) {
        const int q = w / WPS, rq = w % WPS; const int dir = q & 1, hh = (q >> 1) & 15, s = q >> 5;
        const size_t e0 = (size_t)s * c.T * 1024 + hh * 64;
        const unsigned char* Rb = slot(p, 7) + e0 * 2; const unsigned char* Kkb = slot(p, 8) + e0 * 2; const unsigned char* Vb = slot(p, 9) + e0 * 2;
        const unsigned char* Ngb = slot(p, 1 + dir) + e0 * 2; const unsigned char* Bdb = slot(p, 3 + dir) + e0 * 2;
        const unsigned char* Kdb = slot(p, dir ? 10 : 6) + e0 * 2; unsigned char* Ob = slot(p, 11 + dir) + e0 * 2;
        const int vec = lane >> 3, chunk = lane & 7;
        const unsigned char* lb = (vec == 0 ? Kkb : vec == 1 ? Ngb : vec == 2 ? Bdb : vec == 3 ? Kdb : vec == 4 ? Rb : Vb) + chunk * 16;
        const int vrow0 = rq * ROWS + lr;
        const int step = dir ? -2048 : 2048; const long ro0 = dir ? (long)(c.T - 1) * 2048 : 0;
        f32x2 S2[RPL][NJ / 2];
#pragma unroll
        for (int a_ = 0; a_ < RPL; ++a_)
#pragma unroll
            for (int j = 0; j < NJ / 2; ++j) S2[a_][j] = (f32x2){0.f, 0.f};
        u32x4 xr[RING];
#define SCAN_LD(dst, tt) do { const int _t = (tt) < c.T ? (tt) : c.T - 1; const long _r = ro0 + (long)_t * step; dst = *(const u32x4*)(lb + _r); } while (0)
#define SCAN_PARK(x, buf) do { if (vec < 6) { f32x4 _lo, _hi; _lo[0] = bflo(x[0]); _lo[1] = bfhi(x[0]); _lo[2] = bflo(x[1]); _lo[3] = bfhi(x[1]); _hi[0] = bflo(x[2]); _hi[1] = bfhi(x[2]); _hi[2] = bflo(x[3]); _hi[3] = bfhi(x[3]); \
            LAS f32x4* _d = (LAS f32x4*)((buf) + vec * 64 + chunk * 8); _d[0] = _lo; _d[1] = _hi; } } while (0)
#define SCAN_RD4(dst, base, jj) do { _Pragma("unroll") for (int _h = 0; _h < BQ; ++_h) { dst[4 * _h] = ((const LAS f32x4*)((base) + 64))[(jj) + _h]; dst[4 * _h + 1] = ((const LAS f32x4*)((base) + 128))[(jj) + _h]; \
            dst[4 * _h + 2] = ((const LAS f32x4*)((base) + 192))[(jj) + _h]; dst[4 * _h + 3] = ((const LAS f32x4*)((base) + 256))[(jj) + _h]; } } while (0)
        float vi[RPL];
        { u32x4 x; SCAN_LD(x, 0); SCAN_PARK(x, wb); }
#pragma unroll
        for (int k = 1; k < RING; ++k) SCAN_LD(xr[k], k);
        SCAN_LD(xr[0], RING);
        f32x4 kq[NQ];
#pragma unroll
        for (int j = 0; j < NQ; ++j) kq[j] = ((const LAS f32x4*)(wb + jp * NJ))[j];
#pragma unroll
        for (int a_ = 0; a_ < RPL; ++a_) vi[a_] = wb[320 + vrow0 + a_ * LR];
        int fstart = 0;
        for (int tb = 0; tb < c.T; tb += RING) {
#pragma unroll
            for (int k = 0; k < RING; ++k) {
                const int t = tb + k;
                const LAS float* sb = wb + (k & 1) * 512 + jp * NJ; LAS float* sn = wb + ((k + 1) & 1) * 512;
                f32x4 PQ[2][4 * BQ];
                SCAN_RD4(PQ[0], sb, 0);
                __builtin_amdgcn_sched_barrier(0);
                float sa[RPL];
#pragma unroll
                for (int a_ = 0; a_ < RPL; ++a_) { f32x2 a0 = (f32x2){0.f, 0.f}, a1 = (f32x2){0.f, 0.f};
#pragma unroll
                    for (int j = 0; j < NQ; ++j) { a0 = __builtin_elementwise_fma(S2[a_][2 * j], (f32x2){kq[j][0], kq[j][1]}, a0); a1 = __builtin_elementwise_fma(S2[a_][2 * j + 1], (f32x2){kq[j][2], kq[j][3]}, a1); }
                    sa[a_] = (a0[0] + a0[1]) + (a1[0] + a1[1]); }
                u32x4& xs = xr[(k + 1) % RING];
                SCAN_PARK(xs, sn);
                float vcur[RPL];
#pragma unroll
                for (int a_ = 0; a_ < RPL; ++a_) vcur[a_] = vi[a_];
                SCAN_LD(xs, t + 1 + RING);
                f32x2 sa2[RPL], v2[RPL], oa0[RPL], oa1[RPL];
#pragma unroll
                for (int a_ = 0; a_ < RPL; ++a_) { const float sr = -(JP == 2 ? half_sum(sa[a_]) : quarter_sum(sa[a_])); sa2[a_] = (f32x2){sr, sr}; v2[a_] = (f32x2){vcur[a_], vcur[a_]};
                    oa0[a_] = (f32x2){0.f, 0.f}; oa1[a_] = (f32x2){0.f, 0.f}; }
#pragma unroll
                for (int b_ = 0; b_ < NB; ++b_) {
                    if (b_ + 1 < NB) { SCAN_RD4(PQ[(b_ + 1) & 1], sb, BQ * (b_ + 1)); }
                    else {
#pragma unroll
                        for (int j = 0; j < NQ; ++j) kq[j] = ((const LAS f32x4*)(sn + jp * NJ))[j];
#pragma unroll
                        for (int a_ = 0; a_ < RPL; ++a_) vi[a_] = sn[320 + vrow0 + a_ * LR];
                    }
                    __builtin_amdgcn_sched_barrier(0);
#pragma unroll
                    for (int h_ = 0; h_ < BQ; ++h_) { const f32x4 g4 = PQ[b_ & 1][4 * h_], b4 = PQ[b_ & 1][4 * h_ + 1], d4 = PQ[b_ & 1][4 * h_ + 2], r4 = PQ[b_ & 1][4 * h_ + 3]; const int j_ = 2 * (BQ * b_ + h_);
#pragma unroll
                        for (int a_ = 0; a_ < RPL; ++a_) { f32x2 s0 = S2[a_][j_], s1 = S2[a_][j_ + 1];
                            s0 = __builtin_elementwise_fma(s0, (f32x2){g4[0], g4[1]}, s0); s1 = __builtin_elementwise_fma(s1, (f32x2){g4[2], g4[3]}, s1);
                            s0 = __builtin_elementwise_fma(sa2[a_], (f32x2){b4[0], b4[1]}, s0); s1 = __builtin_elementwise_fma(sa2[a_], (f32x2){b4[2], b4[3]}, s1);
                            s0 = __builtin_elementwise_fma(v2[a_], (f32x2){d4[0], d4[1]}, s0); s1 = __builtin_elementwise_fma(v2[a_], (f32x2){d4[2], d4[3]}, s1);
                            S2[a_][j_] = s0; S2[a_][j_ + 1] = s1;
                            oa0[a_] = __builtin_elementwise_fma(s0, (f32x2){r4[0], r4[1]}, oa0[a_]); oa1[a_] = __builtin_elementwise_fma(s1, (f32x2){r4[2], r4[3]}, oa1[a_]); } }
                    __builtin_amdgcn_sched_barrier(0);
                }
#pragma unroll
                for (int a_ = 0; a_ < RPL; ++a_) { const float os_ = (oa0[a_][0] + oa0[a_][1]) + (oa1[a_][0] + oa1[a_][1]); const float ov = JP == 2 ? half_sum(os_) : quarter_sum(os_);
                    if (jp == 0) oring[(t & 63) * ROWS + a_ * LR + lr] = ov; }
            }
            const int tend = tb + RING, nfl = tend - fstart;
            if (nfl == 64 || tend >= c.T) {
                for (int idx = lane; idx < nfl * ROWS; idx += 64) { const int st = idx / ROWS, row = idx % ROWS;
                    ((bf16_t*)(Ob + ro0 + (long)(fstart + st) * step))[rq * ROWS + row] = (bf16_t)(pk2(oring[idx], 0.f) & 0xffffu); }
                fstart = tend;
            }
        }
#undef SCAN_LD
#undef SCAN_PARK
#undef SCAN_RD4
    }
}
__device__ __forceinline__ void phase_scan(LAS unsigned char* lds, const Params& p, const Ctx& c) {
    if (c.g < 2) scan_items<1, 2, 8>(lds, p, c); else scan_items<1, 4, 8>(lds, p, c);
}

__device__ __forceinline__ void phase_postscan(const Params& p, const Ctx& c) {
    const int wave = __builtin_amdgcn_readfirstlane(ltid() >> 6), lane = ltid() & 63;
    const int gw = blockIdx.x * 8 + wave, NW = gridDim.x * 8; const int ch0 = lane * 16;
    float gw_[16], gb_[16]; load16f(p.in[19] + ch0, gw_); load16f(p.in[20] + ch0, gb_);
    const float* bonus = (const float*)(p.ws + O_BONUS);
    u32x4 nf[2], nb[2], nv[2], ng[2];
    if (gw < c.R) { const size_t e = (size_t)gw * 1024 + ch0; ld2(slot(p, 11), e, nf); ld2(slot(p, 12), e, nb); ld2(slot(p, 9), e, nv); ld2(slot(p, 5), e, ng); }
    for (int row = gw; row < c.R; row += NW) {
        const size_t e = (size_t)row * 1024 + ch0;
        float of[16], ob[16], v[16], g[16];
        unpack16(nf[0], nf[1], of); unpack16(nb[0], nb[1], ob); unpack16(nv[0], nv[1], v); unpack16(ng[0], ng[1], g);
        if (row + NW < c.R) { const size_t e2 = (size_t)(row + NW) * 1024 + ch0; ld2(slot(p, 11), e2, nf); ld2(slot(p, 12), e2, nb); ld2(slot(p, 9), e2, nv); ld2(slot(p, 5), e2, ng); }
        float sum = 0.f;
#pragma unroll
        for (int i = 0; i < 16; ++i) { of[i] += ob[i]; sum += of[i]; }
        sum += __shfl_xor(sum, 1); sum += __shfl_xor(sum, 2); const float mean = sum * (1.f / 64.f);
        float var = 0.f;
#pragma unroll
        for (int i = 0; i < 16; ++i) { of[i] -= mean; var += of[i] * of[i]; }
        var += __shfl_xor(var, 1); var += __shfl_xor(var, 2); const float rs = rsqrtf(var * (1.f / 64.f) + 64e-5f);
        const float bon = bonus[(size_t)row * 16 + (lane >> 2)];
#pragma unroll
        for (int i = 0; i < 16; ++i) of[i] = (of[i] * rs * gw_[i] + gb_[i] + bon * v[i]) * g[i];
        store16bf(slot(p, 1), e, of);
    }
}

__device__ __forceinline__ void phase_glu(const Params& p, const Ctx& c, int layer) {
    const size_t gt = (size_t)blockIdx.x * 512 + ltid(), NT = (size_t)gridDim.x * 512;
    const unsigned char* U = slot(p, 1); unsigned char* Aout = slot(p, 7);
    const float* cw = p.in[24] + (size_t)layer * 3 * DFF; const float* cb = p.in[25] + (size_t)layer * DFF;
    const size_t nitem = (size_t)(c.R / 16) * 352;
    for (size_t it = gt; it < nitem; it += NT) {
        const int strip = (int)(it / 352), cc = (int)(it % 352) * 8; const int row0 = strip * 16, pos0 = row0 % c.T;
        float w0[8], w1[8], w2[8], bb[8];
#pragma unroll
        for (int h = 0; h < 2; ++h) { const f32x4 a = *(const f32x4*)(cw + cc + 4 * h), b = *(const f32x4*)(cw + DFF + cc + 4 * h), d = *(const f32x4*)(cw + 2 * DFF + cc + 4 * h), e = *(const f32x4*)(cb + cc + 4 * h);
#pragma unroll
            for (int i = 0; i < 4; ++i) { w0[4 * h + i] = a[i]; w1[4 * h + i] = b[i]; w2[4 * h + i] = d[i]; bb[4 * h + i] = e[i]; } }
        const unsigned char* ur = U + (size_t)row0 * 5632 * 2 + cc * 2;
        const u32x4 z = (u32x4){0u, 0u, 0u, 0u};
        u32x4 pm = pos0 > 0 ? *(const u32x4*)(ur - 5632 * 2) : z, pc = *(const u32x4*)ur;
        for (int i0 = 0; i0 < 16; i0 += 4) {
            u32x4 PP[4], LN[4];
#pragma unroll
            for (int j = 0; j < 4; ++j) { PP[j] = (pos0 + i0 + j < c.T - 1) ? *(const u32x4*)(ur + (size_t)(j + 1) * 5632 * 2) : z; LN[j] = *(const u32x4*)(ur + (size_t)j * 5632 * 2 + DFF * 2); }
#pragma unroll
            for (int j = 0; j < 4; ++j) { const u32x4 pp = PP[j], ln = LN[j]; u32x4 o;
#pragma unroll
                for (int e = 0; e < 4; ++e) {
                    const float c0 = bflo(pm[e]) * w0[2 * e] + bflo(pc[e]) * w1[2 * e] + bflo(pp[e]) * w2[2 * e] + bb[2 * e];
                    const float c1 = bfhi(pm[e]) * w0[2 * e + 1] + bfhi(pc[e]) * w1[2 * e + 1] + bfhi(pp[e]) * w2[2 * e + 1] + bb[2 * e + 1];
                    o[e] = pk2(c0 * sigmoidf_(c0) * bflo(ln[e]), c1 * sigmoidf_(c1) * bfhi(ln[e])); }
                *(u32x4*)(Aout + ((size_t)(row0 + i0 + j) * DFF + cc) * 2) = o;
                pm = pc; pc = pp; }
            ur += (size_t)4 * 5632 * 2;
        }
    }
}

__device__ __forceinline__ void phase_final(const Params& p, const Ctx& c) {
    const int tid = ltid(); const int wave = __builtin_amdgcn_readfirstlane(tid >> 6), lane = tid & 63;
    const int gw = blockIdx.x * 8 + wave, NW = gridDim.x * 8; const int ch0 = lane * 16;
    float nf[16]; load16f(p.in[5] + ch0, nf);
    const int To = c.T - NMETA, nrow = c.nseq * To;
    for (int q0 = gw * 4; q0 < nrow; q0 += NW * 4) {
        u32x4 ha[4], hb[4];
#pragma unroll
        for (int j = 0; j < 4; ++j) { const int q = q0 + j, s = q / To, po = q - s * To; const size_t row = (size_t)s * c.T + NMETA + po;
            const u32x4* src = (const u32x4*)(slot(p, 0) + (row * 1024 + ch0) * 2); ha[j] = src[0]; hb[j] = src[1]; }
#pragma unroll
        for (int j = 0; j < 4; ++j) { float h[16]; unpack16(ha[j], hb[j], h);
            float ss = 0.f;
#pragma unroll
            for (int i = 0; i < 16; ++i) ss += h[i] * h[i];
            ss = wave_sum(ss); const float rs = rsqrtf(ss * (1.f / 1024.f) + 1e-6f);
            float* dst = c.y + (size_t)(q0 + j) * 1024 + ch0;
#pragma unroll
            for (int k = 0; k < 4; ++k) { f32x4 o; o[0] = h[4 * k] * rs * nf[4 * k]; o[1] = h[4 * k + 1] * rs * nf[4 * k + 1]; o[2] = h[4 * k + 2] * rs * nf[4 * k + 2]; o[3] = h[4 * k + 3] * rs * nf[4 * k + 3]; ((f32x4*)dst)[k] = o; } }
    }
}


#define XB_TMO      128
#define XB_XCNT(j)  (256  + 64 * (j))
#define XB_XSUB(j)  (1280 + 64 * (j))
#define XB_XGEN(j)  (2304 + 64 * (j))
#define XB_TOP      3328
#define XB_TOPGEN   3392
#define XCD_BAR_WORDS 3456
#define XB_SPIN_CAP (1u << 18)
__device__ __forceinline__ unsigned xb_ld(unsigned* p)              { return __hip_atomic_load(p, __ATOMIC_RELAXED, __HIP_MEMORY_SCOPE_AGENT); }
__device__ __forceinline__ unsigned xb_add(unsigned* p, unsigned v) { return __hip_atomic_fetch_add(p, v, __ATOMIC_RELAXED, __HIP_MEMORY_SCOPE_AGENT); }
__device__ __forceinline__ unsigned xb_xcc_id() { return (unsigned)__builtin_amdgcn_s_getreg((3 << 11) | 20) & 0xFu; }
#define XB_SPIN(cond, bar) do { unsigned _sp = 0; while (cond) { __builtin_amdgcn_s_sleep(1); \
    if ((++_sp & 255u) == 0u) { if (xb_ld(&(bar)[XB_TMO])) break; if (_sp > XB_SPIN_CAP) { atomicAdd(&(bar)[XB_TMO], 1u); break; } } } } while (0)
struct XcdBarrier { unsigned* bar; unsigned x; volatile LAS unsigned* st; };
__device__ __forceinline__ XcdBarrier xcd_barrier_post(unsigned* bar, volatile LAS unsigned* st) {
    XcdBarrier b; b.bar = bar; b.x = xb_xcc_id(); b.st = st;
    if (threadIdx.x == 0) (void)xb_add(&bar[XB_XCNT(b.x)], 1u);
    return b;
}
__device__ __forceinline__ void xcd_barrier_complete(unsigned* bar, unsigned x, unsigned& nloc, unsigned& nx) {
    const unsigned G = gridDim.x * gridDim.y * gridDim.z;
    unsigned sum, cnt, mine, sp = 0u;
    for (;;) {
        sum = 0u; cnt = 0u; mine = 0u;
#pragma unroll
        for (unsigned j = 0; j < 16; ++j) { const unsigned c = xb_ld(&bar[XB_XCNT(j)]); sum += c; cnt += (c > 0u) ? 1u : 0u; mine = (j == x) ? c : mine; }
        if (sum == G) break;
        __builtin_amdgcn_s_sleep(1);
        if ((++sp & 255u) == 0u) { if (xb_ld(&bar[XB_TMO])) break; if (sp > XB_SPIN_CAP) { atomicAdd(&bar[XB_TMO], 1u); break; } }
    }
    nloc = mine > 0u ? mine : 1u; nx = cnt > 0u ? cnt : 1u;
}
__device__ __forceinline__ void xcd_barrier(const XcdBarrier& b) {
    asm volatile("s_waitcnt vmcnt(0)" ::: "memory");
    __syncthreads();
    if (threadIdx.x == 0) {
        unsigned* bar = b.bar;
        __builtin_amdgcn_s_waitcnt(0);
        unsigned nloc = b.st[0], nx = b.st[1];
        if (nloc == 0u) { xcd_barrier_complete(bar, b.x, nloc, nx); b.st[0] = nloc; b.st[1] = nx; }
        const unsigned old = xb_add(&bar[XB_XSUB(b.x)], 1u);
        const unsigned gen = old / nloc;
        if (old + 1u == (gen + 1u) * nloc) {
            __builtin_amdgcn_fence(__ATOMIC_RELEASE, "agent");
            asm volatile("s_waitcnt vmcnt(0)" ::: "memory");
            const unsigned og = xb_add(&bar[XB_TOP], 1u);
            const unsigned tg = og / nx;
            if (og + 1u == (tg + 1u) * nx) xb_add(&bar[XB_TOPGEN], 1u);
            else XB_SPIN(xb_ld(&bar[XB_TOPGEN]) == tg, bar);
            __builtin_amdgcn_fence(__ATOMIC_ACQUIRE, "agent");
            xb_add(&bar[XB_XGEN(b.x)], 1u);
            asm volatile("s_waitcnt vmcnt(0)" ::: "memory");
        } else {
            XB_SPIN(xb_ld(&bar[XB_XGEN(b.x)]) == gen, bar);
            __builtin_amdgcn_fence(__ATOMIC_ACQUIRE, "agent");
            asm volatile("s_waitcnt vmcnt(0)" ::: "memory");
        }
    }
    __syncthreads();
}

constexpr int NSUB = 20, NPHASE = 1 + 4 * NSUB;

__device__ __forceinline__ void phase_rstd(const Params& p, int which) {
    const float* part = (const float*)(p.ws + O_SS) + (size_t)which * 16 * RP; float* rs = (float*)(p.ws + O_RSTD) + (size_t)which * RP;
    for (int r = blockIdx.x * 512 + ltid(); r < RP; r += gridDim.x * 512) rs[r] = rstd16(part, r);
}

__device__ __forceinline__ void phase_fold(const Params& p, const Ctx& c) {
    const int tid = ltid(); const int wave = __builtin_amdgcn_readfirstlane(tid >> 6), lane = tid & 63;
    const int gw = blockIdx.x * 8 + wave, NW = gridDim.x * 8; const int ch0 = lane * 16;
    const float* part = (const float*)(p.ws + O_SS) + (size_t)16 * RP;
    const int nrow = c.nseq * c.Tp, Th = c.T / 2;
    for (int q = gw; q < nrow; q += NW) {
        const int s = q / c.Tp, tf = q - s * c.Tp; float oc[16], os[16];
        if (tf > Th) {
#pragma unroll
            for (int i = 0; i < 16; ++i) { oc[i] = 0.f; os[i] = 0.f; }
        } else {
            const int r1 = s * c.T + tf; float a[16]; load16bf(slot(p, 0), (size_t)r1 * 1024 + ch0, a); const float rs1 = rsqrtf(wave_sum(lane < 16 ? part[(size_t)lane * RP + r1] : 0.f) * (1.f / 1024.f) + 1e-6f);
            if (tf == 0 || tf == Th) {
#pragma unroll
                for (int i = 0; i < 16; ++i) { oc[i] = a[i] * rs1; os[i] = 0.f; }
            } else {
                const int r2 = s * c.T + (c.T - tf); float b[16]; load16bf(slot(p, 0), (size_t)r2 * 1024 + ch0, b); const float rs2 = rsqrtf(wave_sum(lane < 16 ? part[(size_t)lane * RP + r2] : 0.f) * (1.f / 1024.f) + 1e-6f);
#pragma unroll
                for (int i = 0; i < 16; ++i) { const float x = a[i] * rs1, y = b[i] * rs2; oc[i] = x + y; os[i] = x - y; }
            }
        }
        store16bf(slot(p, 5), (size_t)q * 1024 + ch0, oc); store16bf(slot(p, 6), (size_t)q * 1024 + ch0, os);
    }
}

__device__ __forceinline__ void run_phase(LAS unsigned char* lds, const Params& p, int ph) {
    if (ph == 0) { prep_phase(lds, p); return; }
    const int g = (ph - 1) / NSUB, sp = (ph - 1) % NSUB; const Ctx c = get_ctx(p, g);
    GemmPh P; P.G = gridDim.x; P.c = blockIdx.x; P.A = nullptr; P.B = nullptr; P.O = nullptr; P.ss = nullptr; P.ssin = nullptr; P.ldo = 0; P.kind = -1;
    float* ssb = (float*)(p.ws + O_SS); const float* rsb = (const float*)(p.ws + O_RSTD);
    switch (sp) {
    case 1: P.kind = K_L1; P.nunits = MT * 15; P.lda = 1024; P.ldb = 1024; P.K = 1024; break;
    case 2: P.kind = K_L2; P.nunits = MT * 20; P.lda = 256; P.ldb = 256; P.K = 256; break;
    case 6: P.kind = K_RES; P.nunits = MT * 4; P.lda = 1024; P.ldb = 1024; P.K = 1024; P.A = (const char*)slot(p, 1); P.B = (const char*)p.ws + O_WO; P.O = slot(p, 0); P.ss = ssb; break;
    case 8: case 16: { const int l = sp == 8 ? 0 : 1; P.kind = K_U; P.nunits = MT * 22; P.lda = 1024; P.ldb = 1024; P.K = 1024; P.A = (const char*)slot(p, 0); P.B = (const char*)p.ws + O_WIN + (size_t)l * 5632 * 1024 * 2;
        P.O = slot(p, 1); P.ssin = rsb + (l ? 2 * RP : 0); } break;
    case 10: case 18: { const int l = sp == 10 ? 0 : 1; P.kind = K_RES; P.nunits = MT * 4; P.lda = DFF; P.ldb = DFF; P.K = DFF; P.A = (const char*)slot(p, 7); P.B = (const char*)p.ws + O_WOUT + (size_t)l * 1024 * DFF * 2;
        P.O = slot(p, 0); P.ss = l ? nullptr : ssb + 16 * RP; } break;
    case 12: P.kind = K_CH; P.nunits = (c.nseq * c.Tp / 256) * 8; P.lda = 1024; P.ldb = 1024; P.K = 256; P.A = (const char*)p.ws + O_CHD; P.B = (const char*)slot(p, 5); P.O = slot(p, 1); break;
    case 13: P.kind = K_TD; P.nunits = c.nseq * c.tm * 4; P.lda = 2 * c.Tp; P.ldb = 2 * c.Tp; P.K = 2 * c.Tp; P.A = (const char*)p.ws + (g < 2 ? O_DFTP : O_DFTS); P.B = (const char*)slot(p, 1); P.O = slot(p, 4); break;
    case 14: P.kind = K_RES; P.nunits = MT * 4; P.lda = 1024; P.ldb = 1024; P.K = 1024; P.A = (const char*)slot(p, 4); P.B = (const char*)p.ws + O_WF; P.O = slot(p, 0); P.ss = ssb + 2 * 16 * RP; break;
    default: break;
    }
    if (P.kind >= 0) {
        switch (P.kind) {
        case K_L1: gemm_phase<K_L1>(lds, P, p, c); break;
        case K_L2: gemm_phase<K_L2>(lds, P, p, c); break;
        case K_RES: gemm_phase<K_RES>(lds, P, p, c); break;
        case K_U: gemm_phase<K_U>(lds, P, p, c); break;
        case K_CH: gemm_phase<K_CH>(lds, P, p, c); break;
        default: gemm_phase<K_TD>(lds, P, p, c); break;
        }
        if (sp == 13) {
            const int tid = ltid(); const int wave = __builtin_amdgcn_readfirstlane(tid >> 6), lane = tid & 63; const int K2 = 2 * c.Tp;
            const bf16_t* drow = (const bf16_t*)P.A + (size_t)(NMETA - 1) * K2; const bf16_t* yT = (const bf16_t*)slot(p, 1); bf16_t* F = (bf16_t*)slot(p, 4);
            for (int it = blockIdx.x * 8 + wave; it < c.nseq * 1024; it += gridDim.x * 8) {
                const int s = it >> 10, ch = it & 1023; const bf16_t* yr = yT + ((size_t)s * 1024 + ch) * K2; float acc = 0.f;
                for (int kk = lane * 2; kk < K2; kk += 128) { const unsigned a = *(const unsigned*)(drow + kk), b = *(const unsigned*)(yr + kk); acc += bflo(a) * bflo(b) + bfhi(a) * bfhi(b); }
                acc = wave_sum(acc);
                if (lane == 0) F[((size_t)s * c.T + (NMETA - 1)) * 1024 + ch] = (bf16_t)(pk2(acc, 0.f) & 0xffffu);
            }
        }
        return;
    }
    if (sp == 0) phase_mix(p, c);
    else if (sp == 3) phase_prescan(p, c);
    else if (sp == 4) phase_scan(lds, p, c);
    else if (sp == 5) phase_postscan(p, c);
    else if (sp == 11) phase_fold(p, c);
    else if (sp == 7 || sp == 15) phase_rstd(p, sp == 7 ? 0 : 2);
    else if (sp == 9 || sp == 17) phase_glu(p, c, sp == 9 ? 0 : 1);
    else phase_final(p, c);
}

__global__ void __launch_bounds__(512, 2) mega(Params p, int ph_lo, int ph_hi) {
    extern __shared__ __attribute__((aligned(16))) unsigned char shm[];
    LAS unsigned char* lds = (LAS unsigned char*)shm;
    cg::grid_group grid = cg::this_grid();
    volatile LAS unsigned* st = (volatile LAS unsigned*)(lds + STAGE_BYTES);
    if (threadIdx.x == 0) { st[0] = 0u; st[1] = 0u; }
    __syncthreads();
    const XcdBarrier xb = xcd_barrier_post((unsigned*)(p.ws + O_BAR), st);
    for (int ph = ph_lo; ph < ph_hi; ++ph) {
        if (ph_hi < 0) grid.sync();
        if (ph > ph_lo) xcd_barrier(xb);
        run_phase(lds, p, ph);
    }
}

extern "C" void kernel_launch(void* const* d_in, const int* in_sizes, int n_in, void* d_out, int out_size, void* d_ws, size_t ws_size, hipStream_t stream) {
    static int grid = 0;
    if (grid == 0) {
        if (n_in != 27 || ws_size < WS_END) { fprintf(stderr, "kernel_launch: need 27 inputs and %zu B of workspace (got %d, %zu)\n", (size_t)WS_END, n_in, ws_size); grid = -1; return; }
        int dev = 0, cus = 0, per_cu = 0;
        hipGetDevice(&dev); hipDeviceGetAttribute(&cus, hipDeviceAttributeMultiprocessorCount, dev);
        if (hipFuncSetAttribute((const void*)mega, hipFuncAttributeMaxDynamicSharedMemorySize, STAGE_BYTES + 16) != hipSuccess) { fprintf(stderr, "hipFuncSetAttribute failed\n"); grid = -1; return; }
        hipOccupancyMaxActiveBlocksPerMultiprocessor(&per_cu, (const void*)mega, 512, STAGE_BYTES + 16);
        if (per_cu < 1) per_cu = 1;
        (void)hipGetLastError();
        grid = cus * 1;
    }
    if (grid < 0) return;
    Params p{};
    for (int i = 0; i < 27; ++i) p.in[i] = (const float*)d_in[i];
    p.out = (float*)d_out; p.ws = (unsigned char*)d_ws;
#if MK_PER_PHASE
    for (int ph = 0; ph < NPHASE; ++ph) hipLaunchKernelGGL(mega, dim3(grid), dim3(512), STAGE_BYTES + 16, stream, p, ph, ph + 1);
#else
    (void)hipMemsetAsync((unsigned char*)d_ws + O_BAR, 0, 16384, stream);
    int lo = 0, hi = NPHASE;
    void* args[] = {&p, &lo, &hi};
    hipError_t e = hipLaunchCooperativeKernel((const void*)mega, dim3(grid), dim3(512), args, STAGE_BYTES + 16, stream);
    if (e != hipSuccess) fprintf(stderr, "cooperative launch failed: %s (grid %d)\n", hipGetErrorString(e), grid);
#endif
}
```

```cpp
#include <hip/hip_runtime.h>
#include <hip/hip_cooperative_groups.h>
#include <cstdio>
namespace cg = cooperative_groups;

#ifndef MK_PER_PHASE
#define MK_PER_PHASE 0
#endif

#define LAS __attribute__((address_space(3)))
typedef unsigned short bf16_t;
typedef short bf16x8 __attribute__((ext_vector_type(8)));
typedef float f32x4 __attribute__((ext_vector_type(4)));
typedef unsigned u32x4 __attribute__((ext_vector_type(4)));
typedef unsigned u32x2 __attribute__((ext_vector_type(2)));
typedef float f32x2 __attribute__((ext_vector_type(2)));
typedef const __attribute__((address_space(4))) unsigned* cptr;

constexpr int D = 1024, DFF = 2816, NMETA = 16;
constexpr int RP = 33024;
constexpr int MT = RP / 256;
constexpr size_t SLOT = (size_t)RP * D * 2;
constexpr int NSLOT = 13;
constexpr size_t O_WRKV = NSLOT * SLOT;
constexpr size_t O_G1 = O_WRKV + (size_t)3072 * 1024 * 2;
constexpr size_t O_W1 = O_G1 + (size_t)256 * 1024 * 2;
constexpr size_t O_A1 = O_W1 + (size_t)256 * 1024 * 2;
constexpr size_t O_L2 = O_A1 + (size_t)256 * 1024 * 2;
constexpr size_t O_G2 = O_L2 + (size_t)4096 * 256 * 2;
constexpr size_t O_WO = O_G2 + (size_t)1024 * 256 * 2;
constexpr size_t O_WF = O_WO + (size_t)1024 * 1024 * 2;
constexpr size_t O_WIN = O_WF + (size_t)1024 * 1024 * 2;
constexpr size_t O_WOUT = O_WIN + (size_t)2 * 5632 * 1024 * 2;
constexpr size_t O_CHD = O_WOUT + (size_t)2 * 1024 * 2816 * 2;
constexpr int TP_P = 1088, TP_S = 2112, MP_P = 2304, MP_S = 4352;
constexpr size_t O_DFTP = O_CHD + (size_t)2048 * 1024 * 2;
constexpr size_t O_DFTS = O_DFTP + (size_t)MP_P * 2 * TP_P * 2;
constexpr size_t O_SS = O_DFTS + (size_t)MP_S * 2 * TP_S * 2;
constexpr size_t O_RSTD = O_SS + (size_t)3 * 16 * RP * 4;
constexpr size_t O_BONUS = O_RSTD + (size_t)3 * RP * 4;
constexpr size_t O_BAR = O_BONUS + (size_t)RP * 16 * 4;
constexpr size_t WS_END = O_BAR + 16384;

struct Params { const float* in[27]; float* out; unsigned char* ws; };
struct Ctx { int g, T, nseq, R, Tp, tm; const float* x; float* y; };

__device__ __forceinline__ Ctx get_ctx(const Params& p, int g) {
    Ctx c; c.g = g;
    if (g < 2) { c.T = 2064; c.nseq = 16; c.Tp = TP_P; c.tm = 8; c.x = p.in[0] + (size_t)g * 16 * 2048 * 1024; c.y = p.out + (size_t)g * 16 * 2048 * 1024; }
    else { c.T = 4112; c.nseq = 8; c.Tp = TP_S; c.tm = 16; c.x = p.in[1] + (size_t)(g - 2) * 8 * 4096 * 1024; c.y = p.out + (size_t)32 * 2048 * 1024 + (size_t)(g - 2) * 8 * 4096 * 1024; }
    c.R = c.nseq * c.T; return c;
}
__device__ __forceinline__ int ltid() { int t = threadIdx.x; asm volatile("" : "+v"(t)); return t; }
__device__ __forceinline__ unsigned char* slot(const Params& p, int i) { return p.ws + (size_t)i * SLOT; }

__device__ __forceinline__ unsigned pk2(float lo, float hi) { unsigned r; asm volatile("v_cvt_pk_bf16_f32 %0, %1, %2" : "=v"(r) : "v"(lo), "v"(hi)); return r; }
__device__ __forceinline__ float bflo(unsigned u) { return __uint_as_float(u << 16); }
__device__ __forceinline__ float bfhi(unsigned u) { return __uint_as_float(u & 0xffff0000u); }
__device__ __forceinline__ float wave_sum(float v) {
#pragma unroll
    for (int o = 1; o < 64; o <<= 1) v += __shfl_xor(v, o);
    return v;
}
__device__ __forceinline__ float sigmoidf_(float x) { return __builtin_amdgcn_rcpf(1.f + __expf(-x)); }
__device__ __forceinline__ void unpack16(const u32x4 a, const u32x4 b, float (&v)[16]) {
#pragma unroll
    for (int i = 0; i < 4; ++i) { v[2 * i] = bflo(a[i]); v[2 * i + 1] = bfhi(a[i]); v[8 + 2 * i] = bflo(b[i]); v[8 + 2 * i + 1] = bfhi(b[i]); }
}
__device__ __forceinline__ void load16bf(const unsigned char* base, size_t elem, float (&v)[16]) {
    const u32x4* q = (const u32x4*)(base + elem * 2); unpack16(q[0], q[1], v);
}
__device__ __forceinline__ void store16bf(unsigned char* base, size_t elem, const float (&v)[16]) {
    u32x4 a, b;
#pragma unroll
    for (int i = 0; i < 4; ++i) { a[i] = pk2(v[2 * i], v[2 * i + 1]); b[i] = pk2(v[8 + 2 * i], v[8 + 2 * i + 1]); }
    u32x4* q = (u32x4*)(base + elem * 2); q[0] = a; q[1] = b;
}
__device__ __forceinline__ void load16f(const float* src, float (&v)[16]) {
#pragma unroll
    for (int j = 0; j < 4; ++j) { f32x4 t = ((const f32x4*)src)[j]; v[4 * j] = t[0]; v[4 * j + 1] = t[1]; v[4 * j + 2] = t[2]; v[4 * j + 3] = t[3]; }
}

constexpr int BM = 256, BK = 64, HALF = 128, HTB = HALF * BK * 2, STAGE_BYTES = 8 * HTB;
__device__ __forceinline__ int lds_byte(int r, int c) { const int st = (r >> 4) * 2 + (c >> 5), rr = r & 15, cc = c & 31, ob = rr * 64 + cc * 2; return st * 1024 + (ob ^ (((ob >> 9) & 1) << 5)); }
__device__ __forceinline__ void stage_rc(int b, int& R, int& C) { const int st = b / 1024, sb = b % 1024, swz = sb ^ (((sb >> 9) & 1) << 5); R = (st >> 1) * 16 + swz / 64; C = (st & 1) * 32 + (swz % 64) / 2; }
__device__ __forceinline__ int perm32(int rho) { const int n = rho >> 4, i = rho & 15; return 8 * (i >> 2) + 4 * n + (i & 3); }

enum { K_L1 = 0, K_L2, K_RES, K_U, K_CH, K_TD };
struct Unit { const char* A; const char* B; int pm, pn, job, s; };
struct GemmPh {
    int kind, nunits, lda, ldb, K, G, c;
    const char* A; const char* B;
    unsigned char* O; float* ss; const float* ssin; int ldo;
};

__device__ __forceinline__ void xcd_order(int L, int nM, int nN, int& pm, int& pn) {
    const int nwg = nM * nN; int wgid = L; { const int q = nwg / 8, r = nwg % 8, xcd = wgid % 8, off = wgid / 8; wgid = (xcd < r ? xcd * (q + 1) : r * (q + 1) + (xcd - r) * q) + off; }
    const int nig = 8 * nN, gid = wgid / nig, fm = gid * 8, gsz = (nM - fm) < 8 ? (nM - fm) : 8;
    pm = fm + ((wgid % nig) % gsz); pn = (wgid % nig) / gsz;
}
__device__ __forceinline__ bool next_unit(const GemmPh& P, const Params& p, const Ctx& cx, int i, Unit& u) {
    const long Lg = (long)i * P.G + P.c; if (Lg >= P.nunits) return false;
    const int L = (int)Lg; u.s = 0; u.job = 0;
    if (P.kind == K_L1) {
        int pm, jn; xcd_order(L, MT, 15, pm, jn); int job, pn;
        if (jn < 12) { job = jn >> 2; pn = jn & 3; } else { job = 3 + (jn - 12); pn = 0; }
        const int aslot = job == 0 ? 1 : job == 1 ? 3 : job == 2 ? 4 : job == 3 ? 6 : job == 4 ? 2 : 5;
        u.A = (const char*)slot(p, aslot) + (size_t)pm * 256 * 2048;
        const size_t boff = job < 3 ? O_WRKV + ((size_t)job * 1024 + pn * 256) * 2048 : job == 3 ? O_G1 : job == 4 ? O_W1 : O_A1;
        u.B = (const char*)p.ws + boff; u.pm = pm; u.pn = pn; u.job = job;
    } else if (P.kind == K_L2) {
        int pm, jn; xcd_order(L, MT, 20, pm, jn); const int job = jn < 16 ? 0 : 1, pn = jn < 16 ? jn : jn - 16;
        u.A = (const char*)slot(p, 10) + (job == 0 ? (size_t)RP * 512 : 0) + (size_t)pm * 256 * 512;
        u.B = (const char*)p.ws + (job == 0 ? O_L2 : O_G2) + (size_t)pn * 256 * 512; u.pm = pm; u.pn = pn; u.job = job;
    } else if (P.kind == K_RES) {
        int pm, pn; xcd_order(L, MT, 4, pm, pn);
        u.A = P.A + (size_t)pm * 256 * P.lda * 2; u.B = P.B + (size_t)pn * 256 * P.ldb * 2; u.pm = pm; u.pn = pn;
    } else if (P.kind == K_U) {
        int pm, pn; xcd_order(L, MT, 22, pm, pn);
        u.A = P.A + (size_t)pm * 256 * 2048; u.B = P.B + (size_t)pn * 256 * 2048; u.pm = pm; u.pn = pn;
    } else if (P.kind == K_CH) {
        int pn, pm; xcd_order(L, P.nunits >> 3, 8, pn, pm);
        u.A = P.A + (size_t)pm * 256 * 2048 + (pm & 3) * 512; u.B = (const char*)slot(p, pm < 4 ? 5 : 6) + (size_t)pn * 256 * 2048 + (pm & 3) * 512; u.pm = pm; u.pn = pn;
    } else {
        int rt, pn; xcd_order(L, cx.nseq * cx.tm, 4, rt, pn); const int s = rt / cx.tm, pm = rt % cx.tm;
        u.A = P.A + (size_t)(NMETA + pm * 256) * P.lda * 2; u.B = P.B + ((size_t)s * 1024 + pn * 256) * P.ldb * 2; u.pm = pm; u.pn = pn; u.s = s;
    }
    return true;
}

__device__ __forceinline__ void st8(unsigned char* ptr, const f32x4 a, const f32x4 b) {
    u32x4 o; o[0] = pk2(a[0], a[1]); o[1] = pk2(a[2], a[3]); o[2] = pk2(b[0], b[1]); o[3] = pk2(b[2], b[3]); *(u32x4*)ptr = o;
}
__device__ __forceinline__ float decaymap(float w) {
    const float e = 0.6065306597f * __builtin_amdgcn_rcpf(1.f + __expf(-w)); return __expf(-e) - 1.f;
}
__device__ __forceinline__ float act_apply(int act, float x) {
    if (act == 1) return __builtin_amdgcn_rcpf(1.f + __expf(-x));
    if (act == 2) return 1.f - 2.f * __builtin_amdgcn_rcpf(__expf(2.f * x) + 1.f);
    if (act == 3) return decaymap(x);
    return x;
}

__device__ __forceinline__ float rstd16(const float* ss, int r) {
    float s = 0.f;
#pragma unroll
    for (int i = 0; i < 16; ++i) s += ss[(size_t)i * RP + r];
    return rsqrtf(s * (1.f / 1024.f) + 1e-6f);
}
__device__ __forceinline__ void epilogue(const GemmPh& P, const Params& p, const Ctx& cx, const f32x4 (&acc)[2][2][4][2], const Unit& u, int wr, int wc, int fr, int fq) {
    const int rbase = u.pm * 256 + wr * 64 + fr, cbase = u.pn * 256 + wc * 32 + 8 * fq;
    if (P.kind == K_L1 || P.kind == K_L2) {
        unsigned char* O; int ldo = 1024, coff = 0, act = 0, cvalid = 1 << 30; const float* bias = nullptr;
        if (P.kind == K_L1) {
            if (u.job < 3) { O = slot(p, 7 + u.job); }
            else if (u.job == 3) { O = slot(p, 10); ldo = 256; act = 1; }
            else if (u.job == 4) { O = slot(p, 10) + (size_t)RP * 512; ldo = 256; act = 2; cvalid = 128; }
            else { O = slot(p, 10) + (size_t)RP * 512; ldo = 256; coff = 128; cvalid = 128; }
        } else {
            if (u.job == 1) { O = slot(p, 5); }
            else { const int cb = u.pn >> 2; O = slot(p, 1 + cb); bias = (cb < 2 ? p.in[8] : p.in[11]) + (cb & 1) * 1024 - cb * 1024; coff = -cb * 1024; act = cb < 2 ? 3 : 1; }
        }
        f32x4 bv[2][2];
#pragma unroll
        for (int bj = 0; bj < 2; ++bj)
#pragma unroll
            for (int n = 0; n < 2; ++n) bv[bj][n] = bias ? *(const f32x4*)(bias + cbase + bj * 128 + 4 * n) : (f32x4){0.f, 0.f, 0.f, 0.f};
#pragma unroll
        for (int ai = 0; ai < 2; ++ai)
#pragma unroll
            for (int m = 0; m < 4; ++m) { if ((m & 1) == 0) __builtin_amdgcn_sched_barrier(0);
#pragma unroll
                for (int bj = 0; bj < 2; ++bj) { const int r = rbase + ai * 128 + m * 16; const int c0 = cbase + bj * 128;
                    f32x4 v0 = acc[ai][bj][m][0] + bv[bj][0], v1 = acc[ai][bj][m][1] + bv[bj][1];
#pragma unroll
                    for (int i = 0; i < 4; ++i) { v0[i] = act_apply(act, v0[i]); v1[i] = act_apply(act, v1[i]); }
                    if (c0 < cvalid) st8(O + ((size_t)r * ldo + coff + c0) * 2, v0, v1); } }
    } else if (P.kind == K_RES) {
        unsigned char* H = P.O;
        u32x4 oldall[2][4][2];
#pragma unroll
        for (int ai = 0; ai < 2; ++ai)
#pragma unroll
            for (int m = 0; m < 4; ++m)
#pragma unroll
                for (int bj = 0; bj < 2; ++bj) oldall[ai][m][bj] = *(const u32x4*)(H + ((size_t)(rbase + ai * 128 + m * 16) * 1024 + cbase + bj * 128) * 2);
        __builtin_amdgcn_sched_barrier(0);
#pragma unroll
        for (int ai = 0; ai < 2; ++ai) {
#pragma unroll
            for (int m = 0; m < 4; ++m) { const int r = rbase + ai * 128 + m * 16; float sq = 0.f;
#pragma unroll
                for (int bj = 0; bj < 2; ++bj) { unsigned char* ptr = H + ((size_t)r * 1024 + cbase + bj * 128) * 2;
                    const u32x4 old = oldall[ai][m][bj]; u32x4 o; const f32x4 a0 = acc[ai][bj][m][0], a1 = acc[ai][bj][m][1];
                    o[0] = pk2(bflo(old[0]) + a0[0], bfhi(old[0]) + a0[1]); o[1] = pk2(bflo(old[1]) + a0[2], bfhi(old[1]) + a0[3]);
                    o[2] = pk2(bflo(old[2]) + a1[0], bfhi(old[2]) + a1[1]); o[3] = pk2(bflo(old[3]) + a1[2], bfhi(old[3]) + a1[3]);
#pragma unroll
                    for (int i = 0; i < 4; ++i) { const float rl = bflo(o[i]), rh = bfhi(o[i]); sq += rl * rl + rh * rh; }
                    *(u32x4*)ptr = o; }
                if (P.ss) { sq += __shfl_xor(sq, 16); sq += __shfl_xor(sq, 32); if (fq == 0) P.ss[(size_t)(u.pn * 4 + wc) * RP + r] = sq; } }
            __builtin_amdgcn_sched_barrier(0);
        }
    } else if (P.kind == K_U) {
        float rsv[2][4];
#pragma unroll
        for (int ai = 0; ai < 2; ++ai)
#pragma unroll
            for (int m = 0; m < 4; ++m) rsv[ai][m] = P.ssin[rbase + ai * 128 + m * 16];
        __builtin_amdgcn_sched_barrier(0);
#pragma unroll
        for (int ai = 0; ai < 2; ++ai)
#pragma unroll
            for (int m = 0; m < 4; ++m) { if ((m & 1) == 0) __builtin_amdgcn_sched_barrier(0); const int r = rbase + ai * 128 + m * 16; const float rs = rsv[ai][m];
#pragma unroll
                for (int bj = 0; bj < 2; ++bj) st8(P.O + ((size_t)r * 5632 + cbase + bj * 128) * 2, acc[ai][bj][m][0] * rs, acc[ai][bj][m][1] * rs); }
    } else if (P.kind == K_CH) {
#pragma unroll
        for (int bj = 0; bj < 2; ++bj) { const int n0 = cbase + bj * 128; const int s = n0 / cx.Tp, t = n0 - s * cx.Tp;
#pragma unroll
            for (int ai = 0; ai < 2; ++ai)
#pragma unroll
                for (int m = 0; m < 4; ++m) { if ((m & 1) == 0) __builtin_amdgcn_sched_barrier(0); const int rr = rbase + ai * 128 + m * 16; const int cs = rr >> 10, ch = rr & 1023;
                    st8(P.O + ((((size_t)s * 1024 + ch) * 2 + cs) * cx.Tp + t) * 2, acc[ai][bj][m][0], acc[ai][bj][m][1]); } }
    } else {
#pragma unroll
        for (int ai = 0; ai < 2; ++ai)
#pragma unroll
            for (int m = 0; m < 4; ++m) { if ((m & 1) == 0) __builtin_amdgcn_sched_barrier(0); const int k = NMETA + rbase + ai * 128 + m * 16; const size_t row = (size_t)u.s * cx.T + k;
#pragma unroll
                for (int bj = 0; bj < 2; ++bj) if (k < cx.T) st8(P.O + (row * 1024 + cbase + bj * 128) * 2, acc[ai][bj][m][0], acc[ai][bj][m][1]); }
    }
}

template <int KIND> __device__ __forceinline__ void gemm_phase(LAS unsigned char* lds, GemmPh P, const Params& p, const Ctx& cx) {
    P.kind = KIND;
    const int tid = ltid(), wid = __builtin_amdgcn_readfirstlane(tid >> 6), lane = tid & 63, wr = wid >> 2, wc = wid & 3, fr = lane & 15, fq = lane >> 4;
    const int nt = P.K / BK;
    unsigned voffA[2], voffB[2];
#pragma unroll
    for (int i = 0; i < 2; ++i) { int R, C; stage_rc(tid * 16 + i * 8192, R, C); const int Rb = (R & ~31) + perm32(R & 31);
        voffA[i] = (unsigned)(R * P.lda + C) * 2u; voffB[i] = (unsigned)(Rb * P.ldb + C) * 2u; }
    const size_t kstep = (size_t)(BK * 2);
    const size_t hstepA = (size_t)HALF * P.lda * 2, hstepB = (size_t)HALF * P.ldb * 2;
    const unsigned ldsw = (unsigned)wid * 1024u;
    const int aoff = lds_byte(wr * 64 + fr, fq * 8), boff = lds_byte(wc * 32 + fr, fq * 8);
#define PG8_SA(b, h) (((b) * 2 + (h)) * HTB)
#define PG8_SB(b, h) ((4 + (b) * 2 + (h)) * HTB)
#define PG8_STAGE(bufoff, gbase, voff) do { _Pragma("unroll") for (int _i = 0; _i < 2; ++_i) \
        __builtin_amdgcn_global_load_lds((const unsigned*)((const char*)(gbase) + (voff)[_i]), (LAS unsigned*)(lds + (bufoff) + ldsw + _i * 8192), 16, 0, 0); } while (0)
#define PG8_LDA(dst, b, h) do { _Pragma("unroll") for (int m = 0; m < 4; ++m) _Pragma("unroll") for (int k = 0; k < 2; ++k) dst[m][k] = *(const LAS bf16x8*)(lds + PG8_SA(b, h) + aoff + m * 2048 + k * 1024); } while (0)
#define PG8_LDB(dst, b, h) do { _Pragma("unroll") for (int n = 0; n < 2; ++n) _Pragma("unroll") for (int k = 0; k < 2; ++k) dst[n][k] = *(const LAS bf16x8*)(lds + PG8_SB(b, h) + boff + n * 2048 + k * 1024); } while (0)
#define PG8_MMA(ai, bj, At, Bt) do { __builtin_amdgcn_s_setprio(1); _Pragma("unroll") for (int m = 0; m < 4; ++m) _Pragma("unroll") for (int n = 0; n < 2; ++n) _Pragma("unroll") for (int k = 0; k < 2; ++k) \
        acc[ai][bj][m][n] = __builtin_amdgcn_mfma_f32_16x16x32_bf16(Bt[n][k], At[m][k], acc[ai][bj][m][n], 0, 0, 0); __builtin_amdgcn_s_setprio(0); } while (0)
#define PG8_WAIT_V(n) asm volatile("s_waitcnt vmcnt(" #n ")" ::: "memory")
#define PG8_WAIT_L(n) asm volatile("s_waitcnt lgkmcnt(" #n ")" ::: "memory")
#define PG8_BAR __builtin_amdgcn_s_barrier()
#define PG8_SCHED __builtin_amdgcn_sched_barrier(0)
    Unit cur, nxt; int ui = 0;
    if (!next_unit(P, p, cx, 0, cur)) return;
    f32x4 acc[2][2][4][2];
#pragma unroll
    for (int a = 0; a < 2; ++a)
#pragma unroll
        for (int b = 0; b < 2; ++b)
#pragma unroll
            for (int m = 0; m < 4; ++m)
#pragma unroll
                for (int n = 0; n < 2; ++n) acc[a][b][m][n] = (f32x4){0.f, 0.f, 0.f, 0.f};
    bf16x8 At[4][2], B0[2][2], B1[2][2];
    const char* cA = cur.A; const char* cB = cur.B;
    PG8_STAGE(PG8_SB(0, 0), cB, voffB); PG8_STAGE(PG8_SA(0, 0), cA, voffA); PG8_STAGE(PG8_SB(0, 1), cB + hstepB, voffB); PG8_STAGE(PG8_SA(0, 1), cA + hstepA, voffA);
    if (wr == 1) PG8_BAR;
    PG8_WAIT_V(4); PG8_BAR;
    PG8_STAGE(PG8_SB(1, 0), cB + kstep, voffB); PG8_STAGE(PG8_SA(1, 0), cA + kstep, voffA); PG8_STAGE(PG8_SB(1, 1), cB + hstepB + kstep, voffB);
    PG8_WAIT_V(6); PG8_BAR;
    for (;;) {
        const bool has_next = next_unit(P, p, cx, ui + 1, nxt);
        const char* nA = has_next ? nxt.A : cA; const char* nB = has_next ? nxt.B : cB;
        for (int t = 0; t < nt; t += 2) {
            const bool last = (t == nt - 2);
            const char* a1 = cA + (size_t)(t + 1) * kstep;
            const char* a2 = last ? nA : cA + (size_t)(t + 2) * kstep; const char* b2 = last ? nB : cB + (size_t)(t + 2) * kstep;
            const char* a3 = a2 + kstep; const char* b3 = b2 + kstep;
            PG8_LDB(B0, 0, 0); PG8_SCHED; PG8_LDA(At, 0, 0); PG8_STAGE(PG8_SA(1, 1), a1 + hstepA, voffA);
            PG8_WAIT_L(8); PG8_BAR; PG8_WAIT_L(0); PG8_MMA(0, 0, At, B0); PG8_BAR; PG8_SCHED;
            PG8_LDB(B1, 0, 1); PG8_STAGE(PG8_SB(0, 0), b2, voffB);
            PG8_BAR; PG8_WAIT_L(0); PG8_MMA(0, 1, At, B1); PG8_BAR;
            PG8_LDA(At, 0, 1); PG8_STAGE(PG8_SA(0, 0), a2, voffA);
            PG8_BAR; PG8_WAIT_L(0); PG8_MMA(1, 0, At, B0); PG8_BAR; PG8_SCHED;
            PG8_STAGE(PG8_SB(0, 1), b2 + hstepB, voffB);
            PG8_WAIT_V(6); PG8_BAR; PG8_MMA(1, 1, At, B1); PG8_BAR;
            PG8_LDB(B0, 1, 0); PG8_SCHED; PG8_LDA(At, 1, 0); PG8_STAGE(PG8_SA(0, 1), a2 + hstepA, voffA);
            PG8_WAIT_L(8); PG8_BAR; PG8_WAIT_L(0); PG8_MMA(0, 0, At, B0); PG8_BAR; PG8_SCHED;
            PG8_LDB(B1, 1, 1); PG8_STAGE(PG8_SB(1, 0), b3, voffB);
            PG8_BAR; PG8_WAIT_L(0); PG8_MMA(0, 1, At, B1); PG8_BAR;
            PG8_LDA(At, 1, 1); PG8_STAGE(PG8_SA(1, 0), a3, voffA);
            PG8_BAR; PG8_WAIT_L(0); PG8_MMA(1, 0, At, B0); PG8_BAR; PG8_SCHED;
            PG8_STAGE(PG8_SB(1, 1), b3 + hstepB, voffB);
            PG8_WAIT_V(6); PG8_BAR; PG8_MMA(1, 1, At, B1); PG8_BAR;
        }
        epilogue(P, p, cx, acc, cur, wr, wc, fr, fq);
        if (!has_next) break;
#pragma unroll
        for (int a = 0; a < 2; ++a)
#pragma unroll
            for (int b = 0; b < 2; ++b)
#pragma unroll
                for (int m = 0; m < 4; ++m)
#pragma unroll
                    for (int n = 0; n < 2; ++n) acc[a][b][m][n] = (f32x4){0.f, 0.f, 0.f, 0.f};
        cur = nxt; cA = nA; cB = nB; ++ui;
    }
    PG8_WAIT_V(0);
    if (wr == 0) PG8_BAR;
    PG8_BAR;
#undef PG8_SA
#undef PG8_SB
#undef PG8_STAGE
#undef PG8_LDA
#undef PG8_LDB
#undef PG8_MMA
#undef PG8_WAIT_V
#undef PG8_WAIT_L
#undef PG8_BAR
#undef PG8_SCHED
}

__device__ __forceinline__ void tr_job(LAS float* tile, const float* src, int K, int N, unsigned char* dst, int ldk, int koff, int Kpad, int Npad, const float* scale, int& cnt, int stride_start, int G) {
    const int tk = Kpad / 64, tn = Npad / 64, ntile = tk * tn; const int tid = ltid();
    for (int it = 0; it < ntile; ++it, ++cnt) {
        if ((cnt % G) != stride_start) continue;
        const int k0 = (it / tn) * 64, n0 = (it % tn) * 64;
        __syncthreads();
        { const int tx = tid & 63, ty = tid >> 6;
#pragma unroll
            for (int i = 0; i < 8; ++i) { const int kd = k0 + ty + 8 * i, ks = kd - koff, n = n0 + tx; float v = 0.f;
                if (ks >= 0 && ks < K && n < N) { v = src[(size_t)ks * N + n]; if (scale) v *= scale[ks]; }
                tile[(ty + 8 * i) * 65 + tx] = v; } }
        __syncthreads();
        { const int n = tid >> 3, kc = (tid & 7) * 8; u32x4 o;
#pragma unroll
            for (int i = 0; i < 4; ++i) o[i] = pk2(tile[(kc + 2 * i) * 65 + n], tile[(kc + 2 * i + 1) * 65 + n]);
            *(u32x4*)(dst + ((size_t)(n0 + n) * ldk + k0 + kc) * 2) = o; }
    }
}

__device__ __forceinline__ void prep_phase(LAS unsigned char* lds, const Params& p) {
    LAS float* tile = (LAS float*)lds; unsigned char* ws = p.ws; int cnt = 0; const int b = blockIdx.x, G = gridDim.x;
    for (int i = 0; i < 3; ++i) tr_job(tile, p.in[7] + (size_t)i * D * D, D, D, ws + O_WRKV + (size_t)i * D * D * 2, 1024, 0, 1024, 1024, nullptr, cnt, b, G);
    tr_job(tile, p.in[14], D, 160, ws + O_G1, 1024, 0, 1024, 256, nullptr, cnt, b, G);
    tr_job(tile, p.in[9], D, 64, ws + O_W1, 1024, 0, 1024, 64, nullptr, cnt, b, G);
    tr_job(tile, p.in[9] + D * 64, D, 64, ws + O_W1 + (size_t)64 * 1024 * 2, 1024, 0, 1024, 192, nullptr, cnt, b, G);
    tr_job(tile, p.in[12], D, 64, ws + O_A1, 1024, 0, 1024, 64, nullptr, cnt, b, G);
    tr_job(tile, p.in[12] + D * 64, D, 64, ws + O_A1 + (size_t)64 * 1024 * 2, 1024, 0, 1024, 192, nullptr, cnt, b, G);
    for (int z = 0; z < 2; ++z) {
        tr_job(tile, p.in[10] + (size_t)z * 64 * D, 64, D, ws + O_L2 + (size_t)z * 1024 * 256 * 2, 256, z * 64, 256, 1024, nullptr, cnt, b, G);
        tr_job(tile, p.in[13] + (size_t)z * 64 * D, 64, D, ws + O_L2 + (size_t)(2 + z) * 1024 * 256 * 2, 256, (2 + z) * 64, 256, 1024, nullptr, cnt, b, G);
    }
    tr_job(tile, p.in[15], 160, D, ws + O_G2, 256, 0, 256, 1024, nullptr, cnt, b, G);
    tr_job(tile, p.in[21], D, D, ws + O_WO, 1024, 0, 1024, 1024, nullptr, cnt, b, G);
    tr_job(tile, p.in[22], D, D, ws + O_WF, 1024, 0, 1024, 1024, nullptr, cnt, b, G);
    for (int l = 0; l < 2; ++l) {
        tr_job(tile, p.in[23] + (size_t)l * D * 5632, D, 5632, ws + O_WIN + (size_t)l * 5632 * 1024 * 2, 1024, 0, 1024, 5632, p.in[4] + l * D, cnt, b, G);
        tr_job(tile, p.in[26] + (size_t)l * DFF * D, DFF, D, ws + O_WOUT + (size_t)l * 1024 * DFF * 2, DFF, 0, DFF, 1024, nullptr, cnt, b, G);
    }
    const size_t gt = (size_t)blockIdx.x * 512 + ltid(), NT = (size_t)gridDim.x * 512;
    const float* nm1 = p.in[3] + D;
    for (size_t e = gt; e < (size_t)2048 * 128; e += NT) {
        const int rr = (int)(e >> 7), c0 = (int)(e & 127) * 8; const int cs = rr >> 10, ch = rr & 1023; float v[8];
#pragma unroll
        for (int i = 0; i < 8; ++i) { const int c = c0 + i; float val = 0.f;
            if ((c >> 7) == (ch >> 7)) { const int m = ((ch & 127) * (c & 127)) & 127; float sn, cn; sincospif((float)m * (1.f / 64.f), &sn, &cn); val = (cs ? sn : cn) * nm1[c] * 0.08838834764831845f; }
            v[i] = val; }
        u32x4 o; o[0] = pk2(v[0], v[1]); o[1] = pk2(v[2], v[3]); o[2] = pk2(v[4], v[5]); o[3] = pk2(v[6], v[7]);
        *(u32x4*)(ws + O_CHD + e * 16) = o;
    }
    for (int ty = 0; ty < 2; ++ty) {
        const int T = ty ? 4112 : 2064, Tp = ty ? TP_S : TP_P, Mp = ty ? MP_S : MP_P; const int rowv = 2 * Tp / 8;
        unsigned char* dst = ws + (ty ? O_DFTS : O_DFTP); const float isq = rsqrtf((float)T), invT = 2.f / (float)T;
        for (size_t e = gt; e < (size_t)Mp * rowv; e += NT) {
            const int k = (int)(e / rowv), kk0 = (int)(e % rowv) * 8; float v[8];
#pragma unroll
            for (int i = 0; i < 8; ++i) { const int kk = kk0 + i; const int issin = kk >= Tp, t = issin ? kk - Tp : kk; float val = 0.f;
                if (k < T && (issin ? (t >= 1 && t <= T / 2 - 1) : (t <= T / 2))) { const int m = (int)(((long)k * t) % T); float sn, cn; sincospif((float)m * invT, &sn, &cn); val = (issin ? -sn : cn) * isq; }
                v[i] = val; }
            u32x4 o; o[0] = pk2(v[0], v[1]); o[1] = pk2(v[2], v[3]); o[2] = pk2(v[4], v[5]); o[3] = pk2(v[6], v[7]);
            *(u32x4*)(dst + e * 16) = o;
        }
    }
}

__device__ __forceinline__ void ea_load_row(const Params& p, const Ctx& c, int s, int pos, int lane, float (&v)[16]) {
    if (pos < 0 || pos >= c.T) {
#pragma unroll
        for (int i = 0; i < 16; ++i) v[i] = 0.f;
        return; }
    const float* src = pos < NMETA ? p.in[2] + (size_t)pos * D : c.x + ((size_t)s * (c.T - NMETA) + (pos - NMETA)) * D;
#pragma unroll
    for (int j = 0; j < 4; ++j) { const f32x4 t = *(const f32x4*)(src + j * 256 + lane * 4); v[4 * j] = t[0]; v[4 * j + 1] = t[1]; v[4 * j + 2] = t[2]; v[4 * j + 3] = t[3]; }
}
__device__ __forceinline__ void ea_store_row(unsigned char* base, size_t row, int lane, const float (&v)[16]) {
#pragma unroll
    for (int j = 0; j < 4; ++j) { u32x2 o; o[0] = pk2(v[4 * j], v[4 * j + 1]); o[1] = pk2(v[4 * j + 2], v[4 * j + 3]); *(u32x2*)(base + (row * 1024 + j * 256 + lane * 4) * 2) = o; }
}
__device__ __forceinline__ void ea_norm(float (&v)[16], const float (&nw)[16]) {
    float ss = 0.f;
#pragma unroll
    for (int i = 0; i < 16; ++i) ss += v[i] * v[i];
    ss = wave_sum(ss); const float rs = rsqrtf(ss * (1.f / 1024.f) + 1e-6f);
#pragma unroll
    for (int i = 0; i < 16; ++i) v[i] = v[i] * rs * nw[i];
}
__device__ __forceinline__ void phase_mix(const Params& p, const Ctx& c) {
    const int wave = __builtin_amdgcn_readfirstlane(ltid() >> 6), lane = ltid() & 63;
    const int gw = blockIdx.x * 8 + wave, NW = gridDim.x * 8;
    float nw[16];
#pragma unroll
    for (int j = 0; j < 4; ++j) { const f32x4 t = *(const f32x4*)(p.in[3] + j * 256 + lane * 4); nw[4 * j] = t[0]; nw[4 * j + 1] = t[1]; nw[4 * j + 2] = t[2]; nw[4 * j + 3] = t[3]; }
    const int nstrips = c.R / 16, spq = c.T / 16;
    for (int st = gw; st < nstrips; st += NW) {
        const int s = st / spq, pos0 = (st - s * spq) * 16; const size_t row0 = (size_t)st * 16;
        float prev[16], cur[16], nx[16];
        ea_load_row(p, c, s, pos0 - 1, lane, prev); ea_norm(prev, nw);
        ea_load_row(p, c, s, pos0, lane, cur); ea_store_row(slot(p, 0), row0, lane, cur); ea_norm(cur, nw);
        float ah[16];
        ea_load_row(p, c, s, pos0 + 1, lane, ah);
        for (int i = 0; i < 16; ++i) {
#pragma unroll
            for (int e = 0; e < 16; ++e) nx[e] = ah[e];
            if (i < 15) ea_load_row(p, c, s, pos0 + i + 2, lane, ah);
            if (i < 15) ea_store_row(slot(p, 0), row0 + i + 1, lane, nx);
            ea_norm(nx, nw);
            float xx[16], o[16];
#pragma unroll
            for (int e = 0; e < 16; ++e) xx[e] = 0.5f * (prev[e] + nx[e]) - cur[e];
            for (int m = 0; m < 6; ++m) {
#pragma unroll
                for (int j = 0; j < 4; ++j) { const f32x4 t = *(const f32x4*)(p.in[6] + m * D + j * 256 + lane * 4);
#pragma unroll
                    for (int e = 0; e < 4; ++e) o[4 * j + e] = cur[4 * j + e] + xx[4 * j + e] * t[e]; }
                ea_store_row(slot(p, 1 + m), row0 + i, lane, o); }
#pragma unroll
            for (int e = 0; e < 16; ++e) { prev[e] = cur[e]; cur[e] = nx[e]; }
        }
    }
}

__device__ __forceinline__ void ld2(const unsigned char* base, size_t elem, u32x4 (&d)[2]) { const u32x4* q = (const u32x4*)(base + elem * 2); d[0] = q[0]; d[1] = q[1]; }
__device__ __forceinline__ void phase_prescan(const Params& p, const Ctx& c) {
    const int wave = __builtin_amdgcn_readfirstlane(ltid() >> 6), lane = ltid() & 63;
    const int gw = blockIdx.x * 8 + wave, NW = gridDim.x * 8; const int ch0 = lane * 16;
    float kkw[16], kaw[16], rkw[16];
    load16f(p.in[16] + ch0, kkw); load16f(p.in[17] + ch0, kaw); load16f(p.in[18] + ch0, rkw);
    float* bonus = (float*)(p.ws + O_BONUS);
    u32x4 nk[2], na0[2], na1[2], nr[2];
    if (gw < c.R) { const size_t e = (size_t)gw * 1024 + ch0; ld2(slot(p, 8), e, nk); ld2(slot(p, 3), e, na0); ld2(slot(p, 4), e, na1); ld2(slot(p, 7), e, nr); }
    for (int row = gw; row < c.R; row += NW) {
        const size_t e = (size_t)row * 1024 + ch0;
        float k[16], a0[16], a1[16], r[16];
        unpack16(nk[0], nk[1], k); unpack16(na0[0], na0[1], a0); unpack16(na1[0], na1[1], a1); unpack16(nr[0], nr[1], r);
        if (row + NW < c.R) { const size_t e2 = (size_t)(row + NW) * 1024 + ch0; ld2(slot(p, 8), e2, nk); ld2(slot(p, 3), e2, na0); ld2(slot(p, 4), e2, na1); ld2(slot(p, 7), e2, nr); }
        float kk[16], n2 = 0.f;
#pragma unroll
        for (int i = 0; i < 16; ++i) { kk[i] = k[i] * kkw[i]; n2 += kk[i] * kk[i]; }
        n2 += __shfl_xor(n2, 1); n2 += __shfl_xor(n2, 2);
        const float inv = 1.f / fmaxf(sqrtf(n2), 1e-12f);
        float kd0[16], kd1[16], bon = 0.f;
#pragma unroll
        for (int i = 0; i < 16; ++i) { kk[i] *= inv; kd0[i] = k[i] * (1.f + (a0[i] - 1.f) * kaw[i]); kd1[i] = k[i] * (1.f + (a1[i] - 1.f) * kaw[i]);
            bon += r[i] * (kd0[i] + kd1[i]) * rkw[i]; a0[i] *= kk[i]; a1[i] *= kk[i]; }
        bon += __shfl_xor(bon, 1); bon += __shfl_xor(bon, 2);
        if ((lane & 3) == 0) bonus[(size_t)row * 16 + (lane >> 2)] = bon;
        store16bf(slot(p, 8), e, kk); store16bf(slot(p, 3), e, a0); store16bf(slot(p, 4), e, a1);
        store16bf(slot(p, 6), e, kd0); store16bf(slot(p, 10), e, kd1);
    }
}

__device__ __forceinline__ float half_sum(float x) {
    const unsigned a = __float_as_uint(x); auto r = __builtin_amdgcn_permlane32_swap(a, a, false, false);
    return __uint_as_float(r[0]) + __uint_as_float(r[1]);
}
__device__ __forceinline__ float ldbf(const unsigned char* base, int idx) { return __uint_as_float(((unsigned)((const bf16_t*)base)[idx]) << 16); }
__device__ __forceinline__ float quarter_sum(float x) {
    const unsigned a = __float_as_uint(x); auto r = __builtin_amdgcn_permlane16_swap(a, a, false, false);
    return half_sum(__uint_as_float(r[0]) + __uint_as_float(r[1]));
}
template <int RPL, int JP, int RING>
__device__ __forceinline__ void scan_items(LAS unsigned char* lds, const Params& p, const Ctx& c) {
    constexpr int LR = 64 / JP, NJ = 64 / JP, ROWS = LR * RPL, WPS = 64 / ROWS, NQ = NJ / 4, BQ = RPL == 2 ? 1 : 2, NB = NQ / BQ;
    const int tid = ltid(); const int wave = __builtin_amdgcn_readfirstlane(tid >> 6), lane = tid & 63;
    const int nitem = c.nseq * 32 * WPS; const int lr = lane % LR, jp = lane / LR;
    LAS float* wb = (LAS float*)(lds + wave * 16384);
    LAS float* oring = wb + 1024;
    for (int w = blockIdx.x + gridDim.x * wave; w < nitem; w += gridDim.x * 8) {
        const int q = w / WPS, rq = w % WPS; const int dir = q & 1, hh = (q >> 1) & 15, s = q >> 5;
        const size_t e0 = (size_t)s * c.T * 1024 + hh * 64;
        const unsigned char* Rb = slot(p, 7) + e0 * 2; const unsigned char* Kkb = slot(p, 8) + e0 * 2; const unsigned char* Vb = slot(p, 9) + e0 * 2;
        const unsigned char* Ngb = slot(p, 1 + dir) + e0 * 2; const unsigned char* Bdb = slot(p, 3 + dir) + e0 * 2;
        const unsigned char* Kdb = slot(p, dir ? 10 : 6) + e0 * 2; unsigned char* Ob = slot(p, 11 + dir) + e0 * 2;
        const int vec = lane >> 3, chunk = lane & 7;
        const unsigned char* lb = (vec == 0 ? Kkb : vec == 1 ? Ngb : vec == 2 ? Bdb : vec == 3 ? Kdb : vec == 4 ? Rb : Vb) + chunk * 16;
        const int vrow0 = rq * ROWS + lr;
        const int step = dir ? -2048 : 2048; const long ro0 = dir ? (long)(c.T - 1) * 2048 : 0;
        f32x2 S2[RPL][NJ / 2];
#pragma unroll
        for (int a_ = 0; a_ < RPL; ++a_)
#pragma unroll
            for (int j = 0; j < NJ / 2; ++j) S2[a_][j] = (f32x2){0.f, 0.f};
        u32x4 xr[RING];
#define SCAN_LD(dst, tt) do { const int _t = (tt) < c.T ? (tt) : c.T - 1; const long _r = ro0 + (long)_t * step; dst = *(const u32x4*)(lb + _r); } while (0)
#define SCAN_PARK(x, buf) do { if (vec < 6) { f32x4 _lo, _hi; _lo[0] = bflo(x[0]); _lo[1] = bfhi(x[0]); _lo[2] = bflo(x[1]); _lo[3] = bfhi(x[1]); _hi[0] = bflo(x[2]); _hi[1] = bfhi(x[2]); _hi[2] = bflo(x[3]); _hi[3] = bfhi(x[3]); \
            LAS f32x4* _d = (LAS f32x4*)((buf) + vec * 64 + chunk * 8); _d[0] = _lo; _d[1] = _hi; } } while (0)
#define SCAN_RD4(dst, base, jj) do { _Pragma("unroll") for (int _h = 0; _h < BQ; ++_h) { dst[4 * _h] = ((const LAS f32x4*)((base) + 64))[(jj) + _h]; dst[4 * _h + 1] = ((const LAS f32x4*)((base) + 128))[(jj) + _h]; \
            dst[4 * _h + 2] = ((const LAS f32x4*)((base) + 192))[(jj) + _h]; dst[4 * _h + 3] = ((const LAS f32x4*)((base) + 256))[(jj) + _h]; } } while (0)
        float vi[RPL];
        { u32x4 x; SCAN_LD(x, 0); SCAN_PARK(x, wb); }
#pragma unroll
        for (int k = 1; k < RING; ++k) SCAN_LD(xr[k], k);
        SCAN_LD(xr[0], RING);
        f32x4 kq[NQ];
#pragma unroll
        for (int j = 0; j < NQ; ++j) kq[j] = ((const LAS f32x4*)(wb + jp * NJ))[j];
#pragma unroll
        for (int a_ = 0; a_ < RPL; ++a_) vi[a_] = wb[320 + vrow0 + a_ * LR];
        int fstart = 0;
        for (int tb = 0; tb < c.T; tb += RING) {
#pragma unroll
            for (int k = 0; k < RING; ++k) {
                const int t = tb + k;
                const LAS float* sb = wb + (k & 1) * 512 + jp * NJ; LAS float* sn = wb + ((k + 1) & 1) * 512;
                f32x4 PQ[2][4 * BQ];
                SCAN_RD4(PQ[0], sb, 0);
                __builtin_amdgcn_sched_barrier(0);
                float sa[RPL];
#pragma unroll
                for (int a_ = 0; a_ < RPL; ++a_) { f32x2 a0 = (f32x2){0.f, 0.f}, a1 = (f32x2){0.f, 0.f};
#pragma unroll
                    for (int j = 0; j < NQ; ++j) { a0 = __builtin_elementwise_fma(S2[a_][2 * j], (f32x2){kq[j][0], kq[j][1]}, a0); a1 = __builtin_elementwise_fma(S2[a_][2 * j + 1], (f32x2){kq[j][2], kq[j][3]}, a1); }
                    sa[a_] = (a0[0] + a0[1]) + (a1[0] + a1[1]); }
                u32x4& xs = xr[(k + 1) % RING];
                SCAN_PARK(xs, sn);
                float vcur[RPL];
#pragma unroll
                for (int a_ = 0; a_ < RPL; ++a_) vcur[a_] = vi[a_];
                SCAN_LD(xs, t + 1 + RING);
                f32x2 sa2[RPL], v2[RPL], oa0[RPL], oa1[RPL];
#pragma unroll
                for (int a_ = 0; a_ < RPL; ++a_) { const float sr = -(JP == 2 ? half_sum(sa[a_]) : quarter_sum(sa[a_])); sa2[a_] = (f32x2){sr, sr}; v2[a_] = (f32x2){vcur[a_], vcur[a_]};
                    oa0[a_] = (f32x2){0.f, 0.f}; oa1[a_] = (f32x2){0.f, 0.f}; }
#pragma unroll
                for (int b_ = 0; b_ < NB; ++b_) {
                    if (b_ + 1 < NB) { SCAN_RD4(PQ[(b_ + 1) & 1], sb, BQ * (b_ + 1)); }
                    else {
#pragma unroll
                        for (int j = 0; j < NQ; ++j) kq[j] = ((const LAS f32x4*)(sn + jp * NJ))[j];
#pragma unroll
                        for (int a_ = 0; a_ < RPL; ++a_) vi[a_] = sn[320 + vrow0 + a_ * LR];
                    }
                    __builtin_amdgcn_sched_barrier(0);
#pragma unroll
                    for (int h_ = 0; h_ < BQ; ++h_) { const f32x4 g4 = PQ[b_ & 1][4 * h_], b4 = PQ[b_ & 1][4 * h_ + 1], d4 = PQ[b_ & 1][4 * h_ + 2], r4 = PQ[b_ & 1][4 * h_ + 3]; const int j_ = 2 * (BQ * b_ + h_);
#pragma unroll
                        for (int a_ = 0; a_ < RPL; ++a_) { f32x2 s0 = S2[a_][j_], s1 = S2[a_][j_ + 1];
                            s0 = __builtin_elementwise_fma(s0, (f32x2){g4[0], g4[1]}, s0); s1 = __builtin_elementwise_fma(s1, (f32x2){g4[2], g4[3]}, s1);
                            s0 = __builtin_elementwise_fma(sa2[a_], (f32x2){b4[0], b4[1]}, s0); s1 = __builtin_elementwise_fma(sa2[a_], (f32x2){b4[2], b4[3]}, s1);
                            s0 = __builtin_elementwise_fma(v2[a_], (f32x2){d4[0], d4[1]}, s0); s1 = __builtin_elementwise_fma(v2[a_], (f32x2){d4[2], d4[3]}, s1);
                            S2[a_][j_] = s0; S2[a_][j_ + 1] = s1;
                            oa0[a_] = __builtin_elementwise_fma(s0, (f32x2){r4[0], r4[1]}, oa0[a_]); oa1[a_] = __builtin_elementwise_fma(s1, (f32x2){r4[2], r4[3]}, oa1[a_]); } }
                    __builtin_amdgcn_sched_barrier(0);
                }
#pragma unroll
                for (int a_ = 0; a_ < RPL; ++a_) { const float os_ = (oa0[a_][0] + oa0[a_][1]) + (oa1[a_][0] + oa1[a_][1]); const float ov = JP == 2 ? half_sum(os_) : quarter_sum(os_);
                    if (jp == 0) oring[(t & 63) * ROWS + a_ * LR + lr] = ov; }
            }
            const int tend = tb + RING, nfl = tend - fstart;
            if (nfl == 64 || tend >= c.T) {
                for (int idx = lane; idx < nfl * ROWS; idx += 64) { const int st = idx / ROWS, row = idx % ROWS;
                    ((bf16_t*)(Ob + ro0 + (long)(fstart + st) * step))[rq * ROWS + row] = (bf16_t)(pk2(oring[idx], 0.f) & 0xffffu); }
                fstart = tend;
            }
        }
#undef SCAN_LD
#undef SCAN_PARK
#undef SCAN_RD4
    }
}
__device__ __forceinline__ void phase_scan(LAS unsigned char* lds, const Params& p, const Ctx& c) {
    if (c.g < 2) scan_items<2, 4, 8>(lds, p, c); else scan_items<1, 4, 8>(lds, p, c);
}

__device__ __forceinline__ void phase_postscan(const Params& p, const Ctx& c) {
    const int wave = __builtin_amdgcn_readfirstlane(ltid() >> 6), lane = ltid() & 63;
    const int gw = blockIdx.x * 8 + wave, NW = gridDim.x * 8; const int ch0 = lane * 16;
    float gw_[16], gb_[16]; load16f(p.in[19] + ch0, gw_); load16f(p.in[20] + ch0, gb_);
    const float* bonus = (const float*)(p.ws + O_BONUS);
    u32x4 nf[2], nb[2], nv[2], ng[2];
    if (gw < c.R) { const size_t e = (size_t)gw * 1024 + ch0; ld2(slot(p, 11), e, nf); ld2(slot(p, 12), e, nb); ld2(slot(p, 9), e, nv); ld2(slot(p, 5), e, ng); }
    for (int row = gw; row < c.R; row += NW) {
        const size_t e = (size_t)row * 1024 + ch0;
        float of[16], ob[16], v[16], g[16];
        unpack16(nf[0], nf[1], of); unpack16(nb[0], nb[1], ob); unpack16(nv[0], nv[1], v); unpack16(ng[0], ng[1], g);
        if (row + NW < c.R) { const size_t e2 = (size_t)(row + NW) * 1024 + ch0; ld2(slot(p, 11), e2, nf); ld2(slot(p, 12), e2, nb); ld2(slot(p, 9), e2, nv); ld2(slot(p, 5), e2, ng); }
        float sum = 0.f;
#pragma unroll
        for (int i = 0; i < 16; ++i) { of[i] += ob[i]; sum += of[i]; }
        sum += __shfl_xor(sum, 1); sum += __shfl_xor(sum, 2); const float mean = sum * (1.f / 64.f);
        float var = 0.f;
#pragma unroll
        for (int i = 0; i < 16; ++i) { of[i] -= mean; var += of[i] * of[i]; }
        var += __shfl_xor(var, 1); var += __shfl_xor(var, 2); const float rs = rsqrtf(var * (1.f / 64.f) + 64e-5f);
        const float bon = bonus[(size_t)row * 16 + (lane >> 2)];
#pragma unroll
        for (int i = 0; i < 16; ++i) of[i] = (of[i] * rs * gw_[i] + gb_[i] + bon * v[i]) * g[i];
        store16bf(slot(p, 1), e, of);
    }
}

__device__ __forceinline__ void phase_glu(const Params& p, const Ctx& c, int layer) {
    const size_t gt = (size_t)blockIdx.x * 512 + ltid(), NT = (size_t)gridDim.x * 512;
    const unsigned char* U = slot(p, 1); unsigned char* Aout = slot(p, 7);
    const float* cw = p.in[24] + (size_t)layer * 3 * DFF; const float* cb = p.in[25] + (size_t)layer * DFF;
    const size_t nitem = (size_t)(c.R / 16) * 352;
    for (size_t it = gt; it < nitem; it += NT) {
        const int strip = (int)(it / 352), cc = (int)(it % 352) * 8; const int row0 = strip * 16, pos0 = row0 % c.T;
        float w0[8], w1[8], w2[8], bb[8];
#pragma unroll
        for (int h = 0; h < 2; ++h) { const f32x4 a = *(const f32x4*)(cw + cc + 4 * h), b = *(const f32x4*)(cw + DFF + cc + 4 * h), d = *(const f32x4*)(cw + 2 * DFF + cc + 4 * h), e = *(const f32x4*)(cb + cc + 4 * h);
#pragma unroll
            for (int i = 0; i < 4; ++i) { w0[4 * h + i] = a[i]; w1[4 * h + i] = b[i]; w2[4 * h + i] = d[i]; bb[4 * h + i] = e[i]; } }
        const unsigned char* ur = U + (size_t)row0 * 5632 * 2 + cc * 2;
        const u32x4 z = (u32x4){0u, 0u, 0u, 0u};
        u32x4 pm = pos0 > 0 ? *(const u32x4*)(ur - 5632 * 2) : z, pc = *(const u32x4*)ur;
        for (int i0 = 0; i0 < 16; i0 += 4) {
            u32x4 PP[4], LN[4];
#pragma unroll
            for (int j = 0; j < 4; ++j) { PP[j] = (pos0 + i0 + j < c.T - 1) ? *(const u32x4*)(ur + (size_t)(j + 1) * 5632 * 2) : z; LN[j] = *(const u32x4*)(ur + (size_t)j * 5632 * 2 + DFF * 2); }
#pragma unroll
            for (int j = 0; j < 4; ++j) { const u32x4 pp = PP[j], ln = LN[j]; u32x4 o;
#pragma unroll
                for (int e = 0; e < 4; ++e) {
                    const float c0 = bflo(pm[e]) * w0[2 * e] + bflo(pc[e]) * w1[2 * e] + bflo(pp[e]) * w2[2 * e] + bb[2 * e];
                    const float c1 = bfhi(pm[e]) * w0[2 * e + 1] + bfhi(pc[e]) * w1[2 * e + 1] + bfhi(pp[e]) * w2[2 * e + 1] + bb[2 * e + 1];
                    o[e] = pk2(c0 * sigmoidf_(c0) * bflo(ln[e]), c1 * sigmoidf_(c1) * bfhi(ln[e])); }
                *(u32x4*)(Aout + ((size_t)(row0 + i0 + j) * DFF + cc) * 2) = o;
                pm = pc; pc = pp; }
            ur += (size_t)4 * 5632 * 2;
        }
    }
}

__device__ __forceinline__ void phase_final(const Params& p, const Ctx& c) {
    const int tid = ltid(); const int wave = __builtin_amdgcn_readfirstlane(tid >> 6), lane = tid & 63;
    const int gw = blockIdx.x * 8 + wave, NW = gridDim.x * 8; const int ch0 = lane * 16;
    float nf[16]; load16f(p.in[5] + ch0, nf);
    const int To = c.T - NMETA, nrow = c.nseq * To;
    for (int q0 = gw * 4; q0 < nrow; q0 += NW * 4) {
        u32x4 ha[4], hb[4];
#pragma unroll
        for (int j = 0; j < 4; ++j) { const int q = q0 + j, s = q / To, po = q - s * To; const size_t row = (size_t)s * c.T + NMETA + po;
            const u32x4* src = (const u32x4*)(slot(p, 0) + (row * 1024 + ch0) * 2); ha[j] = src[0]; hb[j] = src[1]; }
#pragma unroll
        for (int j = 0; j < 4; ++j) { float h[16]; unpack16(ha[j], hb[j], h);
            float ss = 0.f;
#pragma unroll
            for (int i = 0; i < 16; ++i) ss += h[i] * h[i];
            ss = wave_sum(ss); const float rs = rsqrtf(ss * (1.f / 1024.f) + 1e-6f);
            float* dst = c.y + (size_t)(q0 + j) * 1024 + ch0;
#pragma unroll
            for (int k = 0; k < 4; ++k) { f32x4 o; o[0] = h[4 * k] * rs * nf[4 * k]; o[1] = h[4 * k + 1] * rs * nf[4 * k + 1]; o[2] = h[4 * k + 2] * rs * nf[4 * k + 2]; o[3] = h[4 * k + 3] * rs * nf[4 * k + 3]; ((f32x4*)dst)[k] = o; } }
    }
}


#define XB_TMO      128
#define XB_XCNT(j)  (256  + 64 * (j))
#define XB_XSUB(j)  (1280 + 64 * (j))
#define XB_XGEN(j)  (2304 + 64 * (j))
#define XB_TOP      3328
#define XB_TOPGEN   3392
#define XCD_BAR_WORDS 3456
#define XB_SPIN_CAP (1u << 18)
__device__ __forceinline__ unsigned xb_ld(unsigned* p)              { return __hip_atomic_load(p, __ATOMIC_RELAXED, __HIP_MEMORY_SCOPE_AGENT); }
__device__ __forceinline__ unsigned xb_add(unsigned* p, unsigned v) { return __hip_atomic_fetch_add(p, v, __ATOMIC_RELAXED, __HIP_MEMORY_SCOPE_AGENT); }
__device__ __forceinline__ unsigned xb_xcc_id() { return (unsigned)__builtin_amdgcn_s_getreg((3 << 11) | 20) & 0xFu; }
#define XB_SPIN(cond, bar) do { unsigned _sp = 0; while (cond) { __builtin_amdgcn_s_sleep(1); \
    if ((++_sp & 255u) == 0u) { if (xb_ld(&(bar)[XB_TMO])) break; if (_sp > XB_SPIN_CAP) { atomicAdd(&(bar)[XB_TMO], 1u); break; } } } } while (0)
struct XcdBarrier { unsigned* bar; unsigned x; volatile LAS unsigned* st; };
__device__ __forceinline__ XcdBarrier xcd_barrier_post(unsigned* bar, volatile LAS unsigned* st) {
    XcdBarrier b; b.bar = bar; b.x = xb_xcc_id(); b.st = st;
    if (threadIdx.x == 0) (void)xb_add(&bar[XB_XCNT(b.x)], 1u);
    return b;
}
__device__ __forceinline__ void xcd_barrier_complete(unsigned* bar, unsigned x, unsigned& nloc, unsigned& nx) {
    const unsigned G = gridDim.x * gridDim.y * gridDim.z;
    unsigned sum, cnt, mine, sp = 0u;
    for (;;) {
        sum = 0u; cnt = 0u; mine = 0u;
#pragma unroll
        for (unsigned j = 0; j < 16; ++j) { const unsigned c = xb_ld(&bar[XB_XCNT(j)]); sum += c; cnt += (c > 0u) ? 1u : 0u; mine = (j == x) ? c : mine; }
        if (sum == G) break;
        __builtin_amdgcn_s_sleep(1);
        if ((++sp & 255u) == 0u) { if (xb_ld(&bar[XB_TMO])) break; if (sp > XB_SPIN_CAP) { atomicAdd(&bar[XB_TMO], 1u); break; } }
    }
    nloc = mine > 0u ? mine : 1u; nx = cnt > 0u ? cnt : 1u;
}
__device__ __forceinline__ void xcd_barrier(const XcdBarrier& b) {
    asm volatile("s_waitcnt vmcnt(0)" ::: "memory");
    __syncthreads();
    if (threadIdx.x == 0) {
        unsigned* bar = b.bar;
        __builtin_amdgcn_s_waitcnt(0);
        unsigned nloc = b.st[0], nx = b.st[1];
        if (nloc == 0u) { xcd_barrier_complete(bar, b.x, nloc, nx); b.st[0] = nloc; b.st[1] = nx; }
        const unsigned old = xb_add(&bar[XB_XSUB(b.x)], 1u);
        const unsigned gen = old / nloc;
        if (old + 1u == (gen + 1u) * nloc) {
            __builtin_amdgcn_fence(__ATOMIC_RELEASE, "agent");
            asm volatile("s_waitcnt vmcnt(0)" ::: "memory");
            const unsigned og = xb_add(&bar[XB_TOP], 1u);
            const unsigned tg = og / nx;
            if (og + 1u == (tg + 1u) * nx) xb_add(&bar[XB_TOPGEN], 1u);
            else XB_SPIN(xb_ld(&bar[XB_TOPGEN]) == tg, bar);
            __builtin_amdgcn_fence(__ATOMIC_ACQUIRE, "agent");
            xb_add(&bar[XB_XGEN(b.x)], 1u);
            asm volatile("s_waitcnt vmcnt(0)" ::: "memory");
        } else {
            XB_SPIN(xb_ld(&bar[XB_XGEN(b.x)]) == gen, bar);
            __builtin_amdgcn_fence(__ATOMIC_ACQUIRE, "agent");
            asm volatile("s_waitcnt vmcnt(0)" ::: "memory");
        }
    }
    __syncthreads();
}

constexpr int NSUB = 20, NPHASE = 1 + 4 * NSUB;

__device__ __forceinline__ void phase_rstd(const Params& p, int which) {
    const float* part = (const float*)(p.ws + O_SS) + (size_t)which * 16 * RP; float* rs = (float*)(p.ws + O_RSTD) + (size_t)which * RP;
    for (int r = blockIdx.x * 512 + ltid(); r < RP; r += gridDim.x * 512) rs[r] = rstd16(part, r);
}

__device__ __forceinline__ void phase_fold(const Params& p, const Ctx& c) {
    const int tid = ltid(); const int wave = __builtin_amdgcn_readfirstlane(tid >> 6), lane = tid & 63;
    const int gw = blockIdx.x * 8 + wave, NW = gridDim.x * 8; const int ch0 = lane * 16;
    const float* part = (const float*)(p.ws + O_SS) + (size_t)16 * RP;
    const int nrow = c.nseq * c.Tp, Th = c.T / 2;
    for (int q = gw; q < nrow; q += NW) {
        const int s = q / c.Tp, tf = q - s * c.Tp; float oc[16], os[16];
        if (tf > Th) {
#pragma unroll
            for (int i = 0; i < 16; ++i) { oc[i] = 0.f; os[i] = 0.f; }
        } else {
            const int r1 = s * c.T + tf; float a[16]; load16bf(slot(p, 0), (size_t)r1 * 1024 + ch0, a); const float rs1 = rsqrtf(wave_sum(lane < 16 ? part[(size_t)lane * RP + r1] : 0.f) * (1.f / 1024.f) + 1e-6f);
            if (tf == 0 || tf == Th) {
#pragma unroll
                for (int i = 0; i < 16; ++i) { oc[i] = a[i] * rs1; os[i] = 0.f; }
            } else {
                const int r2 = s * c.T + (c.T - tf); float b[16]; load16bf(slot(p, 0), (size_t)r2 * 1024 + ch0, b); const float rs2 = rsqrtf(wave_sum(lane < 16 ? part[(size_t)lane * RP + r2] : 0.f) * (1.f / 1024.f) + 1e-6f);
#pragma unroll
                for (int i = 0; i < 16; ++i) { const float x = a[i] * rs1, y = b[i] * rs2; oc[i] = x + y; os[i] = x - y; }
            }
        }
        store16bf(slot(p, 5), (size_t)q * 1024 + ch0, oc); store16bf(slot(p, 6), (size_t)q * 1024 + ch0, os);
    }
}

__device__ __forceinline__ void run_phase(LAS unsigned char* lds, const Params& p, int ph) {
    if (ph == 0) { prep_phase(lds, p); return; }
    const int g = (ph - 1) / NSUB, sp = (ph - 1) % NSUB; const Ctx c = get_ctx(p, g);
    GemmPh P; P.G = gridDim.x; P.c = blockIdx.x; P.A = nullptr; P.B = nullptr; P.O = nullptr; P.ss = nullptr; P.ssin = nullptr; P.ldo = 0; P.kind = -1;
    float* ssb = (float*)(p.ws + O_SS); const float* rsb = (const float*)(p.ws + O_RSTD);
    switch (sp) {
    case 1: P.kind = K_L1; P.nunits = MT * 15; P.lda = 1024; P.ldb = 1024; P.K = 1024; break;
    case 2: P.kind = K_L2; P.nunits = MT * 20; P.lda = 256; P.ldb = 256; P.K = 256; break;
    case 6: P.kind = K_RES; P.nunits = MT * 4; P.lda = 1024; P.ldb = 1024; P.K = 1024; P.A = (const char*)slot(p, 1); P.B = (const char*)p.ws + O_WO; P.O = slot(p, 0); P.ss = ssb; break;
    case 8: case 16: { const int l = sp == 8 ? 0 : 1; P.kind = K_U; P.nunits = MT * 22; P.lda = 1024; P.ldb = 1024; P.K = 1024; P.A = (const char*)slot(p, 0); P.B = (const char*)p.ws + O_WIN + (size_t)l * 5632 * 1024 * 2;
        P.O = slot(p, 1); P.ssin = rsb + (l ? 2 * RP : 0); } break;
    case 10: case 18: { const int l = sp == 10 ? 0 : 1; P.kind = K_RES; P.nunits = MT * 4; P.lda = DFF; P.ldb = DFF; P.K = DFF; P.A = (const char*)slot(p, 7); P.B = (const char*)p.ws + O_WOUT + (size_t)l * 1024 * DFF * 2;
        P.O = slot(p, 0); P.ss = l ? nullptr : ssb + 16 * RP; } break;
    case 12: P.kind = K_CH; P.nunits = (c.nseq * c.Tp / 256) * 8; P.lda = 1024; P.ldb = 1024; P.K = 256; P.A = (const char*)p.ws + O_CHD; P.B = (const char*)slot(p, 5); P.O = slot(p, 1); break;
    case 13: P.kind = K_TD; P.nunits = c.nseq * c.tm * 4; P.lda = 2 * c.Tp; P.ldb = 2 * c.Tp; P.K = 2 * c.Tp; P.A = (const char*)p.ws + (g < 2 ? O_DFTP : O_DFTS); P.B = (const char*)slot(p, 1); P.O = slot(p, 4); break;
    case 14: P.kind = K_RES; P.nunits = MT * 4; P.lda = 1024; P.ldb = 1024; P.K = 1024; P.A = (const char*)slot(p, 4); P.B = (const char*)p.ws + O_WF; P.O = slot(p, 0); P.ss = ssb + 2 * 16 * RP; break;
    default: break;
    }
    if (P.kind >= 0) {
        switch (P.kind) {
        case K_L1: gemm_phase<K_L1>(lds, P, p, c); break;
        case K_L2: gemm_phase<K_L2>(lds, P, p, c); break;
        case K_RES: gemm_phase<K_RES>(lds, P, p, c); break;
        case K_U: gemm_phase<K_U>(lds, P, p, c); break;
        case K_CH: gemm_phase<K_CH>(lds, P, p, c); break;
        default: gemm_phase<K_TD>(lds, P, p, c); break;
        }
        if (sp == 13) {
            const int tid = ltid(); const int wave = __builtin_amdgcn_readfirstlane(tid >> 6), lane = tid & 63; const int K2 = 2 * c.Tp;
            const bf16_t* drow = (const bf16_t*)P.A + (size_t)(NMETA - 1) * K2; const bf16_t* yT = (const bf16_t*)slot(p, 1); bf16_t* F = (bf16_t*)slot(p, 4);
            for (int it = blockIdx.x * 8 + wave; it < c.nseq * 1024; it += gridDim.x * 8) {
                const int s = it >> 10, ch = it & 1023; const bf16_t* yr = yT + ((size_t)s * 1024 + ch) * K2; float acc = 0.f;
                for (int kk = lane * 2; kk < K2; kk += 128) { const unsigned a = *(const unsigned*)(drow + kk), b = *(const unsigned*)(yr + kk); acc += bflo(a) * bflo(b) + bfhi(a) * bfhi(b); }
                acc = wave_sum(acc);
                if (lane == 0) F[((size_t)s * c.T + (NMETA - 1)) * 1024 + ch] = (bf16_t)(pk2(acc, 0.f) & 0xffffu);
            }
        }
        return;
    }
    if (sp == 0) phase_mix(p, c);
    else if (sp == 3) phase_prescan(p, c);
    else if (sp == 4) phase_scan(lds, p, c);
    else if (sp == 5) phase_postscan(p, c);
    else if (sp == 11) phase_fold(p, c);
    else if (sp == 7 || sp == 15) phase_rstd(p, sp == 7 ? 0 : 2);
    else if (sp == 9 || sp == 17) phase_glu(p, c, sp == 9 ? 0 : 1);
    else phase_final(p, c);
}

__global__ void __launch_bounds__(512, 2) mega(Params p, int ph_lo, int ph_hi) {
    extern __shared__ __attribute__((aligned(16))) unsigned char shm[];
    LAS unsigned char* lds = (LAS unsigned char*)shm;
    cg::grid_group grid = cg::this_grid();
    volatile LAS unsigned* st = (volatile LAS unsigned*)(lds + STAGE_BYTES);
    if (threadIdx.x == 0) { st[0] = 0u; st[1] = 0u; }
    __syncthreads();
    const XcdBarrier xb = xcd_barrier_post((unsigned*)(p.ws + O_BAR), st);
    for (int ph = ph_lo; ph < ph_hi; ++ph) {
        if (ph_hi < 0) grid.sync();
        if (ph > ph_lo) xcd_barrier(xb);
        run_phase(lds, p, ph);
    }
}

extern "C" void kernel_launch(void* const* d_in, const int* in_sizes, int n_in, void* d_out, int out_size, void* d_ws, size_t ws_size, hipStream_t stream) {
    static int grid = 0;
    if (grid == 0) {
        if (n_in != 27 || ws_size < WS_END) { fprintf(stderr, "kernel_launch: need 27 inputs and %zu B of workspace (got %d, %zu)\n", (size_t)WS_END, n_in, ws_size); grid = -1; return; }
        int dev = 0, cus = 0, per_cu = 0;
        hipGetDevice(&dev); hipDeviceGetAttribute(&cus, hipDeviceAttributeMultiprocessorCount, dev);
        if (hipFuncSetAttribute((const void*)mega, hipFuncAttributeMaxDynamicSharedMemorySize, STAGE_BYTES + 16) != hipSuccess) { fprintf(stderr, "hipFuncSetAttribute failed\n"); grid = -1; return; }
        hipOccupancyMaxActiveBlocksPerMultiprocessor(&per_cu, (const void*)mega, 512, STAGE_BYTES + 16);
        if (per_cu < 1) per_cu = 1;
        (void)hipGetLastError();
        grid = cus * 1;
    }
    if (grid < 0) return;
    Params p{};
    for (int i = 0; i < 27; ++i) p.in[i] = (const float*)d_in[i];
    p.out = (float*)d_out; p.ws = (unsigned char*)d_ws;
#if MK_PER_PHASE
    for (int ph = 0; ph < NPHASE; ++ph) hipLaunchKernelGGL(mega, dim3(grid), dim3(512), STAGE_BYTES + 16, stream, p, ph, ph + 1);
#else
    (void)hipMemsetAsync((unsigned char*)d_ws + O_BAR, 0, 16384, stream);
    int lo = 0, hi = NPHASE;
    void* args[] = {&p, &lo, &hi};
    hipError_t e = hipLaunchCooperativeKernel((const void*)mega, dim3(grid), dim3(512), args, STAGE_BYTES + 16, stream);
    if (e != hipSuccess) fprintf(stderr, "cooperative launch failed: %s (grid %d)\n", hipGetErrorString(e), grid);
#endif
}
```

```cpp
#include <hip/hip_runtime.h>
#include <hip/hip_cooperative_groups.h>
#include <cstdio>
namespace cg = cooperative_groups;

#ifndef MK_PER_PHASE
#define MK_PER_PHASE 0
#endif

#define LAS __attribute__((address_space(3)))
typedef unsigned short bf16_t;
typedef short bf16x8 __attribute__((ext_vector_type(8)));
typedef float f32x4 __attribute__((ext_vector_type(4)));
typedef unsigned u32x4 __attribute__((ext_vector_type(4)));
typedef unsigned u32x2 __attribute__((ext_vector_type(2)));
typedef float f32x2 __attribute__((ext_vector_type(2)));
typedef const __attribute__((address_space(4))) unsigned* cptr;

constexpr int D = 1024, DFF = 2816, NMETA = 16;
constexpr int RP = 33024;
constexpr int MT = RP / 256;
constexpr size_t SLOT = (size_t)RP * D * 2;
constexpr int NSLOT = 13;
constexpr size_t O_WRKV = NSLOT * SLOT;
constexpr size_t O_G1 = O_WRKV + (size_t)3072 * 1024 * 2;
constexpr size_t O_W1 = O_G1 + (size_t)256 * 1024 * 2;
constexpr size_t O_A1 = O_W1 + (size_t)256 * 1024 * 2;
constexpr size_t O_L2 = O_A1 + (size_t)256 * 1024 * 2;
constexpr size_t O_G2 = O_L2 + (size_t)4096 * 256 * 2;
constexpr size_t O_WO = O_G2 + (size_t)1024 * 256 * 2;
constexpr size_t O_WF = O_WO + (size_t)1024 * 1024 * 2;
constexpr size_t O_WIN = O_WF + (size_t)1024 * 1024 * 2;
constexpr size_t O_WOUT = O_WIN + (size_t)2 * 5632 * 1024 * 2;
constexpr size_t O_CHD = O_WOUT + (size_t)2 * 1024 * 2816 * 2;
constexpr int TP_P = 1088, TP_S = 2112, MP_P = 2304, MP_S = 4352;
constexpr size_t O_DFTP = O_CHD + (size_t)2048 * 1024 * 2;
constexpr size_t O_DFTS = O_DFTP + (size_t)MP_P * 2 * TP_P * 2;
constexpr size_t O_SS = O_DFTS + (size_t)MP_S * 2 * TP_S * 2;
constexpr size_t O_RSTD = O_SS + (size_t)3 * 16 * RP * 4;
constexpr size_t O_BONUS = O_RSTD + (size_t)3 * RP * 4;
constexpr size_t O_BAR = O_BONUS + (size_t)RP * 16 * 4;
constexpr size_t WS_END = O_BAR + 16384;

struct Params { const float* in[27]; float* out; unsigned char* ws; };
struct Ctx { int g, T, nseq, R, Tp, tm; const float* x; float* y; };

__device__ __forceinline__ Ctx get_ctx(const Params& p, int g) {
    Ctx c; c.g = g;
    if (g < 2) { c.T = 2064; c.nseq = 16; c.Tp = TP_P; c.tm = 8; c.x = p.in[0] + (size_t)g * 16 * 2048 * 1024; c.y = p.out + (size_t)g * 16 * 2048 * 1024; }
    else { c.T = 4112; c.nseq = 8; c.Tp = TP_S; c.tm = 16; c.x = p.in[1] + (size_t)(g - 2) * 8 * 4096 * 1024; c.y = p.out + (size_t)32 * 2048 * 1024 + (size_t)(g - 2) * 8 * 4096 * 1024; }
    c.R = c.nseq * c.T; return c;
}
__device__ __forceinline__ int ltid() { int t = threadIdx.x; asm volatile("" : "+v"(t)); return t; }
__device__ __forceinline__ unsigned char* slot(const Params& p, int i) { return p.ws + (size_t)i * SLOT; }

__device__ __forceinline__ unsigned pk2(float lo, float hi) { unsigned r; asm volatile("v_cvt_pk_bf16_f32 %0, %1, %2" : "=v"(r) : "v"(lo), "v"(hi)); return r; }
__device__ __forceinline__ float bflo(unsigned u) { return __uint_as_float(u << 16); }
__device__ __forceinline__ float bfhi(unsigned u) { return __uint_as_float(u & 0xffff0000u); }
__device__ __forceinline__ float wave_sum(float v) {
#pragma unroll
    for (int o = 1; o < 64; o <<= 1) v += __shfl_xor(v, o);
    return v;
}
__device__ __forceinline__ float sigmoidf_(float x) { return __builtin_amdgcn_rcpf(1.f + __expf(-x)); }
__device__ __forceinline__ void unpack16(const u32x4 a, const u32x4 b, float (&v)[16]) {
#pragma unroll
    for (int i = 0; i < 4; ++i) { v[2 * i] = bflo(a[i]); v[2 * i + 1] = bfhi(a[i]); v[8 + 2 * i] = bflo(b[i]); v[8 + 2 * i + 1] = bfhi(b[i]); }
}
__device__ __forceinline__ void load16bf(const unsigned char* base, size_t elem, float (&v)[16]) {
    const u32x4* q = (const u32x4*)(base + elem * 2); unpack16(q[0], q[1], v);
}
__device__ __forceinline__ void store16bf(unsigned char* base, size_t elem, const float (&v)[16]) {
    u32x4 a, b;
#pragma unroll
    for (int i = 0; i < 4; ++i) { a[i] = pk2(v[2 * i], v[2 * i + 1]); b[i] = pk2(v[8 + 2 * i], v[8 + 2 * i + 1]); }
    u32x4* q = (u32x4*)(base + elem * 2); q[0] = a; q[1] = b;
}
__device__ __forceinline__ void load16f(const float* src, float (&v)[16]) {
#pragma unroll
    for (int j = 0; j < 4; ++j) { f32x4 t = ((const f32x4*)src)[j]; v[4 * j] = t[0]; v[4 * j + 1] = t[1]; v[4 * j + 2] = t[2]; v[4 * j + 3] = t[3]; }
}

constexpr int BM = 256, BK = 64, HALF = 128, HTB = HALF * BK * 2, STAGE_BYTES = 8 * HTB;
__device__ __forceinline__ int lds_byte(int r, int c) { const int st = (r >> 4) * 2 + (c >> 5), rr = r & 15, cc = c & 31, ob = rr * 64 + cc * 2; return st * 1024 + (ob ^ (((ob >> 9) & 1) << 5)); }
__device__ __forceinline__ void stage_rc(int b, int& R, int& C) { const int st = b / 1024, sb = b % 1024, swz = sb ^ (((sb >> 9) & 1) << 5); R = (st >> 1) * 16 + swz / 64; C = (st & 1) * 32 + (swz % 64) / 2; }
__device__ __forceinline__ int perm32(int rho) { const int n = rho >> 4, i = rho & 15; return 8 * (i >> 2) + 4 * n + (i & 3); }

enum { K_L1 = 0, K_L2, K_RES, K_U, K_CH, K_TD };
struct Unit { const char* A; const char* B; int pm, pn, job, s; };
struct GemmPh {
    int kind, nunits, lda, ldb, K, G, c;
    const char* A; const char* B;
    unsigned char* O; float* ss; const float* ssin; int ldo;
};

__device__ __forceinline__ void xcd_order(int L, int nM, int nN, int& pm, int& pn) {
    const int nwg = nM * nN; int wgid = L; { const int q = nwg / 8, r = nwg % 8, xcd = wgid % 8, off = wgid / 8; wgid = (xcd < r ? xcd * (q + 1) : r * (q + 1) + (xcd - r) * q) + off; }
    const int nig = 8 * nN, gid = wgid / nig, fm = gid * 8, gsz = (nM - fm) < 8 ? (nM - fm) : 8;
    pm = fm + ((wgid % nig) % gsz); pn = (wgid % nig) / gsz;
}
__device__ __forceinline__ bool next_unit(const GemmPh& P, const Params& p, const Ctx& cx, int i, Unit& u) {
    const long Lg = (long)i * P.G + P.c; if (Lg >= P.nunits) return false;
    const int L = (int)Lg; u.s = 0; u.job = 0;
    if (P.kind == K_L1) {
        int pm, jn; xcd_order(L, MT, 15, pm, jn); int job, pn;
        if (jn < 12) { job = jn >> 2; pn = jn & 3; } else { job = 3 + (jn - 12); pn = 0; }
        const int aslot = job == 0 ? 1 : job == 1 ? 3 : job == 2 ? 4 : job == 3 ? 6 : job == 4 ? 2 : 5;
        u.A = (const char*)slot(p, aslot) + (size_t)pm * 256 * 2048;
        const size_t boff = job < 3 ? O_WRKV + ((size_t)job * 1024 + pn * 256) * 2048 : job == 3 ? O_G1 : job == 4 ? O_W1 : O_A1;
        u.B = (const char*)p.ws + boff; u.pm = pm; u.pn = pn; u.job = job;
    } else if (P.kind == K_L2) {
        int pm, jn; xcd_order(L, MT, 20, pm, jn); const int job = jn < 16 ? 0 : 1, pn = jn < 16 ? jn : jn - 16;
        u.A = (const char*)slot(p, 10) + (job == 0 ? (size_t)RP * 512 : 0) + (size_t)pm * 256 * 512;
        u.B = (const char*)p.ws + (job == 0 ? O_L2 : O_G2) + (size_t)pn * 256 * 512; u.pm = pm; u.pn = pn; u.job = job;
    } else if (P.kind == K_RES) {
        int pm, pn; xcd_order(L, MT, 4, pm, pn);
        u.A = P.A + (size_t)pm * 256 * P.lda * 2; u.B = P.B + (size_t)pn * 256 * P.ldb * 2; u.pm = pm; u.pn = pn;
    } else if (P.kind == K_U) {
        int pm, pn; xcd_order(L, MT, 22, pm, pn);
        u.A = P.A + (size_t)pm * 256 * 2048; u.B = P.B + (size_t)pn * 256 * 2048; u.pm = pm; u.pn = pn;
    } else if (P.kind == K_CH) {
        int pn, pm; xcd_order(L, P.nunits >> 3, 8, pn, pm);
        u.A = P.A + (size_t)pm * 256 * 2048 + (pm & 3) * 512; u.B = (const char*)slot(p, pm < 4 ? 5 : 6) + (size_t)pn * 256 * 2048 + (pm & 3) * 512; u.pm = pm; u.pn = pn;
    } else {
        int rt, pn; xcd_order(L, cx.nseq * cx.tm, 4, rt, pn); const int s = rt / cx.tm, pm = rt % cx.tm;
        u.A = P.A + (size_t)(NMETA + pm * 256) * P.lda * 2; u.B = P.B + ((size_t)s * 1024 + pn * 256) * P.ldb * 2; u.pm = pm; u.pn = pn; u.s = s;
    }
    return true;
}

__device__ __forceinline__ void st8(unsigned char* ptr, const f32x4 a, const f32x4 b) {
    u32x4 o; o[0] = pk2(a[0], a[1]); o[1] = pk2(a[2], a[3]); o[2] = pk2(b[0], b[1]); o[3] = pk2(b[2], b[3]); *(u32x4*)ptr = o;
}
__device__ __forceinline__ float decaymap(float w) {
    const float e = 0.6065306597f * __builtin_amdgcn_rcpf(1.f + __expf(-w)); return __expf(-e) - 1.f;
}
__device__ __forceinline__ float act_apply(int act, float x) {
    if (act == 1) return __builtin_amdgcn_rcpf(1.f + __expf(-x));
    if (act == 2) return 1.f - 2.f * __builtin_amdgcn_rcpf(__expf(2.f * x) + 1.f);
    if (act == 3) return decaymap(x);
    return x;
}

__device__ __forceinline__ float rstd16(const float* ss, int r) {
    float s = 0.f;
#pragma unroll
    for (int i = 0; i < 16; ++i) s += ss[(size_t)i * RP + r];
    return rsqrtf(s * (1.f / 1024.f) + 1e-6f);
}
__device__ __forceinline__ void epilogue(const GemmPh& P, const Params& p, const Ctx& cx, const f32x4 (&acc)[2][2][4][2], const Unit& u, int wr, int wc, int fr, int fq) {
    const int rbase = u.pm * 256 + wr * 64 + fr, cbase = u.pn * 256 + wc * 32 + 8 * fq;
    if (P.kind == K_L1 || P.kind == K_L2) {
        unsigned char* O; int ldo = 1024, coff = 0, act = 0, cvalid = 1 << 30; const float* bias = nullptr;
        if (P.kind == K_L1) {
            if (u.job < 3) { O = slot(p, 7 + u.job); }
            else if (u.job == 3) { O = slot(p, 10); ldo = 256; act = 1; }
            else if (u.job == 4) { O = slot(p, 10) + (size_t)RP * 512; ldo = 256; act = 2; cvalid = 128; }
            else { O = slot(p, 10) + (size_t)RP * 512; ldo = 256; coff = 128; cvalid = 128; }
        } else {
            if (u.job == 1) { O = slot(p, 5); }
            else { const int cb = u.pn >> 2; O = slot(p, 1 + cb); bias = (cb < 2 ? p.in[8] : p.in[11]) + (cb & 1) * 1024 - cb * 1024; coff = -cb * 1024; act = cb < 2 ? 3 : 1; }
        }
        f32x4 bv[2][2];
#pragma unroll
        for (int bj = 0; bj < 2; ++bj)
#pragma unroll
            for (int n = 0; n < 2; ++n) bv[bj][n] = bias ? *(const f32x4*)(bias + cbase + bj * 128 + 4 * n) : (f32x4){0.f, 0.f, 0.f, 0.f};
#pragma unroll
        for (int ai = 0; ai < 2; ++ai)
#pragma unroll
            for (int m = 0; m < 4; ++m) { if ((m & 1) == 0) __builtin_amdgcn_sched_barrier(0);
#pragma unroll
                for (int bj = 0; bj < 2; ++bj) { const int r = rbase + ai * 128 + m * 16; const int c0 = cbase + bj * 128;
                    f32x4 v0 = acc[ai][bj][m][0] + bv[bj][0], v1 = acc[ai][bj][m][1] + bv[bj][1];
#pragma unroll
                    for (int i = 0; i < 4; ++i) { v0[i] = act_apply(act, v0[i]); v1[i] = act_apply(act, v1[i]); }
                    if (c0 < cvalid) st8(O + ((size_t)r * ldo + coff + c0) * 2, v0, v1); } }
    } else if (P.kind == K_RES) {
        unsigned char* H = P.O;
        u32x4 oldall[2][4][2];
#pragma unroll
        for (int ai = 0; ai < 2; ++ai)
#pragma unroll
            for (int m = 0; m < 4; ++m)
#pragma unroll
                for (int bj = 0; bj < 2; ++bj) oldall[ai][m][bj] = *(const u32x4*)(H + ((size_t)(rbase + ai * 128 + m * 16) * 1024 + cbase + bj * 128) * 2);
        __builtin_amdgcn_sched_barrier(0);
#pragma unroll
        for (int ai = 0; ai < 2; ++ai) {
#pragma unroll
            for (int m = 0; m < 4; ++m) { const int r = rbase + ai * 128 + m * 16; float sq = 0.f;
#pragma unroll
                for (int bj = 0; bj < 2; ++bj) { unsigned char* ptr = H + ((size_t)r * 1024 + cbase + bj * 128) * 2;
                    const u32x4 old = oldall[ai][m][bj]; u32x4 o; const f32x4 a0 = acc[ai][bj][m][0], a1 = acc[ai][bj][m][1];
                    o[0] = pk2(bflo(old[0]) + a0[0], bfhi(old[0]) + a0[1]); o[1] = pk2(bflo(old[1]) + a0[2], bfhi(old[1]) + a0[3]);
                    o[2] = pk2(bflo(old[2]) + a1[0], bfhi(old[2]) + a1[1]); o[3] = pk2(bflo(old[3]) + a1[2], bfhi(old[3]) + a1[3]);
#pragma unroll
                    for (int i = 0; i < 4; ++i) { const float rl = bflo(o[i]), rh = bfhi(o[i]); sq += rl * rl + rh * rh; }
                    *(u32x4*)ptr = o; }
                if (P.ss) { sq += __shfl_xor(sq, 16); sq += __shfl_xor(sq, 32); if (fq == 0) P.ss[(size_t)(u.pn * 4 + wc) * RP + r] = sq; } }
            __builtin_amdgcn_sched_barrier(0);
        }
    } else if (P.kind == K_U) {
        float rsv[2][4];
#pragma unroll
        for (int ai = 0; ai < 2; ++ai)
#pragma unroll
            for (int m = 0; m < 4; ++m) rsv[ai][m] = P.ssin[rbase + ai * 128 + m * 16];
        __builtin_amdgcn_sched_barrier(0);
#pragma unroll
        for (int ai = 0; ai < 2; ++ai)
#pragma unroll
            for (int m = 0; m < 4; ++m) { if ((m & 1) == 0) __builtin_amdgcn_sched_barrier(0); const int r = rbase + ai * 128 + m * 16; const float rs = rsv[ai][m];
#pragma unroll
                for (int bj = 0; bj < 2; ++bj) st8(P.O + ((size_t)r * 5632 + cbase + bj * 128) * 2, acc[ai][bj][m][0] * rs, acc[ai][bj][m][1] * rs); }
    } else if (P.kind == K_CH) {
#pragma unroll
        for (int bj = 0; bj < 2; ++bj) { const int n0 = cbase + bj * 128; const int s = n0 / cx.Tp, t = n0 - s * cx.Tp;
#pragma unroll
            for (int ai = 0; ai < 2; ++ai)
#pragma unroll
                for (int m = 0; m < 4; ++m) { if ((m & 1) == 0) __builtin_amdgcn_sched_barrier(0); const int rr = rbase + ai * 128 + m * 16; const int cs = rr >> 10, ch = rr & 1023;
                    st8(P.O + ((((size_t)s * 1024 + ch) * 2 + cs) * cx.Tp + t) * 2, acc[ai][bj][m][0], acc[ai][bj][m][1]); } }
    } else {
#pragma unroll
        for (int ai = 0; ai < 2; ++ai)
#pragma unroll
            for (int m = 0; m < 4; ++m) { if ((m & 1) == 0) __builtin_amdgcn_sched_barrier(0); const int k = NMETA + rbase + ai * 128 + m * 16; const size_t row = (size_t)u.s * cx.T + k;
#pragma unroll
                for (int bj = 0; bj < 2; ++bj) if (k < cx.T) st8(P.O + (row * 1024 + cbase + bj * 128) * 2, acc[ai][bj][m][0], acc[ai][bj][m][1]); }
    }
}

template <int KIND> __device__ __forceinline__ void gemm_phase(LAS unsigned char* lds, GemmPh P, const Params& p, const Ctx& cx) {
    P.kind = KIND;
    const int tid = ltid(), wid = __builtin_amdgcn_readfirstlane(tid >> 6), lane = tid & 63, wr = wid >> 2, wc = wid & 3, fr = lane & 15, fq = lane >> 4;
    const int nt = P.K / BK;
    unsigned voffA[2], voffB[2];
#pragma unroll
    for (int i = 0; i < 2; ++i) { int R, C; stage_rc(tid * 16 + i * 8192, R, C); const int Rb = (R & ~31) + perm32(R & 31);
        voffA[i] = (unsigned)(R * P.lda + C) * 2u; voffB[i] = (unsigned)(Rb * P.ldb + C) * 2u; }
    const size_t kstep = (size_t)(BK * 2);
    const size_t hstepA = (size_t)HALF * P.lda * 2, hstepB = (size_t)HALF * P.ldb * 2;
    const unsigned ldsw = (unsigned)wid * 1024u;
    const int aoff = lds_byte(wr * 64 + fr, fq * 8), boff = lds_byte(wc * 32 + fr, fq * 8);
#define PG8_SA(b, h) (((b) * 2 + (h)) * HTB)
#define PG8_SB(b, h) ((4 + (b) * 2 + (h)) * HTB)
#define PG8_STAGE(bufoff, gbase, voff) do { _Pragma("unroll") for (int _i = 0; _i < 2; ++_i) \
        __builtin_amdgcn_global_load_lds((const unsigned*)((const char*)(gbase) + (voff)[_i]), (LAS unsigned*)(lds + (bufoff) + ldsw + _i * 8192), 16, 0, 0); } while (0)
#define PG8_LDA(dst, b, h) do { _Pragma("unroll") for (int m = 0; m < 4; ++m) _Pragma("unroll") for (int k = 0; k < 2; ++k) dst[m][k] = *(const LAS bf16x8*)(lds + PG8_SA(b, h) + aoff + m * 2048 + k * 1024); } while (0)
#define PG8_LDB(dst, b, h) do { _Pragma("unroll") for (int n = 0; n < 2; ++n) _Pragma("unroll") for (int k = 0; k < 2; ++k) dst[n][k] = *(const LAS bf16x8*)(lds + PG8_SB(b, h) + boff + n * 2048 + k * 1024); } while (0)
#define PG8_MMA(ai, bj, At, Bt) do { __builtin_amdgcn_s_setprio(1); _Pragma("unroll") for (int m = 0; m < 4; ++m) _Pragma("unroll") for (int n = 0; n < 2; ++n) _Pragma("unroll") for (int k = 0; k < 2; ++k) \
        acc[ai][bj][m][n] = __builtin_amdgcn_mfma_f32_16x16x32_bf16(Bt[n][k], At[m][k], acc[ai][bj][m][n], 0, 0, 0); __builtin_amdgcn_s_setprio(0); } while (0)
#define PG8_WAIT_V(n) asm volatile("s_waitcnt vmcnt(" #n ")" ::: "memory")
#define PG8_WAIT_L(n) asm volatile("s_waitcnt lgkmcnt(" #n ")" ::: "memory")
#define PG8_BAR __builtin_amdgcn_s_barrier()
#define PG8_SCHED __builtin_amdgcn_sched_barrier(0)
    Unit cur, nxt; int ui = 0;
    if (!next_unit(P, p, cx, 0, cur)) return;
    f32x4 acc[2][2][4][2];
#pragma unroll
    for (int a = 0; a < 2; ++a)
#pragma unroll
        for (int b = 0; b < 2; ++b)
#pragma unroll
            for (int m = 0; m < 4; ++m)
#pragma unroll
                for (int n = 0; n < 2; ++n) acc[a][b][m][n] = (f32x4){0.f, 0.f, 0.f, 0.f};
    bf16x8 At[4][2], B0[2][2], B1[2][2];
    const char* cA = cur.A; const char* cB = cur.B;
    PG8_STAGE(PG8_SB(0, 0), cB, voffB); PG8_STAGE(PG8_SA(0, 0), cA, voffA); PG8_STAGE(PG8_SB(0, 1), cB + hstepB, voffB); PG8_STAGE(PG8_SA(0, 1), cA + hstepA, voffA);
    if (wr == 1) PG8_BAR;
    PG8_WAIT_V(4); PG8_BAR;
    PG8_STAGE(PG8_SB(1, 0), cB + kstep, voffB); PG8_STAGE(PG8_SA(1, 0), cA + kstep, voffA); PG8_STAGE(PG8_SB(1, 1), cB + hstepB + kstep, voffB);
    PG8_WAIT_V(6); PG8_BAR;
    for (;;) {
        const bool has_next = next_unit(P, p, cx, ui + 1, nxt);
        const char* nA = has_next ? nxt.A : cA; const char* nB = has_next ? nxt.B : cB;
        for (int t = 0; t < nt; t += 2) {
            const bool last = (t == nt - 2);
            const char* a1 = cA + (size_t)(t + 1) * kstep;
            const char* a2 = last ? nA : cA + (size_t)(t + 2) * kstep; const char* b2 = last ? nB : cB + (size_t)(t + 2) * kstep;
            const char* a3 = a2 + kstep; const char* b3 = b2 + kstep;
            PG8_LDB(B0, 0, 0); PG8_SCHED; PG8_LDA(At, 0, 0); PG8_STAGE(PG8_SA(1, 1), a1 + hstepA, voffA);
            PG8_WAIT_L(8); PG8_BAR; PG8_WAIT_L(0); PG8_MMA(0, 0, At, B0); PG8_BAR; PG8_SCHED;
            PG8_LDB(B1, 0, 1); PG8_STAGE(PG8_SB(0, 0), b2, voffB);
            PG8_BAR; PG8_WAIT_L(0); PG8_MMA(0, 1, At, B1); PG8_BAR;
            PG8_LDA(At, 0, 1); PG8_STAGE(PG8_SA(0, 0), a2, voffA);
            PG8_BAR; PG8_WAIT_L(0); PG8_MMA(1, 0, At, B0); PG8_BAR; PG8_SCHED;
            PG8_STAGE(PG8_SB(0, 1), b2 + hstepB, voffB);
            PG8_WAIT_V(6); PG8_BAR; PG8_MMA(1, 1, At, B1); PG8_BAR;
            PG8_LDB(B0, 1, 0); PG8_SCHED; PG8_LDA(At, 1, 0); PG8_STAGE(PG8_SA(0, 1), a2 + hstepA, voffA);
            PG8_WAIT_L(8); PG8_BAR; PG8_WAIT_L(0); PG8_MMA(0, 0, At, B0); PG8_BAR; PG8_SCHED;
            PG8_LDB(B1, 1, 1); PG8_STAGE(PG8_SB(1, 0), b3, voffB);
            PG8_BAR; PG8_WAIT_L(0); PG8_MMA(0, 1, At, B1); PG8_BAR;
            PG8_LDA(At, 1, 1); PG8_STAGE(PG8_SA(1, 0), a3, voffA);
            PG8_BAR; PG8_WAIT_L(0); PG8_MMA(1, 0, At, B0); PG8_BAR; PG8_SCHED;
            PG8_STAGE(PG8_SB(1, 1), b3 + hstepB, voffB);
            PG8_WAIT_V(6); PG8_BAR; PG8_MMA(1, 1, At, B1); PG8_BAR;
        }
        epilogue(P, p, cx, acc, cur, wr, wc, fr, fq);
        if (!has_next) break;
#pragma unroll
        for (int a = 0; a < 2; ++a)
#pragma unroll
            for (int b = 0; b < 2; ++b)
#pragma unroll
                for (int m = 0; m < 4; ++m)
#pragma unroll
                    for (int n = 0; n < 2; ++n) acc[a][b][m][n] = (f32x4){0.f, 0.f, 0.f, 0.f};
        cur = nxt; cA = nA; cB = nB; ++ui;
    }
    PG8_WAIT_V(0);
    if (wr == 0) PG8_BAR;
    PG8_BAR;
#undef PG8_SA
#undef PG8_SB
#undef PG8_STAGE
#undef PG8_LDA
#undef PG8_LDB
#undef PG8_MMA
#undef PG8_WAIT_V
#undef PG8_WAIT_L
#undef PG8_BAR
#undef PG8_SCHED
}

__device__ __forceinline__ void tr_job(LAS float* tile, const float* src, int K, int N, unsigned char* dst, int ldk, int koff, int Kpad, int Npad, const float* scale, int& cnt, int stride_start, int G) {
    const int tk = Kpad / 64, tn = Npad / 64, ntile = tk * tn; const int tid = ltid();
    for (int it = 0; it < ntile; ++it, ++cnt) {
        if ((cnt % G) != stride_start) continue;
        const int k0 = (it / tn) * 64, n0 = (it % tn) * 64;
        __syncthreads();
        { const int tx = tid & 63, ty = tid >> 6;
#pragma unroll
            for (int i = 0; i < 8; ++i) { const int kd = k0 + ty + 8 * i, ks = kd - koff, n = n0 + tx; float v = 0.f;
                if (ks >= 0 && ks < K && n < N) { v = src[(size_t)ks * N + n]; if (scale) v *= scale[ks]; }
                tile[(ty + 8 * i) * 65 + tx] = v; } }
        __syncthreads();
        { const int n = tid >> 3, kc = (tid & 7) * 8; u32x4 o;
#pragma unroll
            for (int i = 0; i < 4; ++i) o[i] = pk2(tile[(kc + 2 * i) * 65 + n], tile[(kc + 2 * i + 1) * 65 + n]);
            *(u32x4*)(dst + ((size_t)(n0 + n) * ldk + k0 + kc) * 2) = o; }
    }
}

__device__ __forceinline__ void prep_phase(LAS unsigned char* lds, const Params& p) {
    LAS float* tile = (LAS float*)lds; unsigned char* ws = p.ws; int cnt = 0; const int b = blockIdx.x, G = gridDim.x;
    for (int i = 0; i < 3; ++i) tr_job(tile, p.in[7] + (size_t)i * D * D, D, D, ws + O_WRKV + (size_t)i * D * D * 2, 1024, 0, 1024, 1024, nullptr, cnt, b, G);
    tr_job(tile, p.in[14], D, 160, ws + O_G1, 1024, 0, 1024, 256, nullptr, cnt, b, G);
    tr_job(tile, p.in[9], D, 64, ws + O_W1, 1024, 0, 1024, 64, nullptr, cnt, b, G);
    tr_job(tile, p.in[9] + D * 64, D, 64, ws + O_W1 + (size_t)64 * 1024 * 2, 1024, 0, 1024, 192, nullptr, cnt, b, G);
    tr_job(tile, p.in[12], D, 64, ws + O_A1, 1024, 0, 1024, 64, nullptr, cnt, b, G);
    tr_job(tile, p.in[12] + D * 64, D, 64, ws + O_A1 + (size_t)64 * 1024 * 2, 1024, 0, 1024, 192, nullptr, cnt, b, G);
    for (int z = 0; z < 2; ++z) {
        tr_job(tile, p.in[10] + (size_t)z * 64 * D, 64, D, ws + O_L2 + (size_t)z * 1024 * 256 * 2, 256, z * 64, 256, 1024, nullptr, cnt, b, G);
        tr_job(tile, p.in[13] + (size_t)z * 64 * D, 64, D, ws + O_L2 + (size_t)(2 + z) * 1024 * 256 * 2, 256, (2 + z) * 64, 256, 1024, nullptr, cnt, b, G);
    }
    tr_job(tile, p.in[15], 160, D, ws + O_G2, 256, 0, 256, 1024, nullptr, cnt, b, G);
    tr_job(tile, p.in[21], D, D, ws + O_WO, 1024, 0, 1024, 1024, nullptr, cnt, b, G);
    tr_job(tile, p.in[22], D, D, ws + O_WF, 1024, 0, 1024, 1024, nullptr, cnt, b, G);
    for (int l = 0; l < 2; ++l) {
        tr_job(tile, p.in[23] + (size_t)l * D * 5632, D, 5632, ws + O_WIN + (size_t)l * 5632 * 1024 * 2, 1024, 0, 1024, 5632, p.in[4] + l * D, cnt, b, G);
        tr_job(tile, p.in[26] + (size_t)l * DFF * D, DFF, D, ws + O_WOUT + (size_t)l * 1024 * DFF * 2, DFF, 0, DFF, 1024, nullptr, cnt, b, G);
    }
    const size_t gt = (size_t)blockIdx.x * 512 + ltid(), NT = (size_t)gridDim.x * 512;
    const float* nm1 = p.in[3] + D;
    for (size_t e = gt; e < (size_t)2048 * 128; e += NT) {
        const int rr = (int)(e >> 7), c0 = (int)(e & 127) * 8; const int cs = rr >> 10, ch = rr & 1023; float v[8];
#pragma unroll
        for (int i = 0; i < 8; ++i) { const int c = c0 + i; float val = 0.f;
            if ((c >> 7) == (ch >> 7)) { const int m = ((ch & 127) * (c & 127)) & 127; float sn, cn; sincospif((float)m * (1.f / 64.f), &sn, &cn); val = (cs ? sn : cn) * nm1[c] * 0.08838834764831845f; }
            v[i] = val; }
        u32x4 o; o[0] = pk2(v[0], v[1]); o[1] = pk2(v[2], v[3]); o[2] = pk2(v[4], v[5]); o[3] = pk2(v[6], v[7]);
        *(u32x4*)(ws + O_CHD + e * 16) = o;
    }
    for (int ty = 0; ty < 2; ++ty) {
        const int T = ty ? 4112 : 2064, Tp = ty ? TP_S : TP_P, Mp = ty ? MP_S : MP_P; const int rowv = 2 * Tp / 8;
        unsigned char* dst = ws + (ty ? O_DFTS : O_DFTP); const float isq = rsqrtf((float)T), invT = 2.f / (float)T;
        for (size_t e = gt; e < (size_t)Mp * rowv; e += NT) {
            const int k = (int)(e / rowv), kk0 = (int)(e % rowv) * 8; float v[8];
#pragma unroll
            for (int i = 0; i < 8; ++i) { const int kk = kk0 + i; const int issin = kk >= Tp, t = issin ? kk - Tp : kk; float val = 0.f;
                if (k < T && (issin ? (t >= 1 && t <= T / 2 - 1) : (t <= T / 2))) { const int m = (int)(((long)k * t) % T); float sn, cn; sincospif((float)m * invT, &sn, &cn); val = (issin ? -sn : cn) * isq; }
                v[i] = val; }
            u32x4 o; o[0] = pk2(v[0], v[1]); o[1] = pk2(v[2], v[3]); o[2] = pk2(v[4], v[5]); o[3] = pk2(v[6], v[7]);
            *(u32x4*)(dst + e * 16) = o;
        }
    }
}

__device__ __forceinline__ void ea_load_row(const Params& p, const Ctx& c, int s, int pos, int lane, float (&v)[16]) {
    if (pos < 0 || pos >= c.T) {
#pragma unroll
        for (int i = 0; i < 16; ++i) v[i] = 0.f;
        return; }
    const float* src = pos < NMETA ? p.in[2] + (size_t)pos * D : c.x + ((size_t)s * (c.T - NMETA) + (pos - NMETA)) * D;
#pragma unroll
    for (int j = 0; j < 2; ++j) { const f32x4 t = *(const f32x4*)(src + j * 512 + lane * 8), t2 = *(const f32x4*)(src + j * 512 + lane * 8 + 4);
        v[8 * j] = t[0]; v[8 * j + 1] = t[1]; v[8 * j + 2] = t[2]; v[8 * j + 3] = t[3]; v[8 * j + 4] = t2[0]; v[8 * j + 5] = t2[1]; v[8 * j + 6] = t2[2]; v[8 * j + 7] = t2[3]; }
}
__device__ __forceinline__ void ea_store_row(unsigned char* base, size_t row, int lane, const float (&v)[16]) {
#pragma unroll
    for (int j = 0; j < 2; ++j) { u32x4 o; o[0] = pk2(v[8 * j], v[8 * j + 1]); o[1] = pk2(v[8 * j + 2], v[8 * j + 3]); o[2] = pk2(v[8 * j + 4], v[8 * j + 5]); o[3] = pk2(v[8 * j + 6], v[8 * j + 7]);
        *(u32x4*)(base + (row * 1024 + j * 512 + lane * 8) * 2) = o; }
}
__device__ __forceinline__ void ea_norm(float (&v)[16], const float (&nw)[16]) {
    float ss = 0.f;
#pragma unroll
    for (int i = 0; i < 16; ++i) ss += v[i] * v[i];
    ss = wave_sum(ss); const float rs = rsqrtf(ss * (1.f / 1024.f) + 1e-6f);
#pragma unroll
    for (int i = 0; i < 16; ++i) v[i] = v[i] * rs * nw[i];
}
__device__ __forceinline__ void phase_mix(const Params& p, const Ctx& c) {
    const int wave = __builtin_amdgcn_readfirstlane(ltid() >> 6), lane = ltid() & 63;
    const int gw = blockIdx.x * 8 + wave, NW = gridDim.x * 8;
    float nw[16];
#pragma unroll
    for (int j = 0; j < 4; ++j) { const f32x4 t = *(const f32x4*)(p.in[3] + (j >> 1) * 512 + lane * 8 + (j & 1) * 4); nw[4 * j] = t[0]; nw[4 * j + 1] = t[1]; nw[4 * j + 2] = t[2]; nw[4 * j + 3] = t[3]; }
    const int nstrips = c.R / 16, spq = c.T / 16;
    for (int st = gw; st < nstrips; st += NW) {
        const int s = st / spq, pos0 = (st - s * spq) * 16; const size_t row0 = (size_t)st * 16;
        float prev[16], cur[16], nx[16];
        ea_load_row(p, c, s, pos0 - 1, lane, prev); ea_norm(prev, nw);
        ea_load_row(p, c, s, pos0, lane, cur); ea_store_row(slot(p, 0), row0, lane, cur); ea_norm(cur, nw);
        float ah[16];
        ea_load_row(p, c, s, pos0 + 1, lane, ah);
        for (int i = 0; i < 16; ++i) {
#pragma unroll
            for (int e = 0; e < 16; ++e) nx[e] = ah[e];
            if (i < 15) ea_load_row(p, c, s, pos0 + i + 2, lane, ah);
            if (i < 15) ea_store_row(slot(p, 0), row0 + i + 1, lane, nx);
            ea_norm(nx, nw);
            float xx[16], o[16];
#pragma unroll
            for (int e = 0; e < 16; ++e) xx[e] = 0.5f * (prev[e] + nx[e]) - cur[e];
            for (int m = 0; m < 6; ++m) {
#pragma unroll
                for (int j = 0; j < 4; ++j) { const f32x4 t = *(const f32x4*)(p.in[6] + m * D + (j >> 1) * 512 + lane * 8 + (j & 1) * 4);
#pragma unroll
                    for (int e = 0; e < 4; ++e) o[4 * j + e] = cur[4 * j + e] + xx[4 * j + e] * t[e]; }
                ea_store_row(slot(p, 1 + m), row0 + i, lane, o); }
#pragma unroll
            for (int e = 0; e < 16; ++e) { prev[e] = cur[e]; cur[e] = nx[e]; }
        }
    }
}

__device__ __forceinline__ void ld2(const unsigned char* base, size_t elem, u32x4 (&d)[2]) { const u32x4* q = (const u32x4*)(base + elem * 2); d[0] = q[0]; d[1] = q[1]; }
__device__ __forceinline__ void phase_prescan(const Params& p, const Ctx& c) {
    const int wave = __builtin_amdgcn_readfirstlane(ltid() >> 6), lane = ltid() & 63;
    const int gw = blockIdx.x * 8 + wave, NW = gridDim.x * 8; const int ch0 = lane * 16;
    float kkw[16], kaw[16], rkw[16];
    load16f(p.in[16] + ch0, kkw); load16f(p.in[17] + ch0, kaw); load16f(p.in[18] + ch0, rkw);
    float* bonus = (float*)(p.ws + O_BONUS);
    u32x4 nk[2], na0[2], na1[2], nr[2];
    if (gw < c.R) { const size_t e = (size_t)gw * 1024 + ch0; ld2(slot(p, 8), e, nk); ld2(slot(p, 3), e, na0); ld2(slot(p, 4), e, na1); ld2(slot(p, 7), e, nr); }
    for (int row = gw; row < c.R; row += NW) {
        const size_t e = (size_t)row * 1024 + ch0;
        float k[16], a0[16], a1[16], r[16];
        unpack16(nk[0], nk[1], k); unpack16(na0[0], na0[1], a0); unpack16(na1[0], na1[1], a1); unpack16(nr[0], nr[1], r);
        if (row + NW < c.R) { const size_t e2 = (size_t)(row + NW) * 1024 + ch0; ld2(slot(p, 8), e2, nk); ld2(slot(p, 3), e2, na0); ld2(slot(p, 4), e2, na1); ld2(slot(p, 7), e2, nr); }
        float kk[16], n2 = 0.f;
#pragma unroll
        for (int i = 0; i < 16; ++i) { kk[i] = k[i] * kkw[i]; n2 += kk[i] * kk[i]; }
        n2 += __shfl_xor(n2, 1); n2 += __shfl_xor(n2, 2);
        const float inv = 1.f / fmaxf(sqrtf(n2), 1e-12f);
        float kd0[16], kd1[16], bon = 0.f;
#pragma unroll
        for (int i = 0; i < 16; ++i) { kk[i] *= inv; kd0[i] = k[i] * (1.f + (a0[i] - 1.f) * kaw[i]); kd1[i] = k[i] * (1.f + (a1[i] - 1.f) * kaw[i]);
            bon += r[i] * (kd0[i] + kd1[i]) * rkw[i]; a0[i] *= kk[i]; a1[i] *= kk[i]; }
        bon += __shfl_xor(bon, 1); bon += __shfl_xor(bon, 2);
        if ((lane & 3) == 0) bonus[(size_t)row * 16 + (lane >> 2)] = bon;
        store16bf(slot(p, 8), e, kk); store16bf(slot(p, 3), e, a0); store16bf(slot(p, 4), e, a1);
        store16bf(slot(p, 6), e, kd0); store16bf(slot(p, 10), e, kd1);
    }
}

__device__ __forceinline__ float half_sum(float x) {
    const unsigned a = __float_as_uint(x); auto r = __builtin_amdgcn_permlane32_swap(a, a, false, false);
    return __uint_as_float(r[0]) + __uint_as_float(r[1]);
}
__device__ __forceinline__ float ldbf(const unsigned char* base, int idx) { return __uint_as_float(((unsigned)((const bf16_t*)base)[idx]) << 16); }
__device__ __forceinline__ float quarter_sum(float x) {
    const unsigned a = __float_as_uint(x); auto r = __builtin_amdgcn_permlane16_swap(a, a, false, false);
    return half_sum(__uint_as_float(r[0]) + __uint_as_float(r[1]));
}
template <int RPL, int JP, int RING>
__device__ __forceinline__ void scan_items(LAS unsigned char* lds, const Params& p, const Ctx& c) {
    constexpr int LR = 64 / JP, NJ = 64 / JP, ROWS = LR * RPL, WPS = 64 / ROWS, NQ = NJ / 4, BQ = RPL == 2 ? 1 : 2, NB = NQ / BQ;
    const int tid = ltid(); const int wave = __builtin_amdgcn_readfirstlane(tid >> 6), lane = tid & 63;
    const int nitem = c.nseq * 32 * WPS; const int lr = lane % LR, jp = lane / LR;
    LAS float* wb = (LAS float*)(lds + wave * 16384);
    LAS float* oring = wb + 1024;
    for (int w = blockIdx.x + gridDim.x * wave; w < nitem; w += gridDim.x * 8) {
        const int q = w / WPS, rq = w % WPS; const int dir = q & 1, hh = (q >> 1) & 15, s = q >> 5;
        const size_t e0 = (size_t)s * c.T * 1024 + hh * 64;
        const unsigned char* Rb = slot(p, 7) + e0 * 2; const unsigned char* Kkb = slot(p, 8) + e0 * 2; const unsigned char* Vb = slot(p, 9) + e0 * 2;
        const unsigned char* Ngb = slot(p, 1 + dir) + e0 * 2; const unsigned char* Bdb = slot(p, 3 + dir) + e0 * 2;
        const unsigned char* Kdb = slot(p, dir ? 10 : 6) + e0 * 2; unsigned char* Ob = slot(p, 11 + dir) + e0 * 2;
        const int vec = lane >> 3, chunk = lane & 7;
        const unsigned char* lb = (vec == 0 ? Kkb : vec == 1 ? Ngb : vec == 2 ? Bdb : vec == 3 ? Kdb : vec == 4 ? Rb : Vb) + chunk * 16;
        const int vrow0 = rq * ROWS + lr;
        const int step = dir ? -2048 : 2048; const long ro0 = dir ? (long)(c.T - 1) * 2048 : 0;
        f32x2 S2[RPL][NJ / 2];
#pragma unroll
        for (int a_ = 0; a_ < RPL; ++a_)
#pragma unroll
            for (int j = 0; j < NJ / 2; ++j) S2[a_][j] = (f32x2){0.f, 0.f};
        u32x4 xr[RING];
#define SCAN_LD(dst, tt) do { const int _t = (tt) < c.T ? (tt) : c.T - 1; const long _r = ro0 + (long)_t * step; dst = *(const u32x4*)(lb + _r); } while (0)
#define SCAN_PARK(x, buf) do { if (vec < 6) { f32x4 _lo, _hi; _lo[0] = bflo(x[0]); _lo[1] = bfhi(x[0]); _lo[2] = bflo(x[1]); _lo[3] = bfhi(x[1]); _hi[0] = bflo(x[2]); _hi[1] = bfhi(x[2]); _hi[2] = bflo(x[3]); _hi[3] = bfhi(x[3]); \
            LAS f32x4* _d = (LAS f32x4*)((buf) + vec * 64 + chunk * 8); _d[0] = _lo; _d[1] = _hi; } } while (0)
#define SCAN_RD4(dst, base, jj) do { _Pragma("unroll") for (int _h = 0; _h < BQ; ++_h) { dst[4 * _h] = ((const LAS f32x4*)((base) + 64))[(jj) + _h]; dst[4 * _h + 1] = ((const LAS f32x4*)((base) + 128))[(jj) + _h]; \
            dst[4 * _h + 2] = ((const LAS f32x4*)((base) + 192))[(jj) + _h]; dst[4 * _h + 3] = ((const LAS f32x4*)((base) + 256))[(jj) + _h]; } } while (0)
        float vi[RPL];
        { u32x4 x; SCAN_LD(x, 0); SCAN_PARK(x, wb); }
#pragma unroll
        for (int k = 1; k < RING; ++k) SCAN_LD(xr[k], k);
        SCAN_LD(xr[0], RING);
        f32x4 kq[NQ];
#pragma unroll
        for (int j = 0; j < NQ; ++j) kq[j] = ((const LAS f32x4*)(wb + jp * NJ))[j];
#pragma unroll
        for (int a_ = 0; a_ < RPL; ++a_) vi[a_] = wb[320 + vrow0 + a_ * LR];
        int fstart = 0;
        for (int tb = 0; tb < c.T; tb += RING) {
#pragma unroll
            for (int k = 0; k < RING; ++k) {
                const int t = tb + k;
                const LAS float* sb = wb + (k & 1) * 512 + jp * NJ; LAS float* sn = wb + ((k + 1) & 1) * 512;
                f32x4 PQ[2][4 * BQ];
                SCAN_RD4(PQ[0], sb, 0);
                __builtin_amdgcn_sched_barrier(0);
                float sa[RPL];
#pragma unroll
                for (int a_ = 0; a_ < RPL; ++a_) { f32x2 a0 = (f32x2){0.f, 0.f}, a1 = (f32x2){0.f, 0.f};
#pragma unroll
                    for (int j = 0; j < NQ; ++j) { a0 = __builtin_elementwise_fma(S2[a_][2 * j], (f32x2){kq[j][0], kq[j][1]}, a0); a1 = __builtin_elementwise_fma(S2[a_][2 * j + 1], (f32x2){kq[j][2], kq[j][3]}, a1); }
                    sa[a_] = (a0[0] + a0[1]) + (a1[0] + a1[1]); }
                u32x4& xs = xr[(k + 1) % RING];
                SCAN_PARK(xs, sn);
                float vcur[RPL];
#pragma unroll
                for (int a_ = 0; a_ < RPL; ++a_) vcur[a_] = vi[a_];
                SCAN_LD(xs, t + 1 + RING);
                f32x2 sa2[RPL], v2[RPL], oa0[RPL], oa1[RPL];
#pragma unroll
                for (int a_ = 0; a_ < RPL; ++a_) { const float sr = -(JP == 2 ? half_sum(sa[a_]) : quarter_sum(sa[a_])); sa2[a_] = (f32x2){sr, sr}; v2[a_] = (f32x2){vcur[a_], vcur[a_]};
                    oa0[a_] = (f32x2){0.f, 0.f}; oa1[a_] = (f32x2){0.f, 0.f}; }
#pragma unroll
                for (int b_ = 0; b_ < NB; ++b_) {
                    if (b_ + 1 < NB) { SCAN_RD4(PQ[(b_ + 1) & 1], sb, BQ * (b_ + 1)); }
                    else {
#pragma unroll
                        for (int j = 0; j < NQ; ++j) kq[j] = ((const LAS f32x4*)(sn + jp * NJ))[j];
#pragma unroll
                        for (int a_ = 0; a_ < RPL; ++a_) vi[a_] = sn[320 + vrow0 + a_ * LR];
                    }
                    __builtin_amdgcn_sched_barrier(0);
#pragma unroll
                    for (int h_ = 0; h_ < BQ; ++h_) { const f32x4 g4 = PQ[b_ & 1][4 * h_], b4 = PQ[b_ & 1][4 * h_ + 1], d4 = PQ[b_ & 1][4 * h_ + 2], r4 = PQ[b_ & 1][4 * h_ + 3]; const int j_ = 2 * (BQ * b_ + h_);
#pragma unroll
                        for (int a_ = 0; a_ < RPL; ++a_) { f32x2 s0 = S2[a_][j_], s1 = S2[a_][j_ + 1];
                            s0 = __builtin_elementwise_fma(s0, (f32x2){g4[0], g4[1]}, s0); s1 = __builtin_elementwise_fma(s1, (f32x2){g4[2], g4[3]}, s1);
                            s0 = __builtin_elementwise_fma(sa2[a_], (f32x2){b4[0], b4[1]}, s0); s1 = __builtin_elementwise_fma(sa2[a_], (f32x2){b4[2], b4[3]}, s1);
                            s0 = __builtin_elementwise_fma(v2[a_], (f32x2){d4[0], d4[1]}, s0); s1 = __builtin_elementwise_fma(v2[a_], (f32x2){d4[2], d4[3]}, s1);
                            S2[a_][j_] = s0; S2[a_][j_ + 1] = s1;
                            oa0[a_] = __builtin_elementwise_fma(s0, (f32x2){r4[0], r4[1]}, oa0[a_]); oa1[a_] = __builtin_elementwise_fma(s1, (f32x2){r4[2], r4[3]}, oa1[a_]); } }
                    __builtin_amdgcn_sched_barrier(0);
                }
#pragma unroll
                for (int a_ = 0; a_ < RPL; ++a_) { const float os_ = (oa0[a_][0] + oa0[a_][1]) + (oa1[a_][0] + oa1[a_][1]); const float ov = JP == 2 ? half_sum(os_) : quarter_sum(os_);
                    if (jp == 0) oring[(t & 63) * ROWS + a_ * LR + lr] = ov; }
            }
            const int tend = tb + RING, nfl = tend - fstart;
            if (nfl == 64 || tend >= c.T) {
                for (int idx = lane; idx < nfl * ROWS; idx += 64) { const int st = idx / ROWS, row = idx % ROWS;
                    ((bf16_t*)(Ob + ro0 + (long)(fstart + st) * step))[rq * ROWS + row] = (bf16_t)(pk2(oring[idx], 0.f) & 0xffffu); }
                fstart = tend;
            }
        }
#undef SCAN_LD
#undef SCAN_PARK
#undef SCAN_RD4
    }
}
__device__ __forceinline__ void phase_scan(LAS unsigned char* lds, const Params& p, const Ctx& c) {
    if (c.g < 2) scan_items<2, 4, 8>(lds, p, c); else scan_items<1, 4, 8>(lds, p, c);
}

__device__ __forceinline__ void phase_postscan(const Params& p, const Ctx& c) {
    const int wave = __builtin_amdgcn_readfirstlane(ltid() >> 6), lane = ltid() & 63;
    const int gw = blockIdx.x * 8 + wave, NW = gridDim.x * 8; const int ch0 = lane * 16;
    float gw_[16], gb_[16]; load16f(p.in[19] + ch0, gw_); load16f(p.in[20] + ch0, gb_);
    const float* bonus = (const float*)(p.ws + O_BONUS);
    u32x4 nf[2], nb[2], nv[2], ng[2];
    if (gw < c.R) { const size_t e = (size_t)gw * 1024 + ch0; ld2(slot(p, 11), e, nf); ld2(slot(p, 12), e, nb); ld2(slot(p, 9), e, nv); ld2(slot(p, 5), e, ng); }
    for (int row = gw; row < c.R; row += NW) {
        const size_t e = (size_t)row * 1024 + ch0;
        float of[16], ob[16], v[16], g[16];
        unpack16(nf[0], nf[1], of); unpack16(nb[0], nb[1], ob); unpack16(nv[0], nv[1], v); unpack16(ng[0], ng[1], g);
        if (row + NW < c.R) { const size_t e2 = (size_t)(row + NW) * 1024 + ch0; ld2(slot(p, 11), e2, nf); ld2(slot(p, 12), e2, nb); ld2(slot(p, 9), e2, nv); ld2(slot(p, 5), e2, ng); }
        float sum = 0.f;
#pragma unroll
        for (int i = 0; i < 16; ++i) { of[i] += ob[i]; sum += of[i]; }
        sum += __shfl_xor(sum, 1); sum += __shfl_xor(sum, 2); const float mean = sum * (1.f / 64.f);
        float var = 0.f;
#pragma unroll
        for (int i = 0; i < 16; ++i) { of[i] -= mean; var += of[i] * of[i]; }
        var += __shfl_xor(var, 1); var += __shfl_xor(var, 2); const float rs = rsqrtf(var * (1.f / 64.f) + 64e-5f);
        const float bon = bonus[(size_t)row * 16 + (lane >> 2)];
#pragma unroll
        for (int i = 0; i < 16; ++i) of[i] = (of[i] * rs * gw_[i] + gb_[i] + bon * v[i]) * g[i];
        store16bf(slot(p, 1), e, of);
    }
}

__device__ __forceinline__ void phase_glu(const Params& p, const Ctx& c, int layer) {
    const size_t gt = (size_t)blockIdx.x * 512 + ltid(), NT = (size_t)gridDim.x * 512;
    const unsigned char* U = slot(p, 1); unsigned char* Aout = slot(p, 7);
    const float* cw = p.in[24] + (size_t)layer * 3 * DFF; const float* cb = p.in[25] + (size_t)layer * DFF;
    const size_t nitem = (size_t)(c.R / 16) * 352;
    for (size_t it = gt; it < nitem; it += NT) {
        const int strip = (int)(it / 352), cc = (int)(it % 352) * 8; const int row0 = strip * 16, pos0 = row0 % c.T;
        float w0[8], w1[8], w2[8], bb[8];
#pragma unroll
        for (int h = 0; h < 2; ++h) { const f32x4 a = *(const f32x4*)(cw + cc + 4 * h), b = *(const f32x4*)(cw + DFF + cc + 4 * h), d = *(const f32x4*)(cw + 2 * DFF + cc + 4 * h), e = *(const f32x4*)(cb + cc + 4 * h);
#pragma unroll
            for (int i = 0; i < 4; ++i) { w0[4 * h + i] = a[i]; w1[4 * h + i] = b[i]; w2[4 * h + i] = d[i]; bb[4 * h + i] = e[i]; } }
        const unsigned char* ur = U + (size_t)row0 * 5632 * 2 + cc * 2;
        const u32x4 z = (u32x4){0u, 0u, 0u, 0u};
        u32x4 pm = pos0 > 0 ? *(const u32x4*)(ur - 5632 * 2) : z, pc = *(const u32x4*)ur;
        for (int i0 = 0; i0 < 16; i0 += 4) {
            u32x4 PP[4], LN[4];
#pragma unroll
            for (int j = 0; j < 4; ++j) { PP[j] = (pos0 + i0 + j < c.T - 1) ? *(const u32x4*)(ur + (size_t)(j + 1) * 5632 * 2) : z; LN[j] = *(const u32x4*)(ur + (size_t)j * 5632 * 2 + DFF * 2); }
#pragma unroll
            for (int j = 0; j < 4; ++j) { const u32x4 pp = PP[j], ln = LN[j]; u32x4 o;
#pragma unroll
                for (int e = 0; e < 4; ++e) {
                    const float c0 = bflo(pm[e]) * w0[2 * e] + bflo(pc[e]) * w1[2 * e] + bflo(pp[e]) * w2[2 * e] + bb[2 * e];
                    const float c1 = bfhi(pm[e]) * w0[2 * e + 1] + bfhi(pc[e]) * w1[2 * e + 1] + bfhi(pp[e]) * w2[2 * e + 1] + bb[2 * e + 1];
                    o[e] = pk2(c0 * sigmoidf_(c0) * bflo(ln[e]), c1 * sigmoidf_(c1) * bfhi(ln[e])); }
                *(u32x4*)(Aout + ((size_t)(row0 + i0 + j) * DFF + cc) * 2) = o;
                pm = pc; pc = pp; }
            ur += (size_t)4 * 5632 * 2;
        }
    }
}

__device__ __forceinline__ void phase_final(const Params& p, const Ctx& c) {
    const int tid = ltid(); const int wave = __builtin_amdgcn_readfirstlane(tid >> 6), lane = tid & 63;
    const int gw = blockIdx.x * 8 + wave, NW = gridDim.x * 8; const int ch0 = lane * 16;
    float nf[16]; load16f(p.in[5] + ch0, nf);
    const int To = c.T - NMETA, nrow = c.nseq * To;
    for (int q0 = gw * 4; q0 < nrow; q0 += NW * 4) {
        u32x4 ha[4], hb[4];
#pragma unroll
        for (int j = 0; j < 4; ++j) { const int q = q0 + j, s = q / To, po = q - s * To; const size_t row = (size_t)s * c.T + NMETA + po;
            const u32x4* src = (const u32x4*)(slot(p, 0) + (row * 1024 + ch0) * 2); ha[j] = src[0]; hb[j] = src[1]; }
#pragma unroll
        for (int j = 0; j < 4; ++j) { float h[16]; unpack16(ha[j], hb[j], h);
            float ss = 0.f;
#pragma unroll
            for (int i = 0; i < 16; ++i) ss += h[i] * h[i];
            ss = wave_sum(ss); const float rs = rsqrtf(ss * (1.f / 1024.f) + 1e-6f);
            float* dst = c.y + (size_t)(q0 + j) * 1024 + ch0;
#pragma unroll
            for (int k = 0; k < 4; ++k) { f32x4 o; o[0] = h[4 * k] * rs * nf[4 * k]; o[1] = h[4 * k + 1] * rs * nf[4 * k + 1]; o[2] = h[4 * k + 2] * rs * nf[4 * k + 2]; o[3] = h[4 * k + 3] * rs * nf[4 * k + 3]; ((f32x4*)dst)[k] = o; } }
    }
}


#define XB_TMO      128
#define XB_XCNT(j)  (256  + 64 * (j))
#define XB_XSUB(j)  (1280 + 64 * (j))
#define XB_XGEN(j)  (2304 + 64 * (j))
#define XB_TOP      3328
#define XB_TOPGEN   3392
#define XCD_BAR_WORDS 3456
#define XB_SPIN_CAP (1u << 18)
__device__ __forceinline__ unsigned xb_ld(unsigned* p)              { return __hip_atomic_load(p, __ATOMIC_RELAXED, __HIP_MEMORY_SCOPE_AGENT); }
__device__ __forceinline__ unsigned xb_add(unsigned* p, unsigned v) { return __hip_atomic_fetch_add(p, v, __ATOMIC_RELAXED, __HIP_MEMORY_SCOPE_AGENT); }
__device__ __forceinline__ unsigned xb_xcc_id() { return (unsigned)__builtin_amdgcn_s_getreg((3 << 11) | 20) & 0xFu; }
#define XB_SPIN(cond, bar) do { unsigned _sp = 0; while (cond) { __builtin_amdgcn_s_sleep(1); \
    if ((++_sp & 255u) == 0u) { if (xb_ld(&(bar)[XB_TMO])) break; if (_sp > XB_SPIN_CAP) { atomicAdd(&(bar)[XB_TMO], 1u); break; } } } } while (0)
struct XcdBarrier { unsigned* bar; unsigned x; volatile LAS unsigned* st; };
__device__ __forceinline__ XcdBarrier xcd_barrier_post(unsigned* bar, volatile LAS unsigned* st) {
    XcdBarrier b; b.bar = bar; b.x = xb_xcc_id(); b.st = st;
    if (threadIdx.x == 0) (void)xb_add(&bar[XB_XCNT(b.x)], 1u);
    return b;
}
__device__ __forceinline__ void xcd_barrier_complete(unsigned* bar, unsigned x, unsigned& nloc, unsigned& nx) {
    const unsigned G = gridDim.x * gridDim.y * gridDim.z;
    unsigned sum, cnt, mine, sp = 0u;
    for (;;) {
        sum = 0u; cnt = 0u; mine = 0u;
#pragma unroll
        for (unsigned j = 0; j < 16; ++j) { const unsigned c = xb_ld(&bar[XB_XCNT(j)]); sum += c; cnt += (c > 0u) ? 1u : 0u; mine = (j == x) ? c : mine; }
        if (sum == G) break;
        __builtin_amdgcn_s_sleep(1);
        if ((++sp & 255u) == 0u) { if (xb_ld(&bar[XB_TMO])) break; if (sp > XB_SPIN_CAP) { atomicAdd(&bar[XB_TMO], 1u); break; } }
    }
    nloc = mine > 0u ? mine : 1u; nx = cnt > 0u ? cnt : 1u;
}
__device__ __forceinline__ void xcd_barrier(const XcdBarrier& b) {
    asm volatile("s_waitcnt vmcnt(0)" ::: "memory");
    __syncthreads();
    if (threadIdx.x == 0) {
        unsigned* bar = b.bar;
        __builtin_amdgcn_s_waitcnt(0);
        unsigned nloc = b.st[0], nx = b.st[1];
        if (nloc == 0u) { xcd_barrier_complete(bar, b.x, nloc, nx); b.st[0] = nloc; b.st[1] = nx; }
        const unsigned old = xb_add(&bar[XB_XSUB(b.x)], 1u);
        const unsigned gen = old / nloc;
        if (old + 1u == (gen + 1u) * nloc) {
            __builtin_amdgcn_fence(__ATOMIC_RELEASE, "agent");
            asm volatile("s_waitcnt vmcnt(0)" ::: "memory");
            const unsigned og = xb_add(&bar[XB_TOP], 1u);
            const unsigned tg = og / nx;
            if (og + 1u == (tg + 1u) * nx) xb_add(&bar[XB_TOPGEN], 1u);
            else XB_SPIN(xb_ld(&bar[XB_TOPGEN]) == tg, bar);
            __builtin_amdgcn_fence(__ATOMIC_ACQUIRE, "agent");
            xb_add(&bar[XB_XGEN(b.x)], 1u);
            asm volatile("s_waitcnt vmcnt(0)" ::: "memory");
        } else {
            XB_SPIN(xb_ld(&bar[XB_XGEN(b.x)]) == gen, bar);
            __builtin_amdgcn_fence(__ATOMIC_ACQUIRE, "agent");
            asm volatile("s_waitcnt vmcnt(0)" ::: "memory");
        }
    }
    __syncthreads();
}

constexpr int NSUB = 20, NPHASE = 1 + 4 * NSUB;

__device__ __forceinline__ void phase_rstd(const Params& p, int which) {
    const float* part = (const float*)(p.ws + O_SS) + (size_t)which * 16 * RP; float* rs = (float*)(p.ws + O_RSTD) + (size_t)which * RP;
    for (int r = blockIdx.x * 512 + ltid(); r < RP; r += gridDim.x * 512) rs[r] = rstd16(part, r);
}

__device__ __forceinline__ void phase_fold(const Params& p, const Ctx& c) {
    const int tid = ltid(); const int wave = __builtin_amdgcn_readfirstlane(tid >> 6), lane = tid & 63;
    const int gw = blockIdx.x * 8 + wave, NW = gridDim.x * 8; const int ch0 = lane * 16;
    const float* part = (const float*)(p.ws + O_SS) + (size_t)16 * RP;
    const int nrow = c.nseq * c.Tp, Th = c.T / 2;
    for (int q = gw; q < nrow; q += NW) {
        const int s = q / c.Tp, tf = q - s * c.Tp; float oc[16], os[16];
        if (tf > Th) {
#pragma unroll
            for (int i = 0; i < 16; ++i) { oc[i] = 0.f; os[i] = 0.f; }
        } else {
            const int r1 = s * c.T + tf; float a[16]; load16bf(slot(p, 0), (size_t)r1 * 1024 + ch0, a); const float rs1 = rsqrtf(wave_sum(lane < 16 ? part[(size_t)lane * RP + r1] : 0.f) * (1.f / 1024.f) + 1e-6f);
            if (tf == 0 || tf == Th) {
#pragma unroll
                for (int i = 0; i < 16; ++i) { oc[i] = a[i] * rs1; os[i] = 0.f; }
            } else {
                const int r2 = s * c.T + (c.T - tf); float b[16]; load16bf(slot(p, 0), (size_t)r2 * 1024 + ch0, b); const float rs2 = rsqrtf(wave_sum(lane < 16 ? part[(size_t)lane * RP + r2] : 0.f) * (1.f / 1024.f) + 1e-6f);
#pragma unroll
                for (int i = 0; i < 16; ++i) { const float x = a[i] * rs1, y = b[i] * rs2; oc[i] = x + y; os[i] = x - y; }
            }
        }
        store16bf(slot(p, 5), (size_t)q * 1024 + ch0, oc); store16bf(slot(p, 6), (size_t)q * 1024 + ch0, os);
    }
}

__device__ __forceinline__ void run_phase(LAS unsigned char* lds, const Params& p, int ph) {
    if (ph == 0) { prep_phase(lds, p); return; }
    const int g = (ph - 1) / NSUB, sp = (ph - 1) % NSUB; const Ctx c = get_ctx(p, g);
    GemmPh P; P.G = gridDim.x; P.c = blockIdx.x; P.A = nullptr; P.B = nullptr; P.O = nullptr; P.ss = nullptr; P.ssin = nullptr; P.ldo = 0; P.kind = -1;
    float* ssb = (float*)(p.ws + O_SS); const float* rsb = (const float*)(p.ws + O_RSTD);
    switch (sp) {
    case 1: P.kind = K_L1; P.nunits = MT * 15; P.lda = 1024; P.ldb = 1024; P.K = 1024; break;
    case 2: P.kind = K_L2; P.nunits = MT * 20; P.lda = 256; P.ldb = 256; P.K = 256; break;
    case 6: P.kind = K_RES; P.nunits = MT * 4; P.lda = 1024; P.ldb = 1024; P.K = 1024; P.A = (const char*)slot(p, 1); P.B = (const char*)p.ws + O_WO; P.O = slot(p, 0); P.ss = ssb; break;
    case 8: case 16: { const int l = sp == 8 ? 0 : 1; P.kind = K_U; P.nunits = MT * 22; P.lda = 1024; P.ldb = 1024; P.K = 1024; P.A = (const char*)slot(p, 0); P.B = (const char*)p.ws + O_WIN + (size_t)l * 5632 * 1024 * 2;
        P.O = slot(p, 1); P.ssin = rsb + (l ? 2 * RP : 0); } break;
    case 10: case 18: { const int l = sp == 10 ? 0 : 1; P.kind = K_RES; P.nunits = MT * 4; P.lda = DFF; P.ldb = DFF; P.K = DFF; P.A = (const char*)slot(p, 7); P.B = (const char*)p.ws + O_WOUT + (size_t)l * 1024 * DFF * 2;
        P.O = slot(p, 0); P.ss = l ? nullptr : ssb + 16 * RP; } break;
    case 12: P.kind = K_CH; P.nunits = (c.nseq * c.Tp / 256) * 8; P.lda = 1024; P.ldb = 1024; P.K = 256; P.A = (const char*)p.ws + O_CHD; P.B = (const char*)slot(p, 5); P.O = slot(p, 1); break;
    case 13: P.kind = K_TD; P.nunits = c.nseq * c.tm * 4; P.lda = 2 * c.Tp; P.ldb = 2 * c.Tp; P.K = 2 * c.Tp; P.A = (const char*)p.ws + (g < 2 ? O_DFTP : O_DFTS); P.B = (const char*)slot(p, 1); P.O = slot(p, 4); break;
    case 14: P.kind = K_RES; P.nunits = MT * 4; P.lda = 1024; P.ldb = 1024; P.K = 1024; P.A = (const char*)slot(p, 4); P.B = (const char*)p.ws + O_WF; P.O = slot(p, 0); P.ss = ssb + 2 * 16 * RP; break;
    default: break;
    }
    if (P.kind >= 0) {
        switch (P.kind) {
        case K_L1: gemm_phase<K_L1>(lds, P, p, c); break;
        case K_L2: gemm_phase<K_L2>(lds, P, p, c); break;
        case K_RES: gemm_phase<K_RES>(lds, P, p, c); break;
        case K_U: gemm_phase<K_U>(lds, P, p, c); break;
        case K_CH: gemm_phase<K_CH>(lds, P, p, c); break;
        default: gemm_phase<K_TD>(lds, P, p, c); break;
        }
        if (sp == 13) {
            const int tid = ltid(); const int wave = __builtin_amdgcn_readfirstlane(tid >> 6), lane = tid & 63; const int K2 = 2 * c.Tp;
            const bf16_t* drow = (const bf16_t*)P.A + (size_t)(NMETA - 1) * K2; const bf16_t* yT = (const bf16_t*)slot(p, 1); bf16_t* F = (bf16_t*)slot(p, 4);
            for (int it = blockIdx.x * 8 + wave; it < c.nseq * 1024; it += gridDim.x * 8) {
                const int s = it >> 10, ch = it & 1023; const bf16_t* yr = yT + ((size_t)s * 1024 + ch) * K2; float acc = 0.f;
                for (int kk = lane * 2; kk < K2; kk += 128) { const unsigned a = *(const unsigned*)(drow + kk), b = *(const unsigned*)(yr + kk); acc += bflo(a) * bflo(b) + bfhi(a) * bfhi(b); }
                acc = wave_sum(acc);
                if (lane == 0) F[((size_t)s * c.T + (NMETA - 1)) * 1024 + ch] = (bf16_t)(pk2(acc, 0.f) & 0xffffu);
            }
        }
        return;
    }
    if (sp == 0) phase_mix(p, c);
    else if (sp == 3) phase_prescan(p, c);
    else if (sp == 4) phase_scan(lds, p, c);
    else if (sp == 5) phase_postscan(p, c);
    else if (sp == 11) phase_fold(p, c);
    else if (sp == 7 || sp == 15) phase_rstd(p, sp == 7 ? 0 : 2);
    else if (sp == 9 || sp == 17) phase_glu(p, c, sp == 9 ? 0 : 1);
    else phase_final(p, c);
}

__global__ void __launch_bounds__(512, 2) mega(Params p, int ph_lo, int ph_hi) {
    extern __shared__ __attribute__((aligned(16))) unsigned char shm[];
    LAS unsigned char* lds = (LAS unsigned char*)shm;
    cg::grid_group grid = cg::this_grid();
    volatile LAS unsigned* st = (volatile LAS unsigned*)(lds + STAGE_BYTES);
    if (threadIdx.x == 0) { st[0] = 0u; st[1] = 0u; }
    __syncthreads();
    const XcdBarrier xb = xcd_barrier_post((unsigned*)(p.ws + O_BAR), st);
    for (int ph = ph_lo; ph < ph_hi; ++ph) {
        if (ph_hi < 0) grid.sync();
        if (ph > ph_lo) xcd_barrier(xb);
        run_phase(lds, p, ph);
    }
}

extern "C" void kernel_launch(void* const* d_in, const int* in_sizes, int n_in, void* d_out, int out_size, void* d_ws, size_t ws_size, hipStream_t stream) {
    static int grid = 0;
    if (grid == 0) {
        if (n_in != 27 || ws_size < WS_END) { fprintf(stderr, "kernel_launch: need 27 inputs and %zu B of workspace (got %d, %zu)\n", (size_t)WS_END, n_in, ws_size); grid = -1; return; }
        int dev = 0, cus = 0, per_cu = 0;
        hipGetDevice(&dev); hipDeviceGetAttribute(&cus, hipDeviceAttributeMultiprocessorCount, dev);
        if (hipFuncSetAttribute((const void*)mega, hipFuncAttributeMaxDynamicSharedMemorySize, STAGE_BYTES + 16) != hipSuccess) { fprintf(stderr, "hipFuncSetAttribute failed\n"); grid = -1; return; }
        hipOccupancyMaxActiveBlocksPerMultiprocessor(&per_cu, (const void*)mega, 512, STAGE_BYTES + 16);
        if (per_cu < 1) per_cu = 1;
        (void)hipGetLastError();
        grid = cus * 1;
    }
    if (grid < 0) return;
    Params p{};
    for (int i = 0; i < 27; ++i) p.in[i] = (const float*)d_in[i];
    p.out = (float*)d_out; p.ws = (unsigned char*)d_ws;
#if MK_PER_PHASE
    for (int ph = 0; ph < NPHASE; ++ph) hipLaunchKernelGGL(mega, dim3(grid), dim3(512), STAGE_BYTES + 16, stream, p, ph, ph + 1);
#else
    (void)hipMemsetAsync((unsigned char*)d_ws + O_BAR, 0, 16384, stream);
    int lo = 0, hi = NPHASE;
    void* args[] = {&p, &lo, &hi};
    hipError_t e = hipLaunchCooperativeKernel((const void*)mega, dim3(grid), dim3(512), args, STAGE_BYTES + 16, stream);
    if (e != hipSuccess) fprintf(stderr, "cooperative launch failed: %s (grid %d)\n", hipGetErrorString(e), grid);
#endif
}
```

```cpp
#include <hip/hip_runtime.h>
#include <hip/hip_cooperative_groups.h>
#include <cstdio>
namespace cg = cooperative_groups;

#ifndef MK_PER_PHASE
#define MK_PER_PHASE 0
#endif

#define LAS __attribute__((address_space(3)))
typedef unsigned short bf16_t;
typedef short bf16x8 __attribute__((ext_vector_type(8)));
typedef float f32x4 __attribute__((ext_vector_type(4)));
typedef unsigned u32x4 __attribute__((ext_vector_type(4)));
typedef unsigned u32x2 __attribute__((ext_vector_type(2)));
typedef float f32x2 __attribute__((ext_vector_type(2)));
typedef const __attribute__((address_space(4))) unsigned* cptr;

constexpr int D = 1024, DFF = 2816, NMETA = 16;
constexpr int RP = 33024;
constexpr int MT = RP / 256;
constexpr size_t SLOT = (size_t)RP * D * 2;
constexpr int NSLOT = 13;
constexpr size_t O_WRKV = NSLOT * SLOT;
constexpr size_t O_G1 = O_WRKV + (size_t)3072 * 1024 * 2;
constexpr size_t O_W1 = O_G1 + (size_t)256 * 1024 * 2;
constexpr size_t O_A1 = O_W1 + (size_t)256 * 1024 * 2;
constexpr size_t O_L2 = O_A1 + (size_t)256 * 1024 * 2;
constexpr size_t O_G2 = O_L2 + (size_t)4096 * 256 * 2;
constexpr size_t O_WO = O_G2 + (size_t)1024 * 256 * 2;
constexpr size_t O_WF = O_WO + (size_t)1024 * 1024 * 2;
constexpr size_t O_WIN = O_WF + (size_t)1024 * 1024 * 2;
constexpr size_t O_WOUT = O_WIN + (size_t)2 * 5632 * 1024 * 2;
constexpr size_t O_CHD = O_WOUT + (size_t)2 * 1024 * 2816 * 2;
constexpr int TP_P = 1088, TP_S = 2112, MP_P = 2304, MP_S = 4352;
constexpr size_t O_DFTP = O_CHD + (size_t)2048 * 1024 * 2;
constexpr size_t O_DFTS = O_DFTP + (size_t)MP_P * 2 * TP_P * 2;
constexpr size_t O_SS = O_DFTS + (size_t)MP_S * 2 * TP_S * 2;
constexpr size_t O_RSTD = O_SS + (size_t)3 * 16 * RP * 4;
constexpr size_t O_BONUS = O_RSTD + (size_t)3 * RP * 4;
constexpr size_t O_BAR = O_BONUS + (size_t)RP * 16 * 4;
constexpr size_t WS_END = O_BAR + 16384;

struct Params { const float* in[27]; float* out; unsigned char* ws; };
struct Ctx { int g, T, nseq, R, Tp, tm; const float* x; float* y; };

__device__ __forceinline__ Ctx get_ctx(const Params& p, int g) {
    Ctx c; c.g = g;
    if (g < 2) { c.T = 2064; c.nseq = 16; c.Tp = TP_P; c.tm = 8; c.x = p.in[0] + (size_t)g * 16 * 2048 * 1024; c.y = p.out + (size_t)g * 16 * 2048 * 1024; }
    else { c.T = 4112; c.nseq = 8; c.Tp = TP_S; c.tm = 16; c.x = p.in[1] + (size_t)(g - 2) * 8 * 4096 * 1024; c.y = p.out + (size_t)32 * 2048 * 1024 + (size_t)(g - 2) * 8 * 4096 * 1024; }
    c.R = c.nseq * c.T; return c;
}
__device__ __forceinline__ int ltid() { int t = threadIdx.x; asm volatile("" : "+v"(t)); return t; }
__device__ __forceinline__ unsigned char* slot(const Params& p, int i) { return p.ws + (size_t)i * SLOT; }

__device__ __forceinline__ unsigned pk2(float lo, float hi) { unsigned r; asm volatile("v_cvt_pk_bf16_f32 %0, %1, %2" : "=v"(r) : "v"(lo), "v"(hi)); return r; }
__device__ __forceinline__ float bflo(unsigned u) { return __uint_as_float(u << 16); }
__device__ __forceinline__ float bfhi(unsigned u) { return __uint_as_float(u & 0xffff0000u); }
__device__ __forceinline__ float wave_sum(float v) {
#pragma unroll
    for (int o = 1; o < 64; o <<= 1) v += __shfl_xor(v, o);
    return v;
}
__device__ __forceinline__ float sigmoidf_(float x) { return __builtin_amdgcn_rcpf(1.f + __expf(-x)); }
__device__ __forceinline__ void unpack16(const u32x4 a, const u32x4 b, float (&v)[16]) {
#pragma unroll
    for (int i = 0; i < 4; ++i) { v[2 * i] = bflo(a[i]); v[2 * i + 1] = bfhi(a[i]); v[8 + 2 * i] = bflo(b[i]); v[8 + 2 * i + 1] = bfhi(b[i]); }
}
__device__ __forceinline__ void load16bf(const unsigned char* base, size_t elem, float (&v)[16]) {
    const u32x4* q = (const u32x4*)(base + elem * 2); unpack16(q[0], q[1], v);
}
__device__ __forceinline__ void store16bf(unsigned char* base, size_t elem, const float (&v)[16]) {
    u32x4 a, b;
#pragma unroll
    for (int i = 0; i < 4; ++i) { a[i] = pk2(v[2 * i], v[2 * i + 1]); b[i] = pk2(v[8 + 2 * i], v[8 + 2 * i + 1]); }
    u32x4* q = (u32x4*)(base + elem * 2); q[0] = a; q[1] = b;
}
__device__ __forceinline__ void load16f(const float* src, float (&v)[16]) {
#pragma unroll
    for (int j = 0; j < 4; ++j) { f32x4 t = ((const f32x4*)src)[j]; v[4 * j] = t[0]; v[4 * j + 1] = t[1]; v[4 * j + 2] = t[2]; v[4 * j + 3] = t[3]; }
}

constexpr int BM = 256, BK = 64, HALF = 128, HTB = HALF * BK * 2, STAGE_BYTES = 8 * HTB;
__device__ __forceinline__ int lds_byte(int r, int c) { const int st = (r >> 4) * 2 + (c >> 5), rr = r & 15, cc = c & 31, ob = rr * 64 + cc * 2; return st * 1024 + (ob ^ (((ob >> 9) & 1) << 5)); }
__device__ __forceinline__ void stage_rc(int b, int& R, int& C) { const int st = b / 1024, sb = b % 1024, swz = sb ^ (((sb >> 9) & 1) << 5); R = (st >> 1) * 16 + swz / 64; C = (st & 1) * 32 + (swz % 64) / 2; }
__device__ __forceinline__ int perm32(int rho) { const int n = rho >> 4, i = rho & 15; return 8 * (i >> 2) + 4 * n + (i & 3); }

enum { K_L1 = 0, K_L2, K_RES, K_U, K_CH, K_TD };
struct Unit { const char* A; const char* B; int pm, pn, job, s; };
struct GemmPh {
    int kind, nunits, lda, ldb, K, G, c;
    const char* A; const char* B;
    unsigned char* O; float* ss; const float* ssin; int ldo;
};

__device__ __forceinline__ void xcd_order(int L, int nM, int nN, int& pm, int& pn) {
    const int nwg = nM * nN; int wgid = L; { const int q = nwg / 8, r = nwg % 8, xcd = wgid % 8, off = wgid / 8; wgid = (xcd < r ? xcd * (q + 1) : r * (q + 1) + (xcd - r) * q) + off; }
    const int nig = 8 * nN, gid = wgid / nig, fm = gid * 8, gsz = (nM - fm) < 8 ? (nM - fm) : 8;
    pm = fm + ((wgid % nig) % gsz); pn = (wgid % nig) / gsz;
}
__device__ __forceinline__ bool next_unit(const GemmPh& P, const Params& p, const Ctx& cx, int i, Unit& u) {
    const long Lg = (long)i * P.G + P.c; if (Lg >= P.nunits) return false;
    const int L = (int)Lg; u.s = 0; u.job = 0;
    if (P.kind == K_L1) {
        int pm, jn; xcd_order(L, MT, 15, pm, jn); int job, pn;
        if (jn < 12) { job = jn >> 2; pn = jn & 3; } else { job = 3 + (jn - 12); pn = 0; }
        const int aslot = job == 0 ? 1 : job == 1 ? 3 : job == 2 ? 4 : job == 3 ? 6 : job == 4 ? 2 : 5;
        u.A = (const char*)slot(p, aslot) + (size_t)pm * 256 * 2048;
        const size_t boff = job < 3 ? O_WRKV + ((size_t)job * 1024 + pn * 256) * 2048 : job == 3 ? O_G1 : job == 4 ? O_W1 : O_A1;
        u.B = (const char*)p.ws + boff; u.pm = pm; u.pn = pn; u.job = job;
    } else if (P.kind == K_L2) {
        int pm, jn; xcd_order(L, MT, 20, pm, jn); const int job = jn < 16 ? 0 : 1, pn = jn < 16 ? jn : jn - 16;
        u.A = (const char*)slot(p, 10) + (job == 0 ? (size_t)RP * 512 : 0) + (size_t)pm * 256 * 512;
        u.B = (const char*)p.ws + (job == 0 ? O_L2 : O_G2) + (size_t)pn * 256 * 512; u.pm = pm; u.pn = pn; u.job = job;
    } else if (P.kind == K_RES) {
        int pm, pn; xcd_order(L, MT, 4, pm, pn);
        u.A = P.A + (size_t)pm * 256 * P.lda * 2; u.B = P.B + (size_t)pn * 256 * P.ldb * 2; u.pm = pm; u.pn = pn;
    } else if (P.kind == K_U) {
        int pm, pn; xcd_order(L, MT, 22, pm, pn);
        u.A = P.A + (size_t)pm * 256 * 2048; u.B = P.B + (size_t)pn * 256 * 2048; u.pm = pm; u.pn = pn;
    } else if (P.kind == K_CH) {
        int pn, pm; xcd_order(L, P.nunits >> 3, 8, pn, pm);
        u.A = P.A + (size_t)pm * 256 * 2048 + (pm & 3) * 512; u.B = (const char*)slot(p, pm < 4 ? 5 : 6) + (size_t)pn * 256 * 2048 + (pm & 3) * 512; u.pm = pm; u.pn = pn;
    } else {
        int rt, pn; xcd_order(L, cx.nseq * cx.tm, 4, rt, pn); const int s = rt / cx.tm, pm = rt % cx.tm;
        u.A = P.A + (size_t)(NMETA + pm * 256) * P.lda * 2; u.B = P.B + ((size_t)s * 1024 + pn * 256) * P.ldb * 2; u.pm = pm; u.pn = pn; u.s = s;
    }
    return true;
}

__device__ __forceinline__ void st8(unsigned char* ptr, const f32x4 a, const f32x4 b) {
    u32x4 o; o[0] = pk2(a[0], a[1]); o[1] = pk2(a[2], a[3]); o[2] = pk2(b[0], b[1]); o[3] = pk2(b[2], b[3]); *(u32x4*)ptr = o;
}
__device__ __forceinline__ float decaymap(float w) {
    const float e = 0.6065306597f * __builtin_amdgcn_rcpf(1.f + __expf(-w)); return __expf(-e) - 1.f;
}
__device__ __forceinline__ float act_apply(int act, float x) {
    if (act == 1) return __builtin_amdgcn_rcpf(1.f + __expf(-x));
    if (act == 2) return 1.f - 2.f * __builtin_amdgcn_rcpf(__expf(2.f * x) + 1.f);
    if (act == 3) return decaymap(x);
    return x;
}

__device__ __forceinline__ float rstd16(const float* ss, int r) {
    float s = 0.f;
#pragma unroll
    for (int i = 0; i < 16; ++i) s += ss[(size_t)i * RP + r];
    return rsqrtf(s * (1.f / 1024.f) + 1e-6f);
}
__device__ __forceinline__ void epilogue(const GemmPh& P, const Params& p, const Ctx& cx, const f32x4 (&acc)[2][2][4][2], const Unit& u, int wr, int wc, int fr, int fq) {
    const int rbase = u.pm * 256 + wr * 64 + fr, cbase = u.pn * 256 + wc * 32 + 8 * fq;
    if (P.kind == K_L1 || P.kind == K_L2) {
        unsigned char* O; int ldo = 1024, coff = 0, act = 0, cvalid = 1 << 30; const float* bias = nullptr;
        if (P.kind == K_L1) {
            if (u.job < 3) { O = slot(p, 7 + u.job); }
            else if (u.job == 3) { O = slot(p, 10); ldo = 256; act = 1; }
            else if (u.job == 4) { O = slot(p, 10) + (size_t)RP * 512; ldo = 256; act = 2; cvalid = 128; }
            else { O = slot(p, 10) + (size_t)RP * 512; ldo = 256; coff = 128; cvalid = 128; }
        } else {
            if (u.job == 1) { O = slot(p, 5); }
            else { const int cb = u.pn >> 2; O = slot(p, 1 + cb); bias = (cb < 2 ? p.in[8] : p.in[11]) + (cb & 1) * 1024 - cb * 1024; coff = -cb * 1024; act = cb < 2 ? 3 : 1; }
        }
        f32x4 bv[2][2];
#pragma unroll
        for (int bj = 0; bj < 2; ++bj)
#pragma unroll
            for (int n = 0; n < 2; ++n) bv[bj][n] = bias ? *(const f32x4*)(bias + cbase + bj * 128 + 4 * n) : (f32x4){0.f, 0.f, 0.f, 0.f};
#pragma unroll
        for (int ai = 0; ai < 2; ++ai)
#pragma unroll
            for (int m = 0; m < 4; ++m) { if ((m & 1) == 0) __builtin_amdgcn_sched_barrier(0);
#pragma unroll
                for (int bj = 0; bj < 2; ++bj) { const int r = rbase + ai * 128 + m * 16; const int c0 = cbase + bj * 128;
                    f32x4 v0 = acc[ai][bj][m][0] + bv[bj][0], v1 = acc[ai][bj][m][1] + bv[bj][1];
#pragma unroll
                    for (int i = 0; i < 4; ++i) { v0[i] = act_apply(act, v0[i]); v1[i] = act_apply(act, v1[i]); }
                    if (c0 < cvalid) st8(O + ((size_t)r * ldo + coff + c0) * 2, v0, v1); } }
    } else if (P.kind == K_RES) {
        unsigned char* H = P.O;
        u32x4 oldall[2][4][2];
#pragma unroll
        for (int ai = 0; ai < 2; ++ai)
#pragma unroll
            for (int m = 0; m < 4; ++m)
#pragma unroll
                for (int bj = 0; bj < 2; ++bj) oldall[ai][m][bj] = *(const u32x4*)(H + ((size_t)(rbase + ai * 128 + m * 16) * 1024 + cbase + bj * 128) * 2);
        __builtin_amdgcn_sched_barrier(0);
#pragma unroll
        for (int ai = 0; ai < 2; ++ai) {
#pragma unroll
            for (int m = 0; m < 4; ++m) { const int r = rbase + ai * 128 + m * 16; float sq = 0.f;
#pragma unroll
                for (int bj = 0; bj < 2; ++bj) { unsigned char* ptr = H + ((size_t)r * 1024 + cbase + bj * 128) * 2;
                    const u32x4 old = oldall[ai][m][bj]; u32x4 o; const f32x4 a0 = acc[ai][bj][m][0], a1 = acc[ai][bj][m][1];
                    o[0] = pk2(bflo(old[0]) + a0[0], bfhi(old[0]) + a0[1]); o[1] = pk2(bflo(old[1]) + a0[2], bfhi(old[1]) + a0[3]);
                    o[2] = pk2(bflo(old[2]) + a1[0], bfhi(old[2]) + a1[1]); o[3] = pk2(bflo(old[3]) + a1[2], bfhi(old[3]) + a1[3]);
#pragma unroll
                    for (int i = 0; i < 4; ++i) { const float rl = bflo(o[i]), rh = bfhi(o[i]); sq += rl * rl + rh * rh; }
                    *(u32x4*)ptr = o; }
                if (P.ss) { sq += __shfl_xor(sq, 16); sq += __shfl_xor(sq, 32); if (fq == 0) P.ss[(size_t)(u.pn * 4 + wc) * RP + r] = sq; } }
            __builtin_amdgcn_sched_barrier(0);
        }
    } else if (P.kind == K_U) {
        float rsv[2][4];
#pragma unroll
        for (int ai = 0; ai < 2; ++ai)
#pragma unroll
            for (int m = 0; m < 4; ++m) rsv[ai][m] = P.ssin[rbase + ai * 128 + m * 16];
        __builtin_amdgcn_sched_barrier(0);
#pragma unroll
        for (int ai = 0; ai < 2; ++ai)
#pragma unroll
            for (int m = 0; m < 4; ++m) { if ((m & 1) == 0) __builtin_amdgcn_sched_barrier(0); const int r = rbase + ai * 128 + m * 16; const float rs = rsv[ai][m];
#pragma unroll
                for (int bj = 0; bj < 2; ++bj) st8(P.O + ((size_t)r * 5632 + cbase + bj * 128) * 2, acc[ai][bj][m][0] * rs, acc[ai][bj][m][1] * rs); }
    } else if (P.kind == K_CH) {
#pragma unroll
        for (int bj = 0; bj < 2; ++bj) { const int n0 = cbase + bj * 128; const int s = n0 / cx.Tp, t = n0 - s * cx.Tp;
#pragma unroll
            for (int ai = 0; ai < 2; ++ai)
#pragma unroll
                for (int m = 0; m < 4; ++m) { if ((m & 1) == 0) __builtin_amdgcn_sched_barrier(0); const int rr = rbase + ai * 128 + m * 16; const int cs = rr >> 10, ch = rr & 1023;
                    st8(P.O + ((((size_t)s * 1024 + ch) * 2 + cs) * cx.Tp + t) * 2, acc[ai][bj][m][0], acc[ai][bj][m][1]); } }
    } else {
#pragma unroll
        for (int ai = 0; ai < 2; ++ai)
#pragma unroll
            for (int m = 0; m < 4; ++m) { if ((m & 1) == 0) __builtin_amdgcn_sched_barrier(0); const int k = NMETA + rbase + ai * 128 + m * 16; const size_t row = (size_t)u.s * cx.T + k;
#pragma unroll
                for (int bj = 0; bj < 2; ++bj) if (k < cx.T) st8(P.O + (row * 1024 + cbase + bj * 128) * 2, acc[ai][bj][m][0], acc[ai][bj][m][1]); }
    }
}

template <int KIND> __device__ __forceinline__ void gemm_phase(LAS unsigned char* lds, GemmPh P, const Params& p, const Ctx& cx) {
    P.kind = KIND;
    const int tid = ltid(), wid = __builtin_amdgcn_readfirstlane(tid >> 6), lane = tid & 63, wr = wid >> 2, wc = wid & 3, fr = lane & 15, fq = lane >> 4;
    const int nt = P.K / BK;
    unsigned voffA[2], voffB[2];
#pragma unroll
    for (int i = 0; i < 2; ++i) { int R, C; stage_rc(tid * 16 + i * 8192, R, C); const int Rb = (R & ~31) + perm32(R & 31);
        voffA[i] = (unsigned)(R * P.lda + C) * 2u; voffB[i] = (unsigned)(Rb * P.ldb + C) * 2u; }
    const size_t kstep = (size_t)(BK * 2);
    const size_t hstepA = (size_t)HALF * P.lda * 2, hstepB = (size_t)HALF * P.ldb * 2;
    const unsigned ldsw = (unsigned)wid * 1024u;
    const int aoff = lds_byte(wr * 64 + fr, fq * 8), boff = lds_byte(wc * 32 + fr, fq * 8);
#define PG8_SA(b, h) (((b) * 2 + (h)) * HTB)
#define PG8_SB(b, h) ((4 + (b) * 2 + (h)) * HTB)
#define PG8_STAGE(bufoff, gbase, voff) do { _Pragma("unroll") for (int _i = 0; _i < 2; ++_i) \
        __builtin_amdgcn_global_load_lds((const unsigned*)((const char*)(gbase) + (voff)[_i]), (LAS unsigned*)(lds + (bufoff) + ldsw + _i * 8192), 16, 0, 0); } while (0)
#define PG8_LDA(dst, b, h) do { _Pragma("unroll") for (int m = 0; m < 4; ++m) _Pragma("unroll") for (int k = 0; k < 2; ++k) dst[m][k] = *(const LAS bf16x8*)(lds + PG8_SA(b, h) + aoff + m * 2048 + k * 1024); } while (0)
#define PG8_LDB(dst, b, h) do { _Pragma("unroll") for (int n = 0; n < 2; ++n) _Pragma("unroll") for (int k = 0; k < 2; ++k) dst[n][k] = *(const LAS bf16x8*)(lds + PG8_SB(b, h) + boff + n * 2048 + k * 1024); } while (0)
#define PG8_MMA(ai, bj, At, Bt) do { __builtin_amdgcn_s_setprio(1); _Pragma("unroll") for (int m = 0; m < 4; ++m) _Pragma("unroll") for (int n = 0; n < 2; ++n) _Pragma("unroll") for (int k = 0; k < 2; ++k) \
        acc[ai][bj][m][n] = __builtin_amdgcn_mfma_f32_16x16x32_bf16(Bt[n][k], At[m][k], acc[ai][bj][m][n], 0, 0, 0); __builtin_amdgcn_s_setprio(0); } while (0)
#define PG8_WAIT_V(n) asm volatile("s_waitcnt vmcnt(" #n ")" ::: "memory")
#define PG8_WAIT_L(n) asm volatile("s_waitcnt lgkmcnt(" #n ")" ::: "memory")
#define PG8_BAR __builtin_amdgcn_s_barrier()
#define PG8_SCHED __builtin_amdgcn_sched_barrier(0)
    Unit cur, nxt; int ui = 0;
    if (!next_unit(P, p, cx, 0, cur)) return;
    f32x4 acc[2][2][4][2];
#pragma unroll
    for (int a = 0; a < 2; ++a)
#pragma unroll
        for (int b = 0; b < 2; ++b)
#pragma unroll
            for (int m = 0; m < 4; ++m)
#pragma unroll
                for (int n = 0; n < 2; ++n) acc[a][b][m][n] = (f32x4){0.f, 0.f, 0.f, 0.f};
    bf16x8 At[4][2], B0[2][2], B1[2][2];
    const char* cA = cur.A; const char* cB = cur.B;
    PG8_STAGE(PG8_SB(0, 0), cB, voffB); PG8_STAGE(PG8_SA(0, 0), cA, voffA); PG8_STAGE(PG8_SB(0, 1), cB + hstepB, voffB); PG8_STAGE(PG8_SA(0, 1), cA + hstepA, voffA);
    if (wr == 1) PG8_BAR;
    PG8_WAIT_V(4); PG8_BAR;
    PG8_STAGE(PG8_SB(1, 0), cB + kstep, voffB); PG8_STAGE(PG8_SA(1, 0), cA + kstep, voffA); PG8_STAGE(PG8_SB(1, 1), cB + hstepB + kstep, voffB);
    PG8_WAIT_V(6); PG8_BAR;
    for (;;) {
        const bool has_next = next_unit(P, p, cx, ui + 1, nxt);
        const char* nA = has_next ? nxt.A : cA; const char* nB = has_next ? nxt.B : cB;
        for (int t = 0; t < nt; t += 2) {
            const bool last = (t == nt - 2);
            const char* a1 = cA + (size_t)(t + 1) * kstep;
            const char* a2 = last ? nA : cA + (size_t)(t + 2) * kstep; const char* b2 = last ? nB : cB + (size_t)(t + 2) * kstep;
            const char* a3 = a2 + kstep; const char* b3 = b2 + kstep;
            PG8_LDB(B0, 0, 0); PG8_SCHED; PG8_LDA(At, 0, 0); PG8_STAGE(PG8_SA(1, 1), a1 + hstepA, voffA);
            PG8_WAIT_L(8); PG8_BAR; PG8_WAIT_L(0); PG8_MMA(0, 0, At, B0); PG8_BAR; PG8_SCHED;
            PG8_LDB(B1, 0, 1); PG8_STAGE(PG8_SB(0, 0), b2, voffB);
            PG8_BAR; PG8_WAIT_L(0); PG8_MMA(0, 1, At, B1); PG8_BAR;
            PG8_LDA(At, 0, 1); PG8_STAGE(PG8_SA(0, 0), a2, voffA);
            PG8_BAR; PG8_WAIT_L(0); PG8_MMA(1, 0, At, B0); PG8_BAR; PG8_SCHED;
            PG8_STAGE(PG8_SB(0, 1), b2 + hstepB, voffB);
            PG8_WAIT_V(6); PG8_BAR; PG8_MMA(1, 1, At, B1); PG8_BAR;
            PG8_LDB(B0, 1, 0); PG8_SCHED; PG8_LDA(At, 1, 0); PG8_STAGE(PG8_SA(0, 1), a2 + hstepA, voffA);
            PG8_WAIT_L(8); PG8_BAR; PG8_WAIT_L(0); PG8_MMA(0, 0, At, B0); PG8_BAR; PG8_SCHED;
            PG8_LDB(B1, 1, 1); PG8_STAGE(PG8_SB(1, 0), b3, voffB);
            PG8_BAR; PG8_WAIT_L(0); PG8_MMA(0, 1, At, B1); PG8_BAR;
            PG8_LDA(At, 1, 1); PG8_STAGE(PG8_SA(1, 0), a3, voffA);
            PG8_BAR; PG8_WAIT_L(0); PG8_MMA(1, 0, At, B0); PG8_BAR; PG8_SCHED;
            PG8_STAGE(PG8_SB(1, 1), b3 + hstepB, voffB);
            PG8_WAIT_V(6); PG8_BAR; PG8_MMA(1, 1, At, B1); PG8_BAR;
        }
        epilogue(P, p, cx, acc, cur, wr, wc, fr, fq);
        if (!has_next) break;
#pragma unroll
        for (int a = 0; a < 2; ++a)
#pragma unroll
            for (int b = 0; b < 2; ++b)
#pragma unroll
                for (int m = 0; m < 4; ++m)
#pragma unroll
                    for (int n = 0; n < 2; ++n) acc[a][b][m][n] = (f32x4){0.f, 0.f, 0.f, 0.f};
        cur = nxt; cA = nA; cB = nB; ++ui;
    }
    PG8_WAIT_V(0);
    if (wr == 0) PG8_BAR;
    PG8_BAR;
#undef PG8_SA
#undef PG8_SB
#undef PG8_STAGE
#undef PG8_LDA
#undef PG8_LDB
#undef PG8_MMA
#undef PG8_WAIT_V
#undef PG8_WAIT_L
#undef PG8_BAR
#undef PG8_SCHED
}

__device__ __forceinline__ void tr_job(LAS float* tile, const float* src, int K, int N, unsigned char* dst, int ldk, int koff, int Kpad, int Npad, const float* scale, int& cnt, int stride_start, int G) {
    const int tk = Kpad / 64, tn = Npad / 64, ntile = tk * tn; const int tid = ltid();
    for (int it = 0; it < ntile; ++it, ++cnt) {
        if ((cnt % G) != stride_start) continue;
        const int k0 = (it / tn) * 64, n0 = (it % tn) * 64;
        __syncthreads();
        { const int tx = tid & 63, ty = tid >> 6;
#pragma unroll
            for (int i = 0; i < 8; ++i) { const int kd = k0 + ty + 8 * i, ks = kd - koff, n = n0 + tx; float v = 0.f;
                if (ks >= 0 && ks < K && n < N) { v = src[(size_t)ks * N + n]; if (scale) v *= scale[ks]; }
                tile[(ty + 8 * i) * 65 + tx] = v; } }
        __syncthreads();
        { const int n = tid >> 3, kc = (tid & 7) * 8; u32x4 o;
#pragma unroll
            for (int i = 0; i < 4; ++i) o[i] = pk2(tile[(kc + 2 * i) * 65 + n], tile[(kc + 2 * i + 1) * 65 + n]);
            *(u32x4*)(dst + ((size_t)(n0 + n) * ldk + k0 + kc) * 2) = o; }
    }
}

__device__ __forceinline__ void prep_phase(LAS unsigned char* lds, const Params& p) {
    LAS float* tile = (LAS float*)lds; unsigned char* ws = p.ws; int cnt = 0; const int b = blockIdx.x, G = gridDim.x;
    for (int i = 0; i < 3; ++i) tr_job(tile, p.in[7] + (size_t)i * D * D, D, D, ws + O_WRKV + (size_t)i * D * D * 2, 1024, 0, 1024, 1024, nullptr, cnt, b, G);
    tr_job(tile, p.in[14], D, 160, ws + O_G1, 1024, 0, 1024, 256, nullptr, cnt, b, G);
    tr_job(tile, p.in[9], D, 64, ws + O_W1, 1024, 0, 1024, 64, nullptr, cnt, b, G);
    tr_job(tile, p.in[9] + D * 64, D, 64, ws + O_W1 + (size_t)64 * 1024 * 2, 1024, 0, 1024, 192, nullptr, cnt, b, G);
    tr_job(tile, p.in[12], D, 64, ws + O_A1, 1024, 0, 1024, 64, nullptr, cnt, b, G);
    tr_job(tile, p.in[12] + D * 64, D, 64, ws + O_A1 + (size_t)64 * 1024 * 2, 1024, 0, 1024, 192, nullptr, cnt, b, G);
    for (int z = 0; z < 2; ++z) {
        tr_job(tile, p.in[10] + (size_t)z * 64 * D, 64, D, ws + O_L2 + (size_t)z * 1024 * 256 * 2, 256, z * 64, 256, 1024, nullptr, cnt, b, G);
        tr_job(tile, p.in[13] + (size_t)z * 64 * D, 64, D, ws + O_L2 + (size_t)(2 + z) * 1024 * 256 * 2, 256, (2 + z) * 64, 256, 1024, nullptr, cnt, b, G);
    }
    tr_job(tile, p.in[15], 160, D, ws + O_G2, 256, 0, 256, 1024, nullptr, cnt, b, G);
    tr_job(tile, p.in[21], D, D, ws + O_WO, 1024, 0, 1024, 1024, nullptr, cnt, b, G);
    tr_job(tile, p.in[22], D, D, ws + O_WF, 1024, 0, 1024, 1024, nullptr, cnt, b, G);
    for (int l = 0; l < 2; ++l) {
        tr_job(tile, p.in[23] + (size_t)l * D * 5632, D, 5632, ws + O_WIN + (size_t)l * 5632 * 1024 * 2, 1024, 0, 1024, 5632, p.in[4] + l * D, cnt, b, G);
        tr_job(tile, p.in[26] + (size_t)l * DFF * D, DFF, D, ws + O_WOUT + (size_t)l * 1024 * DFF * 2, DFF, 0, DFF, 1024, nullptr, cnt, b, G);
    }
    const size_t gt = (size_t)blockIdx.x * 512 + ltid(), NT = (size_t)gridDim.x * 512;
    const float* nm1 = p.in[3] + D;
    for (size_t e = gt; e < (size_t)2048 * 128; e += NT) {
        const int rr = (int)(e >> 7), c0 = (int)(e & 127) * 8; const int cs = rr >> 10, ch = rr & 1023; float v[8];
#pragma unroll
        for (int i = 0; i < 8; ++i) { const int c = c0 + i; float val = 0.f;
            if ((c >> 7) == (ch >> 7)) { const int m = ((ch & 127) * (c & 127)) & 127; float sn, cn; sincospif((float)m * (1.f / 64.f), &sn, &cn); val = (cs ? sn : cn) * nm1[c] * 0.08838834764831845f; }
            v[i] = val; }
        u32x4 o; o[0] = pk2(v[0], v[1]); o[1] = pk2(v[2], v[3]); o[2] = pk2(v[4], v[5]); o[3] = pk2(v[6], v[7]);
        *(u32x4*)(ws + O_CHD + e * 16) = o;
    }
    for (int ty = 0; ty < 2; ++ty) {
        const int T = ty ? 4112 : 2064, Tp = ty ? TP_S : TP_P, Mp = ty ? MP_S : MP_P; const int rowv = 2 * Tp / 8;
        unsigned char* dst = ws + (ty ? O_DFTS : O_DFTP); const float isq = rsqrtf((float)T), invT = 2.f / (float)T;
        for (size_t e = gt; e < (size_t)Mp * rowv; e += NT) {
            const int k = (int)(e / rowv), kk0 = (int)(e % rowv) * 8; float v[8];
#pragma unroll
            for (int i = 0; i < 8; ++i) { const int kk = kk0 + i; const int issin = kk >= Tp, t = issin ? kk - Tp : kk; float val = 0.f;
                if (k < T && (issin ? (t >= 1 && t <= T / 2 - 1) : (t <= T / 2))) { const int m = (int)(((long)k * t) % T); float sn, cn; sincospif((float)m * invT, &sn, &cn); val = (issin ? -sn : cn) * isq; }
                v[i] = val; }
            u32x4 o; o[0] = pk2(v[0], v[1]); o[1] = pk2(v[2], v[3]); o[2] = pk2(v[4], v[5]); o[3] = pk2(v[6], v[7]);
            *(u32x4*)(dst + e * 16) = o;
        }
    }
}

__device__ __forceinline__ void ea_load_row(const Params& p, const Ctx& c, int s, int pos, int lane, float (&v)[16]) {
    if (pos < 0 || pos >= c.T) {
#pragma unroll
        for (int i = 0; i < 16; ++i) v[i] = 0.f;
        return; }
    const float* src = pos < NMETA ? p.in[2] + (size_t)pos * D : c.x + ((size_t)s * (c.T - NMETA) + (pos - NMETA)) * D;
#pragma unroll
    for (int j = 0; j < 2; ++j) { const f32x4 t = *(const f32x4*)(src + j * 512 + lane * 8), t2 = *(const f32x4*)(src + j * 512 + lane * 8 + 4);
        v[8 * j] = t[0]; v[8 * j + 1] = t[1]; v[8 * j + 2] = t[2]; v[8 * j + 3] = t[3]; v[8 * j + 4] = t2[0]; v[8 * j + 5] = t2[1]; v[8 * j + 6] = t2[2]; v[8 * j + 7] = t2[3]; }
}
__device__ __forceinline__ void ea_store_row(unsigned char* base, size_t row, int lane, const float (&v)[16]) {
#pragma unroll
    for (int j = 0; j < 2; ++j) { u32x4 o; o[0] = pk2(v[8 * j], v[8 * j + 1]); o[1] = pk2(v[8 * j + 2], v[8 * j + 3]); o[2] = pk2(v[8 * j + 4], v[8 * j + 5]); o[3] = pk2(v[8 * j + 6], v[8 * j + 7]);
        *(u32x4*)(base + (row * 1024 + j * 512 + lane * 8) * 2) = o; }
}
__device__ __forceinline__ void ea_norm(float (&v)[16], const float (&nw)[16]) {
    float ss = 0.f;
#pragma unroll
    for (int i = 0; i < 16; ++i) ss += v[i] * v[i];
    ss = wave_sum(ss); const float rs = rsqrtf(ss * (1.f / 1024.f) + 1e-6f);
#pragma unroll
    for (int i = 0; i < 16; ++i) v[i] = v[i] * rs * nw[i];
}
__device__ __forceinline__ void phase_mix(const Params& p, const Ctx& c) {
    const int wave = __builtin_amdgcn_readfirstlane(ltid() >> 6), lane = ltid() & 63;
    const int gw = blockIdx.x * 8 + wave, NW = gridDim.x * 8;
    float nw[16];
#pragma unroll
    for (int j = 0; j < 4; ++j) { const f32x4 t = *(const f32x4*)(p.in[3] + (j >> 1) * 512 + lane * 8 + (j & 1) * 4); nw[4 * j] = t[0]; nw[4 * j + 1] = t[1]; nw[4 * j + 2] = t[2]; nw[4 * j + 3] = t[3]; }
    float mu[6][16];
#pragma unroll
    for (int m = 0; m < 6; ++m)
#pragma unroll
        for (int j = 0; j < 4; ++j) { const f32x4 t = *(const f32x4*)(p.in[6] + m * D + (j >> 1) * 512 + lane * 8 + (j & 1) * 4); mu[m][4 * j] = t[0]; mu[m][4 * j + 1] = t[1]; mu[m][4 * j + 2] = t[2]; mu[m][4 * j + 3] = t[3]; }
    const int nstrips = c.R / 16, spq = c.T / 16;
    for (int st = gw; st < nstrips; st += NW) {
        const int s = st / spq, pos0 = (st - s * spq) * 16; const size_t row0 = (size_t)st * 16;
        float prev[16], cur[16], nx[16];
        ea_load_row(p, c, s, pos0 - 1, lane, prev); ea_norm(prev, nw);
        ea_load_row(p, c, s, pos0, lane, cur); ea_store_row(slot(p, 0), row0, lane, cur); ea_norm(cur, nw);
        float ah[16];
        ea_load_row(p, c, s, pos0 + 1, lane, ah);
        for (int i = 0; i < 16; ++i) {
#pragma unroll
            for (int e = 0; e < 16; ++e) nx[e] = ah[e];
            if (i < 15) ea_load_row(p, c, s, pos0 + i + 2, lane, ah);
            if (i < 15) ea_store_row(slot(p, 0), row0 + i + 1, lane, nx);
            ea_norm(nx, nw);
            float xx[16], o[16];
#pragma unroll
            for (int e = 0; e < 16; ++e) xx[e] = 0.5f * (prev[e] + nx[e]) - cur[e];
#pragma unroll
            for (int m = 0; m < 6; ++m) {
#pragma unroll
                for (int e = 0; e < 16; ++e) o[e] = cur[e] + xx[e] * mu[m][e];
                ea_store_row(slot(p, 1 + m), row0 + i, lane, o); }
#pragma unroll
            for (int e = 0; e < 16; ++e) { prev[e] = cur[e]; cur[e] = nx[e]; }
        }
    }
}

__device__ __forceinline__ void ld2(const unsigned char* base, size_t elem, u32x4 (&d)[2]) { const u32x4* q = (const u32x4*)(base + elem * 2); d[0] = q[0]; d[1] = q[1]; }
__device__ __forceinline__ void phase_prescan(const Params& p, const Ctx& c) {
    const int wave = __builtin_amdgcn_readfirstlane(ltid() >> 6), lane = ltid() & 63;
    const int gw = blockIdx.x * 8 + wave, NW = gridDim.x * 8; const int ch0 = lane * 16;
    float kkw[16], kaw[16], rkw[16];
    load16f(p.in[16] + ch0, kkw); load16f(p.in[17] + ch0, kaw); load16f(p.in[18] + ch0, rkw);
    float* bonus = (float*)(p.ws + O_BONUS);
    u32x4 nk[2], na0[2], na1[2], nr[2];
    if (gw < c.R) { const size_t e = (size_t)gw * 1024 + ch0; ld2(slot(p, 8), e, nk); ld2(slot(p, 3), e, na0); ld2(slot(p, 4), e, na1); ld2(slot(p, 7), e, nr); }
    for (int row = gw; row < c.R; row += NW) {
        const size_t e = (size_t)row * 1024 + ch0;
        float k[16], a0[16], a1[16], r[16];
        unpack16(nk[0], nk[1], k); unpack16(na0[0], na0[1], a0); unpack16(na1[0], na1[1], a1); unpack16(nr[0], nr[1], r);
        if (row + NW < c.R) { const size_t e2 = (size_t)(row + NW) * 1024 + ch0; ld2(slot(p, 8), e2, nk); ld2(slot(p, 3), e2, na0); ld2(slot(p, 4), e2, na1); ld2(slot(p, 7), e2, nr); }
        float kk[16], n2 = 0.f;
#pragma unroll
        for (int i = 0; i < 16; ++i) { kk[i] = k[i] * kkw[i]; n2 += kk[i] * kk[i]; }
        n2 += __shfl_xor(n2, 1); n2 += __shfl_xor(n2, 2);
        const float inv = 1.f / fmaxf(sqrtf(n2), 1e-12f);
        float kd0[16], kd1[16], bon = 0.f;
#pragma unroll
        for (int i = 0; i < 16; ++i) { kk[i] *= inv; kd0[i] = k[i] * (1.f + (a0[i] - 1.f) * kaw[i]); kd1[i] = k[i] * (1.f + (a1[i] - 1.f) * kaw[i]);
            bon += r[i] * (kd0[i] + kd1[i]) * rkw[i]; a0[i] *= kk[i]; a1[i] *= kk[i]; }
        bon += __shfl_xor(bon, 1); bon += __shfl_xor(bon, 2);
        if ((lane & 3) == 0) bonus[(size_t)row * 16 + (lane >> 2)] = bon;
        store16bf(slot(p, 8), e, kk); store16bf(slot(p, 3), e, a0); store16bf(slot(p, 4), e, a1);
        store16bf(slot(p, 6), e, kd0); store16bf(slot(p, 10), e, kd1);
    }
}

__device__ __forceinline__ float half_sum(float x) {
    const unsigned a = __float_as_uint(x); auto r = __builtin_amdgcn_permlane32_swap(a, a, false, false);
    return __uint_as_float(r[0]) + __uint_as_float(r[1]);
}
__device__ __forceinline__ float ldbf(const unsigned char* base, int idx) { return __uint_as_float(((unsigned)((const bf16_t*)base)[idx]) << 16); }
__device__ __forceinline__ float quarter_sum(float x) {
    const unsigned a = __float_as_uint(x); auto r = __builtin_amdgcn_permlane16_swap(a, a, false, false);
    return half_sum(__uint_as_float(r[0]) + __uint_as_float(r[1]));
}
template <int RPL, int JP, int RING>
__device__ __forceinline__ void scan_items(LAS unsigned char* lds, const Params& p, const Ctx& c) {
    constexpr int LR = 64 / JP, NJ = 64 / JP, ROWS = LR * RPL, WPS = 64 / ROWS, NQ = NJ / 4, BQ = RPL == 2 ? 1 : 2, NB = NQ / BQ;
    const int tid = ltid(); const int wave = __builtin_amdgcn_readfirstlane(tid >> 6), lane = tid & 63;
    const int nitem = c.nseq * 32 * WPS; const int lr = lane % LR, jp = lane / LR;
    LAS float* wb = (LAS float*)(lds + wave * 16384);
    LAS float* oring = wb + 1024;
    for (int w = blockIdx.x + gridDim.x * wave; w < nitem; w += gridDim.x * 8) {
        const int q = w / WPS, rq = w % WPS; const int dir = q & 1, hh = (q >> 1) & 15, s = q >> 5;
        const size_t e0 = (size_t)s * c.T * 1024 + hh * 64;
        const unsigned char* Rb = slot(p, 7) + e0 * 2; const unsigned char* Kkb = slot(p, 8) + e0 * 2; const unsigned char* Vb = slot(p, 9) + e0 * 2;
        const unsigned char* Ngb = slot(p, 1 + dir) + e0 * 2; const unsigned char* Bdb = slot(p, 3 + dir) + e0 * 2;
        const unsigned char* Kdb = slot(p, dir ? 10 : 6) + e0 * 2; unsigned char* Ob = slot(p, 11 + dir) + e0 * 2;
        const int vec = lane >> 3, chunk = lane & 7;
        const unsigned char* lb = (vec == 0 ? Kkb : vec == 1 ? Ngb : vec == 2 ? Bdb : vec == 3 ? Kdb : vec == 4 ? Rb : Vb) + chunk * 16;
        const int vrow0 = rq * ROWS + lr;
        const int step = dir ? -2048 : 2048; const long ro0 = dir ? (long)(c.T - 1) * 2048 : 0;
        f32x2 S2[RPL][NJ / 2];
#pragma unroll
        for (int a_ = 0; a_ < RPL; ++a_)
#pragma unroll
            for (int j = 0; j < NJ / 2; ++j) S2[a_][j] = (f32x2){0.f, 0.f};
        u32x4 xr[RING];
#define SCAN_LD(dst, tt) do { const int _t = (tt) < c.T ? (tt) : c.T - 1; const long _r = ro0 + (long)_t * step; dst = *(const u32x4*)(lb + _r); } while (0)
#define SCAN_PARK(x, buf) do { if (vec < 6) { f32x4 _lo, _hi; _lo[0] = bflo(x[0]); _lo[1] = bfhi(x[0]); _lo[2] = bflo(x[1]); _lo[3] = bfhi(x[1]); _hi[0] = bflo(x[2]); _hi[1] = bfhi(x[2]); _hi[2] = bflo(x[3]); _hi[3] = bfhi(x[3]); \
            LAS f32x4* _d = (LAS f32x4*)((buf) + vec * 64 + chunk * 8); _d[0] = _lo; _d[1] = _hi; } } while (0)
#define SCAN_RD4(dst, base, jj) do { _Pragma("unroll") for (int _h = 0; _h < BQ; ++_h) { dst[4 * _h] = ((const LAS f32x4*)((base) + 64))[(jj) + _h]; dst[4 * _h + 1] = ((const LAS f32x4*)((base) + 128))[(jj) + _h]; \
            dst[4 * _h + 2] = ((const LAS f32x4*)((base) + 192))[(jj) + _h]; dst[4 * _h + 3] = ((const LAS f32x4*)((base) + 256))[(jj) + _h]; } } while (0)
        float vi[RPL];
        { u32x4 x; SCAN_LD(x, 0); SCAN_PARK(x, wb); }
#pragma unroll
        for (int k = 1; k < RING; ++k) SCAN_LD(xr[k], k);
        SCAN_LD(xr[0], RING);
        f32x4 kq[NQ];
#pragma unroll
        for (int j = 0; j < NQ; ++j) kq[j] = ((const LAS f32x4*)(wb + jp * NJ))[j];
#pragma unroll
        for (int a_ = 0; a_ < RPL; ++a_) vi[a_] = wb[320 + vrow0 + a_ * LR];
        int fstart = 0;
        for (int tb = 0; tb < c.T; tb += RING) {
#pragma unroll
            for (int k = 0; k < RING; ++k) {
                const int t = tb + k;
                const LAS float* sb = wb + (k & 1) * 512 + jp * NJ; LAS float* sn = wb + ((k + 1) & 1) * 512;
                f32x4 PQ[2][4 * BQ];
                SCAN_RD4(PQ[0], sb, 0);
                __builtin_amdgcn_sched_barrier(0);
                float sa[RPL];
#pragma unroll
                for (int a_ = 0; a_ < RPL; ++a_) { f32x2 a0 = (f32x2){0.f, 0.f}, a1 = (f32x2){0.f, 0.f};
#pragma unroll
                    for (int j = 0; j < NQ; ++j) { a0 = __builtin_elementwise_fma(S2[a_][2 * j], (f32x2){kq[j][0], kq[j][1]}, a0); a1 = __builtin_elementwise_fma(S2[a_][2 * j + 1], (f32x2){kq[j][2], kq[j][3]}, a1); }
                    sa[a_] = (a0[0] + a0[1]) + (a1[0] + a1[1]); }
                u32x4& xs = xr[(k + 1) % RING];
                SCAN_PARK(xs, sn);
                float vcur[RPL];
#pragma unroll
                for (int a_ = 0; a_ < RPL; ++a_) vcur[a_] = vi[a_];
                SCAN_LD(xs, t + 1 + RING);
                f32x2 sa2[RPL], v2[RPL], oa0[RPL], oa1[RPL];
#pragma unroll
                for (int a_ = 0; a_ < RPL; ++a_) { const float sr = -(JP == 2 ? half_sum(sa[a_]) : quarter_sum(sa[a_])); sa2[a_] = (f32x2){sr, sr}; v2[a_] = (f32x2){vcur[a_], vcur[a_]};
                    oa0[a_] = (f32x2){0.f, 0.f}; oa1[a_] = (f32x2){0.f, 0.f}; }
#pragma unroll
                for (int b_ = 0; b_ < NB; ++b_) {
                    if (b_ + 1 < NB) { SCAN_RD4(PQ[(b_ + 1) & 1], sb, BQ * (b_ + 1)); }
                    else {
#pragma unroll
                        for (int j = 0; j < NQ; ++j) kq[j] = ((const LAS f32x4*)(sn + jp * NJ))[j];
#pragma unroll
                        for (int a_ = 0; a_ < RPL; ++a_) vi[a_] = sn[320 + vrow0 + a_ * LR];
                    }
                    __builtin_amdgcn_sched_barrier(0);
#pragma unroll
                    for (int h_ = 0; h_ < BQ; ++h_) { const f32x4 g4 = PQ[b_ & 1][4 * h_], b4 = PQ[b_ & 1][4 * h_ + 1], d4 = PQ[b_ & 1][4 * h_ + 2], r4 = PQ[b_ & 1][4 * h_ + 3]; const int j_ = 2 * (BQ * b_ + h_);
#pragma unroll
                        for (int a_ = 0; a_ < RPL; ++a_) { f32x2 s0 = S2[a_][j_], s1 = S2[a_][j_ + 1];
                            s0 = __builtin_elementwise_fma(s0, (f32x2){g4[0], g4[1]}, s0); s1 = __builtin_elementwise_fma(s1, (f32x2){g4[2], g4[3]}, s1);
                            s0 = __builtin_elementwise_fma(sa2[a_], (f32x2){b4[0], b4[1]}, s0); s1 = __builtin_elementwise_fma(sa2[a_], (f32x2){b4[2], b4[3]}, s1);
                            s0 = __builtin_elementwise_fma(v2[a_], (f32x2){d4[0], d4[1]}, s0); s1 = __builtin_elementwise_fma(v2[a_], (f32x2){d4[2], d4[3]}, s1);
                            S2[a_][j_] = s0; S2[a_][j_ + 1] = s1;
                            oa0[a_] = __builtin_elementwise_fma(s0, (f32x2){r4[0], r4[1]}, oa0[a_]); oa1[a_] = __builtin_elementwise_fma(s1, (f32x2){r4[2], r4[3]}, oa1[a_]); } }
                    __builtin_amdgcn_sched_barrier(0);
                }
#pragma unroll
                for (int a_ = 0; a_ < RPL; ++a_) { const float os_ = (oa0[a_][0] + oa0[a_][1]) + (oa1[a_][0] + oa1[a_][1]); const float ov = JP == 2 ? half_sum(os_) : quarter_sum(os_);
                    if (jp == 0) oring[(t & 63) * ROWS + a_ * LR + lr] = ov; }
            }
            const int tend = tb + RING, nfl = tend - fstart;
            if (nfl == 64 || tend >= c.T) {
                for (int idx = lane; idx < nfl * ROWS; idx += 64) { const int st = idx / ROWS, row = idx % ROWS;
                    ((bf16_t*)(Ob + ro0 + (long)(fstart + st) * step))[rq * ROWS + row] = (bf16_t)(pk2(oring[idx], 0.f) & 0xffffu); }
                fstart = tend;
            }
        }
#undef SCAN_LD
#undef SCAN_PARK
#undef SCAN_RD4
    }
}
__device__ __forceinline__ void phase_scan(LAS unsigned char* lds, const Params& p, const Ctx& c) {
    if (c.g < 2) scan_items<2, 4, 8>(lds, p, c); else scan_items<1, 4, 8>(lds, p, c);
}

__device__ __forceinline__ void phase_postscan(const Params& p, const Ctx& c) {
    const int wave = __builtin_amdgcn_readfirstlane(ltid() >> 6), lane = ltid() & 63;
    const int gw = blockIdx.x * 8 + wave, NW = gridDim.x * 8; const int ch0 = lane * 16;
    float gw_[16], gb_[16]; load16f(p.in[19] + ch0, gw_); load16f(p.in[20] + ch0, gb_);
    const float* bonus = (const float*)(p.ws + O_BONUS);
    u32x4 nf[2], nb[2], nv[2], ng[2];
    if (gw < c.R) { const size_t e = (size_t)gw * 1024 + ch0; ld2(slot(p, 11), e, nf); ld2(slot(p, 12), e, nb); ld2(slot(p, 9), e, nv); ld2(slot(p, 5), e, ng); }
    for (int row = gw; row < c.R; row += NW) {
        const size_t e = (size_t)row * 1024 + ch0;
        float of[16], ob[16], v[16], g[16];
        unpack16(nf[0], nf[1], of); unpack16(nb[0], nb[1], ob); unpack16(nv[0], nv[1], v); unpack16(ng[0], ng[1], g);
        if (row + NW < c.R) { const size_t e2 = (size_t)(row + NW) * 1024 + ch0; ld2(slot(p, 11), e2, nf); ld2(slot(p, 12), e2, nb); ld2(slot(p, 9), e2, nv); ld2(slot(p, 5), e2, ng); }
        float sum = 0.f;
#pragma unroll
        for (int i = 0; i < 16; ++i) { of[i] += ob[i]; sum += of[i]; }
        sum += __shfl_xor(sum, 1); sum += __shfl_xor(sum, 2); const float mean = sum * (1.f / 64.f);
        float var = 0.f;
#pragma unroll
        for (int i = 0; i < 16; ++i) { of[i] -= mean; var += of[i] * of[i]; }
        var += __shfl_xor(var, 1); var += __shfl_xor(var, 2); const float rs = rsqrtf(var * (1.f / 64.f) + 64e-5f);
        const float bon = bonus[(size_t)row * 16 + (lane >> 2)];
#pragma unroll
        for (int i = 0; i < 16; ++i) of[i] = (of[i] * rs * gw_[i] + gb_[i] + bon * v[i]) * g[i];
        store16bf(slot(p, 1), e, of);
    }
}

__device__ __forceinline__ void phase_glu(const Params& p, const Ctx& c, int layer) {
    const size_t gt = (size_t)blockIdx.x * 512 + ltid(), NT = (size_t)gridDim.x * 512;
    const unsigned char* U = slot(p, 1); unsigned char* Aout = slot(p, 7);
    const float* cw = p.in[24] + (size_t)layer * 3 * DFF; const float* cb = p.in[25] + (size_t)layer * DFF;
    const size_t nitem = (size_t)(c.R / 16) * 352;
    for (size_t it = gt; it < nitem; it += NT) {
        const int strip = (int)(it / 352), cc = (int)(it % 352) * 8; const int row0 = strip * 16, pos0 = row0 % c.T;
        float w0[8], w1[8], w2[8], bb[8];
#pragma unroll
        for (int h = 0; h < 2; ++h) { const f32x4 a = *(const f32x4*)(cw + cc + 4 * h), b = *(const f32x4*)(cw + DFF + cc + 4 * h), d = *(const f32x4*)(cw + 2 * DFF + cc + 4 * h), e = *(const f32x4*)(cb + cc + 4 * h);
#pragma unroll
            for (int i = 0; i < 4; ++i) { w0[4 * h + i] = a[i]; w1[4 * h + i] = b[i]; w2[4 * h + i] = d[i]; bb[4 * h + i] = e[i]; } }
        const unsigned char* ur = U + (size_t)row0 * 5632 * 2 + cc * 2;
        const u32x4 z = (u32x4){0u, 0u, 0u, 0u};
        u32x4 pm = pos0 > 0 ? *(const u32x4*)(ur - 5632 * 2) : z, pc = *(const u32x4*)ur;
        for (int i0 = 0; i0 < 16; i0 += 4) {
            u32x4 PP[4], LN[4];
#pragma unroll
            for (int j = 0; j < 4; ++j) { PP[j] = (pos0 + i0 + j < c.T - 1) ? *(const u32x4*)(ur + (size_t)(j + 1) * 5632 * 2) : z; LN[j] = *(const u32x4*)(ur + (size_t)j * 5632 * 2 + DFF * 2); }
#pragma unroll
            for (int j = 0; j < 4; ++j) { const u32x4 pp = PP[j], ln = LN[j]; u32x4 o;
#pragma unroll
                for (int e = 0; e < 4; ++e) {
                    const float c0 = bflo(pm[e]) * w0[2 * e] + bflo(pc[e]) * w1[2 * e] + bflo(pp[e]) * w2[2 * e] + bb[2 * e];
                    const float c1 = bfhi(pm[e]) * w0[2 * e + 1] + bfhi(pc[e]) * w1[2 * e + 1] + bfhi(pp[e]) * w2[2 * e + 1] + bb[2 * e + 1];
                    o[e] = pk2(c0 * sigmoidf_(c0) * bflo(ln[e]), c1 * sigmoidf_(c1) * bfhi(ln[e])); }
                *(u32x4*)(Aout + ((size_t)(row0 + i0 + j) * DFF + cc) * 2) = o;
                pm = pc; pc = pp; }
            ur += (size_t)4 * 5632 * 2;
        }
    }
}

__device__ __forceinline__ void phase_final(const Params& p, const Ctx& c) {
    const int tid = ltid(); const int wave = __builtin_amdgcn_readfirstlane(tid >> 6), lane = tid & 63;
    const int gw = blockIdx.x * 8 + wave, NW = gridDim.x * 8; const int ch0 = lane * 16;
    float nf[16]; load16f(p.in[5] + ch0, nf);
    const int To = c.T - NMETA, nrow = c.nseq * To;
    for (int q0 = gw * 4; q0 < nrow; q0 += NW * 4) {
        u32x4 ha[4], hb[4];
#pragma unroll
        for (int j = 0; j < 4; ++j) { const int q = q0 + j, s = q / To, po = q - s * To; const size_t row = (size_t)s * c.T + NMETA + po;
            const u32x4* src = (const u32x4*)(slot(p, 0) + (row * 1024 + ch0) * 2); ha[j] = src[0]; hb[j] = src[1]; }
#pragma unroll
        for (int j = 0; j < 4; ++j) { float h[16]; unpack16(ha[j], hb[j], h);
            float ss = 0.f;
#pragma unroll
            for (int i = 0; i < 16; ++i) ss += h[i] * h[i];
            ss = wave_sum(ss); const float rs = rsqrtf(ss * (1.f / 1024.f) + 1e-6f);
            float* dst = c.y + (size_t)(q0 + j) * 1024 + ch0;
#pragma unroll
            for (int k = 0; k < 4; ++k) { f32x4 o; o[0] = h[4 * k] * rs * nf[4 * k]; o[1] = h[4 * k + 1] * rs * nf[4 * k + 1]; o[2] = h[4 * k + 2] * rs * nf[4 * k + 2]; o[3] = h[4 * k + 3] * rs * nf[4 * k + 3]; ((f32x4*)dst)[k] = o; } }
    }
}


#define XB_TMO      128
#define XB_XCNT(j)  (256  + 64 * (j))
#define XB_XSUB(j)  (1280 + 64 * (j))
#define XB_XGEN(j)  (2304 + 64 * (j))
#define XB_TOP      3328
#define XB_TOPGEN   3392
#define XCD_BAR_WORDS 3456
#define XB_SPIN_CAP (1u << 18)
__device__ __forceinline__ unsigned xb_ld(unsigned* p)              { return __hip_atomic_load(p, __ATOMIC_RELAXED, __HIP_MEMORY_SCOPE_AGENT); }
__device__ __forceinline__ unsigned xb_add(unsigned* p, unsigned v) { return __hip_atomic_fetch_add(p, v, __ATOMIC_RELAXED, __HIP_MEMORY_SCOPE_AGENT); }
__device__ __forceinline__ unsigned xb_xcc_id() { return (unsigned)__builtin_amdgcn_s_getreg((3 << 11) | 20) & 0xFu; }
#define XB_SPIN(cond, bar) do { unsigned _sp = 0; while (cond) { __builtin_amdgcn_s_sleep(1); \
    if ((++_sp & 255u) == 0u) { if (xb_ld(&(bar)[XB_TMO])) break; if (_sp > XB_SPIN_CAP) { atomicAdd(&(bar)[XB_TMO], 1u); break; } } } } while (0)
struct XcdBarrier { unsigned* bar; unsigned x; volatile LAS unsigned* st; };
__device__ __forceinline__ XcdBarrier xcd_barrier_post(unsigned* bar, volatile LAS unsigned* st) {
    XcdBarrier b; b.bar = bar; b.x = xb_xcc_id(); b.st = st;
    if (threadIdx.x == 0) (void)xb_add(&bar[XB_XCNT(b.x)], 1u);
    return b;
}
__device__ __forceinline__ void xcd_barrier_complete(unsigned* bar, unsigned x, unsigned& nloc, unsigned& nx) {
    const unsigned G = gridDim.x * gridDim.y * gridDim.z;
    unsigned sum, cnt, mine, sp = 0u;
    for (;;) {
        sum = 0u; cnt = 0u; mine = 0u;
#pragma unroll
        for (unsigned j = 0; j < 16; ++j) { const unsigned c = xb_ld(&bar[XB_XCNT(j)]); sum += c; cnt += (c > 0u) ? 1u : 0u; mine = (j == x) ? c : mine; }
        if (sum == G) break;
        __builtin_amdgcn_s_sleep(1);
        if ((++sp & 255u) == 0u) { if (xb_ld(&bar[XB_TMO])) break; if (sp > XB_SPIN_CAP) { atomicAdd(&bar[XB_TMO], 1u); break; } }
    }
    nloc = mine > 0u ? mine : 1u; nx = cnt > 0u ? cnt : 1u;
}
__device__ __forceinline__ void xcd_barrier(const XcdBarrier& b) {
    asm volatile("s_waitcnt vmcnt(0)" ::: "memory");
    __syncthreads();
    if (threadIdx.x == 0) {
        unsigned* bar = b.bar;
        __builtin_amdgcn_s_waitcnt(0);
        unsigned nloc = b.st[0], nx = b.st[1];
        if (nloc == 0u) { xcd_barrier_complete(bar, b.x, nloc, nx); b.st[0] = nloc; b.st[1] = nx; }
        const unsigned old = xb_add(&bar[XB_XSUB(b.x)], 1u);
        const unsigned gen = old / nloc;
        if (old + 1u == (gen + 1u) * nloc) {
            __builtin_amdgcn_fence(__ATOMIC_RELEASE, "agent");
            asm volatile("s_waitcnt vmcnt(0)" ::: "memory");
            const unsigned og = xb_add(&bar[XB_TOP], 1u);
            const unsigned tg = og / nx;
            if (og + 1u == (tg + 1u) * nx) xb_add(&bar[XB_TOPGEN], 1u);
            else XB_SPIN(xb_ld(&bar[XB_TOPGEN]) == tg, bar);
            __builtin_amdgcn_fence(__ATOMIC_ACQUIRE, "agent");
            xb_add(&bar[XB_XGEN(b.x)], 1u);
            asm volatile("s_waitcnt vmcnt(0)" ::: "memory");
        } else {
            XB_SPIN(xb_ld(&bar[XB_XGEN(b.x)]) == gen, bar);
            __builtin_amdgcn_fence(__ATOMIC_ACQUIRE, "agent");
            asm volatile("s_waitcnt vmcnt(0)" ::: "memory");
        }
    }
    __syncthreads();
}

constexpr int NSUB = 20, NPHASE = 1 + 4 * NSUB;

__device__ __forceinline__ void phase_rstd(const Params& p, int which) {
    const float* part = (const float*)(p.ws + O_SS) + (size_t)which * 16 * RP; float* rs = (float*)(p.ws + O_RSTD) + (size_t)which * RP;
    for (int r = blockIdx.x * 512 + ltid(); r < RP; r += gridDim.x * 512) rs[r] = rstd16(part, r);
}

__device__ __forceinline__ void phase_fold(const Params& p, const Ctx& c) {
    const int tid = ltid(); const int wave = __builtin_amdgcn_readfirstlane(tid >> 6), lane = tid & 63;
    const int gw = blockIdx.x * 8 + wave, NW = gridDim.x * 8; const int ch0 = lane * 16;
    const float* part = (const float*)(p.ws + O_SS) + (size_t)16 * RP;
    const int nrow = c.nseq * c.Tp, Th = c.T / 2;
    for (int q = gw; q < nrow; q += NW) {
        const int s = q / c.Tp, tf = q - s * c.Tp; float oc[16], os[16];
        if (tf > Th) {
#pragma unroll
            for (int i = 0; i < 16; ++i) { oc[i] = 0.f; os[i] = 0.f; }
        } else {
            const int r1 = s * c.T + tf; float a[16]; load16bf(slot(p, 0), (size_t)r1 * 1024 + ch0, a); const float rs1 = rsqrtf(wave_sum(lane < 16 ? part[(size_t)lane * RP + r1] : 0.f) * (1.f / 1024.f) + 1e-6f);
            if (tf == 0 || tf == Th) {
#pragma unroll
                for (int i = 0; i < 16; ++i) { oc[i] = a[i] * rs1; os[i] = 0.f; }
            } else {
                const int r2 = s * c.T + (c.T - tf); float b[16]; load16bf(slot(p, 0), (size_t)r2 * 1024 + ch0, b); const float rs2 = rsqrtf(wave_sum(lane < 16 ? part[(size_t)lane * RP + r2] : 0.f) * (1.f / 1024.f) + 1e-6f);
#pragma unroll
                for (int i = 0; i < 16; ++i) { const float x = a[i] * rs1, y = b[i] * rs2; oc[i] = x + y; os[i] = x - y; }
            }
        }
        store16bf(slot(p, 5), (size_t)q * 1024 + ch0, oc); store16bf(slot(p, 6), (size_t)q * 1024 + ch0, os);
    }
}

__device__ __forceinline__ void run_phase(LAS unsigned char* lds, const Params& p, int ph) {
    if (ph == 0) { prep_phase(lds, p); return; }
    const int g = (ph - 1) / NSUB, sp = (ph - 1) % NSUB; const Ctx c = get_ctx(p, g);
    GemmPh P; P.G = gridDim.x; P.c = blockIdx.x; P.A = nullptr; P.B = nullptr; P.O = nullptr; P.ss = nullptr; P.ssin = nullptr; P.ldo = 0; P.kind = -1;
    float* ssb = (float*)(p.ws + O_SS); const float* rsb = (const float*)(p.ws + O_RSTD);
    switch (sp) {
    case 1: P.kind = K_L1; P.nunits = MT * 15; P.lda = 1024; P.ldb = 1024; P.K = 1024; break;
    case 2: P.kind = K_L2; P.nunits = MT * 20; P.lda = 256; P.ldb = 256; P.K = 256; break;
    case 6: P.kind = K_RES; P.nunits = MT * 4; P.lda = 1024; P.ldb = 1024; P.K = 1024; P.A = (const char*)slot(p, 1); P.B = (const char*)p.ws + O_WO; P.O = slot(p, 0); P.ss = ssb; break;
    case 8: case 16: { const int l = sp == 8 ? 0 : 1; P.kind = K_U; P.nunits = MT * 22; P.lda = 1024; P.ldb = 1024; P.K = 1024; P.A = (const char*)slot(p, 0); P.B = (const char*)p.ws + O_WIN + (size_t)l * 5632 * 1024 * 2;
        P.O = slot(p, 1); P.ssin = rsb + (l ? 2 * RP : 0); } break;
    case 10: case 18: { const int l = sp == 10 ? 0 : 1; P.kind = K_RES; P.nunits = MT * 4; P.lda = DFF; P.ldb = DFF; P.K = DFF; P.A = (const char*)slot(p, 7); P.B = (const char*)p.ws + O_WOUT + (size_t)l * 1024 * DFF * 2;
        P.O = slot(p, 0); P.ss = l ? nullptr : ssb + 16 * RP; } break;
    case 12: P.kind = K_CH; P.nunits = (c.nseq * c.Tp / 256) * 8; P.lda = 1024; P.ldb = 1024; P.K = 256; P.A = (const char*)p.ws + O_CHD; P.B = (const char*)slot(p, 5); P.O = slot(p, 1); break;
    case 13: P.kind = K_TD; P.nunits = c.nseq * c.tm * 4; P.lda = 2 * c.Tp; P.ldb = 2 * c.Tp; P.K = 2 * c.Tp; P.A = (const char*)p.ws + (g < 2 ? O_DFTP : O_DFTS); P.B = (const char*)slot(p, 1); P.O = slot(p, 4); break;
    case 14: P.kind = K_RES; P.nunits = MT * 4; P.lda = 1024; P.ldb = 1024; P.K = 1024; P.A = (const char*)slot(p, 4); P.B = (const char*)p.ws + O_WF; P.O = slot(p, 0); P.ss = ssb + 2 * 16 * RP; break;
    default: break;
    }
    if (P.kind >= 0) {
        switch (P.kind) {
        case K_L1: gemm_phase<K_L1>(lds, P, p, c); break;
        case K_L2: gemm_phase<K_L2>(lds, P, p, c); break;
        case K_RES: gemm_phase<K_RES>(lds, P, p, c); break;
        case K_U: gemm_phase<K_U>(lds, P, p, c); break;
        case K_CH: gemm_phase<K_CH>(lds, P, p, c); break;
        default: gemm_phase<K_TD>(lds, P, p, c); break;
        }
        if (sp == 13) {
            const int tid = ltid(); const int wave = __builtin_amdgcn_readfirstlane(tid >> 6), lane = tid & 63; const int K2 = 2 * c.Tp;
            const bf16_t* drow = (const bf16_t*)P.A + (size_t)(NMETA - 1) * K2; const bf16_t* yT = (const bf16_t*)slot(p, 1); bf16_t* F = (bf16_t*)slot(p, 4);
            for (int it = blockIdx.x * 8 + wave; it < c.nseq * 1024; it += gridDim.x * 8) {
                const int s = it >> 10, ch = it & 1023; const bf16_t* yr = yT + ((size_t)s * 1024 + ch) * K2; float acc = 0.f;
                for (int kk = lane * 2; kk < K2; kk += 128) { const unsigned a = *(const unsigned*)(drow + kk), b = *(const unsigned*)(yr + kk); acc += bflo(a) * bflo(b) + bfhi(a) * bfhi(b); }
                acc = wave_sum(acc);
                if (lane == 0) F[((size_t)s * c.T + (NMETA - 1)) * 1024 + ch] = (bf16_t)(pk2(acc, 0.f) & 0xffffu);
            }
        }
        return;
    }
    if (sp == 0) phase_mix(p, c);
    else if (sp == 3) phase_prescan(p, c);
    else if (sp == 4) phase_scan(lds, p, c);
    else if (sp == 5) phase_postscan(p, c);
    else if (sp == 11) phase_fold(p, c);
    else if (sp == 7 || sp == 15) phase_rstd(p, sp == 7 ? 0 : 2);
    else if (sp == 9 || sp == 17) phase_glu(p, c, sp == 9 ? 0 : 1);
    else phase_final(p, c);
}

__global__ void __launch_bounds__(512, 2) mega(Params p, int ph_lo, int ph_hi) {
    extern __shared__ __attribute__((aligned(16))) unsigned char shm[];
    LAS unsigned char* lds = (LAS unsigned char*)shm;
    cg::grid_group grid = cg::this_grid();
    volatile LAS unsigned* st = (volatile LAS unsigned*)(lds + STAGE_BYTES);
    if (threadIdx.x == 0) { st[0] = 0u; st[1] = 0u; }
    __syncthreads();
    const XcdBarrier xb = xcd_barrier_post((unsigned*)(p.ws + O_BAR), st);
    for (int ph = ph_lo; ph < ph_hi; ++ph) {
        if (ph_hi < 0) grid.sync();
        if (ph > ph_lo) xcd_barrier(xb);
        run_phase(lds, p, ph);
    }
}

extern "C" void kernel_launch(void* const* d_in, const int* in_sizes, int n_in, void* d_out, int out_size, void* d_ws, size_t ws_size, hipStream_t stream) {
    static int grid = 0;
    if (grid == 0) {
        if (n_in != 27 || ws_size < WS_END) { fprintf(stderr, "kernel_launch: need 27 inputs and %zu B of workspace (got %d, %zu)\n", (size_t)WS_END, n_in, ws_size); grid = -1; return; }
        int dev = 0, cus = 0, per_cu = 0;
        hipGetDevice(&dev); hipDeviceGetAttribute(&cus, hipDeviceAttributeMultiprocessorCount, dev);
        if (hipFuncSetAttribute((const void*)mega, hipFuncAttributeMaxDynamicSharedMemorySize, STAGE_BYTES + 16) != hipSuccess) { fprintf(stderr, "hipFuncSetAttribute failed\n"); grid = -1; return; }
        hipOccupancyMaxActiveBlocksPerMultiprocessor(&per_cu, (const void*)mega, 512, STAGE_BYTES + 16);
        if (per_cu < 1) per_cu = 1;
        (void)hipGetLastError();
        grid = cus * 1;
    }
    if (grid < 0) return;
    Params p{};
    for (int i = 0; i < 27; ++i) p.in[i] = (const float*)d_in[i];
    p.out = (float*)d_out; p.ws = (unsigned char*)d_ws;
#if MK_PER_PHASE
    for (int ph = 0; ph < NPHASE; ++ph) hipLaunchKernelGGL(mega, dim3(grid), dim3(512), STAGE_BYTES + 16, stream, p, ph, ph + 1);
#else
    (void)hipMemsetAsync((unsigned char*)d_ws + O_BAR, 0, 16384, stream);
    int lo = 0, hi = NPHASE;
    void* args[] = {&p, &lo, &hi};
    hipError_t e = hipLaunchCooperativeKernel((const void*)mega, dim3(grid), dim3(512), args, STAGE_BYTES + 16, stream);
    if (e != hipSuccess) fprintf(stderr, "cooperative launch failed: %s (grid %d)\n", hipGetErrorString(e), grid);
#endif
}
```
